# Optimizing an MI355X kernel written in HIP

```python
import jax, jax.numpy as jnp
from jax import lax
import numpy as np

D_MODEL = 1024
BATCH = 8
SEQ = 2048
DEPTH = 2
DEC_BATCH = 128
DEC_SEQ = 1
PAST_LEN = 16384
PAGE_SIZE = 128

N_BRANCH = 4
W_BR = D_MODEL // N_BRANCH
HEAD_A = 64
H_A = W_BR // HEAD_A
R_DECAY = 32
R_ICL = 32
GN_EPS_A = 64e-5
H_B = 4
DK_B = W_BR // (2 * H_B)
DV_B = W_BR // H_B
R_GATE_B = 16
GLA_TAU = 16.0
GLA_CHUNK = 64
H_C = 4
KV_C = 2
HD_C = W_BR // H_C
G_C = H_C // KV_C
WINDOW = 128
NB_D = 4
BS_D = W_BR // NB_D
CONV_W = 4
C_RG = 8.0
NORM_EPS = 1e-6

A_COLS = 3 * W_BR + R_DECAY + R_ICL
B_COLS = 2 * H_B * DK_B + W_BR + R_GATE_B
C_COLS = H_C * HD_C + 2 * KV_C * HD_C
D_COLS = W_BR
Z_COLS = N_BRANCH * W_BR
G_COLS = N_BRANCH * D_MODEL
IN_COLS = A_COLS + B_COLS + C_COLS + D_COLS + Z_COLS + G_COLS

kernel_name = 'hybrid_rwkv7_gla_swa_rglru_decode_step'

f32 = jnp.float32


def _split(x, sizes):
    idx = np.cumsum(sizes)[:-1].tolist()
    return jnp.split(x, idx, axis=-1)


def _rmsnorm(x, g):
    xf = x.astype(f32)
    y = xf * lax.rsqrt(jnp.mean(xf * xf, -1, keepdims=True) + NORM_EPS)
    return (y * g.astype(f32)).astype(x.dtype)


def _alibi_slopes(n):
    return 2.0 ** (-8.0 * jnp.arange(1, n + 1, dtype=f32) / n)


def _rwkv7_mix(u, shift0, S0, mu, w0, w_up, a0, a_up, k_k, k_a, r_k, ln_g, ln_b):
    B, L, _ = u.shape
    u = u.astype(f32)
    u_prev = jnp.concatenate([shift0[:, None].astype(f32), u[:, :-1]], axis=1)
    us = u + (u_prev - u) * mu.astype(f32)
    r, k, v, wl, al = _split(us, [W_BR, W_BR, W_BR, R_DECAY, R_ICL])
    w = -jax.nn.softplus(-(w0 + jnp.tanh(wl) @ w_up)) - 0.5
    decay = jnp.exp(-jnp.exp(w))
    a = jax.nn.sigmoid(a0 + al @ a_up)
    heads = lambda t: t.reshape(B, L, H_A, HEAD_A)
    kk = heads(k * k_k)
    kk = kk / jnp.maximum(jnp.sqrt(jnp.sum(kk * kk, -1, keepdims=True)), 1e-12)
    k = k * (1.0 + (a - 1.0) * k_a)
    r_h, k_h, v_h, w_h, a_h = heads(r), heads(k), heads(v), heads(decay), heads(a)

    def step(S, inp):
        r_t, k_t, v_t, w_t, kk_t, a_t = inp
        sa = jnp.einsum('bhvk,bhk->bhv', S, -kk_t)
        S = (S * w_t[:, :, None, :] + sa[..., None] * (kk_t * a_t)[:, :, None, :]
             + v_t[..., None] * k_t[:, :, None, :])
        return S, jnp.einsum('bhvk,bhk->bhv', S, r_t)

    xs = tuple(jnp.moveaxis(t, 1, 0) for t in (r_h, k_h, v_h, w_h, kk, a_h))
    S_fin, o = lax.scan(step, S0.astype(f32), xs)
    o = jnp.moveaxis(o, 0, 1)
    mean = jnp.mean(o, -1, keepdims=True)
    var = jnp.mean(jnp.square(o - mean), -1, keepdims=True)
    o = ((o - mean) * lax.rsqrt(var + GN_EPS_A)).reshape(B, L, W_BR) * ln_g + ln_b
    bonus = jnp.sum(r_h * k_h * r_k, -1, keepdims=True) * v_h
    return o + bonus.reshape(B, L, W_BR), u[:, -1], S_fin


def _gla_mix(f, S0, up, bias, norm_g):
    B, L, _ = f.shape
    f = f.astype(f32)
    q, k, v, gl = _split(f, [H_B * DK_B, H_B * DK_B, W_BR, R_GATE_B])
    g = jax.nn.log_sigmoid(gl @ up + bias) / GLA_TAU
    q = q.reshape(B, L, H_B, DK_B) * DK_B ** -0.5
    k = k.reshape(B, L, H_B, DK_B)
    g = g.reshape(B, L, H_B, DK_B)
    v = v.reshape(B, L, H_B, DV_B)
    pad = (-L) % GLA_CHUNK
    nc = (L + pad) // GLA_CHUNK

    def chunks(t):
        t = jnp.pad(t, ((0, 0), (0, pad), (0, 0), (0, 0)))
        return t.reshape(B, nc, GLA_CHUNK, H_B, t.shape[-1]).transpose(1, 0, 3, 2, 4)

    causal = jnp.tril(jnp.ones((GLA_CHUNK, GLA_CHUNK), bool))

    def step(S, inp):
        q_c, k_c, v_c, g_c = inp
        b = jnp.cumsum(g_c, axis=2)
        qe = q_c * jnp.exp(b)
        ke = k_c * jnp.exp(-b)
        att = jnp.where(causal, jnp.einsum('bhtd,bhsd->bhts', qe, ke), 0.0)
        o = jnp.einsum('bhts,bhse->bhte', att, v_c) + jnp.einsum('bhtd,bhde->bhte', qe, S)
        b_last = b[:, :, -1:, :]
        S = (jnp.exp(b_last[:, :, 0, :])[..., None] * S
             + jnp.einsum('bhsd,bhse->bhde', k_c * jnp.exp(b_last - b), v_c))
        return S, o

    S_fin, o = lax.scan(step, S0.astype(f32), (chunks(q), chunks(k), chunks(v), chunks(g)))
    o = o.transpose(1, 0, 3, 2, 4).reshape(B, nc * GLA_CHUNK, H_B, DV_B)[:, :L]
    o = o * lax.rsqrt(jnp.mean(o * o, -1, keepdims=True) + NORM_EPS) * norm_g
    return o.reshape(B, L, W_BR), S_fin


def _sink_attend(q, k, v, dist, valid, sinks):
    slopes = _alibi_slopes(H_C).reshape(KV_C, G_C)
    s = jnp.einsum('bnqkgd,bnskd->bnkgqs', q, k).astype(f32) * HD_C ** -0.5
    s = s - slopes[None, None, :, :, None, None] * dist[None, :, None, None].astype(f32)
    s = jnp.where(valid[None, :, None, None], s, -jnp.inf)
    sink = jnp.broadcast_to(sinks.astype(f32).reshape(KV_C, G_C)[None, None, :, :, None, None],
                            s.shape[:-1] + (1,))
    p = jax.nn.softmax(jnp.concatenate([s, sink], axis=-1), axis=-1)[..., :-1]
    return jnp.einsum('bnkgqs,bnskd->bnqkgd', p.astype(v.dtype), v)


def _swa_prompt(q, k, v, sinks):
    B, L = q.shape[:2]
    nb = L // WINDOW
    qb = q.reshape(B, nb, WINDOW, KV_C, G_C, HD_C)

    def band(t):
        tp = jnp.pad(t, ((0, 0), (WINDOW, 0), (0, 0), (0, 0))).reshape(B, nb + 1, WINDOW, KV_C, HD_C)
        return jnp.concatenate([tp[:, :-1], tp[:, 1:]], axis=2)

    t_pos = jnp.arange(WINDOW)[:, None] + WINDOW
    s_pos = jnp.arange(2 * WINDOW)[None, :]
    dist = t_pos - s_pos
    blk = jnp.arange(nb)[:, None, None]
    valid = (dist >= 0) & (dist <= WINDOW) & (blk * WINDOW - WINDOW + s_pos >= 0)
    dist = jnp.broadcast_to(dist, valid.shape)
    out = _sink_attend(qb, band(k), band(v), dist, valid, sinks)
    return out.reshape(B, L, H_C * HD_C), k[:, L - WINDOW:], v[:, L - WINDOW:]


def _swa_sample(q, k, v, kbuf, vbuf, sinks):
    B, T = q.shape[:2]
    WB = kbuf.shape[1]
    kc = jnp.concatenate([kbuf.astype(k.dtype), k], axis=1)
    vc = jnp.concatenate([vbuf.astype(v.dtype), v], axis=1)
    dist = (WB + jnp.arange(T)[:, None] - jnp.arange(WB + T)[None, :])[None]
    valid = (dist >= 0) & (dist <= WINDOW)
    out = _sink_attend(q[:, None], kc[:, None], vc[:, None], dist, valid, sinks)
    return out.reshape(B, T, H_C * HD_C), kc[:, -WB:], vc[:, -WB:]


def _rglru_mix(xd, conv0, h0, conv_w, conv_b, wa, ba, wx, bx, lam):
    B, L, _ = xd.shape
    xp = jnp.concatenate([conv0.astype(f32), xd.astype(f32)], axis=1)
    xc = conv_b.astype(f32)
    for j in range(CONV_W):
        xc = xc + xp[:, j:j + L] * conv_w[j]
    xb = xc.reshape(B, L, NB_D, BS_D)
    r = jax.nn.sigmoid(jnp.einsum('blnc,ncd->blnd', xb, wa).reshape(B, L, W_BR) + ba)
    i = jax.nn.sigmoid(jnp.einsum('blnc,ncd->blnd', xb, wx).reshape(B, L, W_BR) + bx)
    log_a = C_RG * r * jax.nn.log_sigmoid(lam)
    a = jnp.exp(log_a)
    bterm = jnp.sqrt(-jnp.expm1(2.0 * log_a)) * (i * xc)
    bterm = bterm.at[:, 0].add(a[:, 0] * h0.astype(f32))

    def comb(lhs, rhs):
        a1, b1 = lhs
        a2, b2 = rhs
        return a1 * a2, a2 * b1 + b2

    _, h = lax.associative_scan(comb, (a, bterm), axis=1)
    return h, xp[:, -(CONV_W - 1):], h[:, -1]


def _layer(x, lp, wkv0, shift0, gla0, conv0, h0, kbuf, vbuf):
    B, L, _ = x.shape
    hn = _rmsnorm(x, lp['norm_g'])
    proj = hn @ lp['w_in']
    fa, fb, fc, fd, z, gates = _split(proj, [A_COLS, B_COLS, C_COLS, D_COLS, Z_COLS, G_COLS])
    y_a, shift1, wkv1 = _rwkv7_mix(fa, shift0, wkv0, lp['mu_shift'], lp['w0'], lp['w_decay_up'],
                                   lp['a0'], lp['a_icl_up'], lp['k_k'], lp['k_a'], lp['r_k'],
                                   lp['ln_x_g'], lp['ln_x_b'])
    y_b, gla1 = _gla_mix(fb, gla0, lp['gla_gate_up'], lp['gla_gate_b'], lp['gla_norm_g'])
    q, k, v = _split(fc, [H_C * HD_C, KV_C * HD_C, KV_C * HD_C])
    q = q.reshape(B, L, KV_C, G_C, HD_C)
    k = k.reshape(B, L, KV_C, HD_C)
    v = v.reshape(B, L, KV_C, HD_C)
    if kbuf is None:
        y_c, k1, v1 = _swa_prompt(q, k, v, lp['swa_sinks'])
    else:
        y_c, k1, v1 = _swa_sample(q, k, v, kbuf, vbuf, lp['swa_sinks'])
    y_d, conv1, h1 = _rglru_mix(fd, conv0, h0, lp['lru_conv_w'], lp['lru_conv_b'], lp['lru_wa'],
                                lp['lru_ba'], lp['lru_wx'], lp['lru_bx'], lp['lru_lambda'])
    ys = jnp.stack([y_a, y_b, y_c.astype(f32), y_d], axis=2)
    ys = ys * jax.nn.silu(z.reshape(B, L, N_BRANCH, W_BR).astype(f32))
    br = jnp.einsum('blnw,nwd->blnd', ys.astype(x.dtype), lp['w_branch'])
    gate = jax.nn.sigmoid(gates.reshape(B, L, N_BRANCH, D_MODEL))
    merged = jnp.sum(gate * br, axis=2)
    out = x + merged @ lp['w_out']
    return out, (wkv1, shift1, gla1, k1, v1, conv1, h1)


def setup_inputs(seed: int = 0) -> dict:
    key = jax.random.key(seed)
    ks = iter(jax.random.split(key, 48))
    nrm = lambda shape, scale: scale * jax.random.normal(next(ks), shape, f32)
    uni = lambda shape, lo, hi: jax.random.uniform(next(ks), shape, f32, lo, hi)
    win_buf = min(WINDOW, PAST_LEN)
    u = uni((DEPTH, W_BR), 0.9, 0.999)
    s = u ** (1.0 / C_RG)
    lam = jnp.log(s) - jnp.log1p(-s)
    return {
        'x_prompt': nrm((BATCH, SEQ, D_MODEL), 1.0),
        'x_sample': nrm((DEC_BATCH, DEC_SEQ, D_MODEL), 1.0),
        'state_wkv': nrm((DEPTH, DEC_BATCH, H_A, HEAD_A, HEAD_A), 1.0),
        'state_shift': nrm((DEPTH, DEC_BATCH, A_COLS), 1.0),
        'state_gla': nrm((DEPTH, DEC_BATCH, H_B, DK_B, DV_B), 1.0),
        'cache_swa_k': nrm((DEPTH, DEC_BATCH, win_buf, KV_C, HD_C), 1.0),
        'cache_swa_v': nrm((DEPTH, DEC_BATCH, win_buf, KV_C, HD_C), 1.0),
        'state_lru_conv': nrm((DEPTH, DEC_BATCH, CONV_W - 1, W_BR), 1.0),
        'state_lru_h': nrm((DEPTH, DEC_BATCH, W_BR), 0.5),
        'norm_g': 1.0 + nrm((DEPTH, D_MODEL), 0.02),
        'w_in': nrm((DEPTH, D_MODEL, IN_COLS), D_MODEL ** -0.5),
        'mu_shift': uni((DEPTH, A_COLS), 0.0, 1.0),
        'w0': uni((DEPTH, W_BR), -6.0, 1.0),
        'w_decay_up': nrm((DEPTH, R_DECAY, W_BR), 0.1 * R_DECAY ** -0.5),
        'a0': nrm((DEPTH, W_BR), 0.1),
        'a_icl_up': nrm((DEPTH, R_ICL, W_BR), R_ICL ** -0.5),
        'k_k': 0.85 + nrm((DEPTH, W_BR), 0.02),
        'k_a': 1.0 + nrm((DEPTH, W_BR), 0.02),
        'r_k': nrm((DEPTH, H_A, HEAD_A), 0.1),
        'ln_x_g': 1.0 + nrm((DEPTH, W_BR), 0.02),
        'ln_x_b': nrm((DEPTH, W_BR), 0.02),
        'gla_gate_up': nrm((DEPTH, R_GATE_B, H_B * DK_B), R_GATE_B ** -0.5),
        'gla_gate_b': uni((DEPTH, H_B * DK_B), 0.0, 4.0),
        'gla_norm_g': 1.0 + nrm((DEPTH, DV_B), 0.02),
        'swa_sinks': nrm((DEPTH, H_C), 0.5),
        'lru_conv_w': nrm((DEPTH, CONV_W, W_BR), CONV_W ** -0.5),
        'lru_conv_b': nrm((DEPTH, W_BR), 0.01),
        'lru_wa': nrm((DEPTH, NB_D, BS_D, BS_D), BS_D ** -0.5),
        'lru_ba': nrm((DEPTH, W_BR), 0.01),
        'lru_wx': nrm((DEPTH, NB_D, BS_D, BS_D), BS_D ** -0.5),
        'lru_bx': nrm((DEPTH, W_BR), 0.01),
        'lru_lambda': lam,
        'w_branch': nrm((DEPTH, N_BRANCH, W_BR, D_MODEL), W_BR ** -0.5),
        'w_out': nrm((DEPTH, D_MODEL, D_MODEL), D_MODEL ** -0.5),
        'final_norm_g': 1.0 + nrm((D_MODEL,), 0.02),
    }


def reference(x_prompt, x_sample, state_wkv, state_shift, state_gla, cache_swa_k, cache_swa_v,
              state_lru_conv, state_lru_h, norm_g, w_in, mu_shift, w0, w_decay_up, a0, a_icl_up,
              k_k, k_a, r_k, ln_x_g, ln_x_b, gla_gate_up, gla_gate_b, gla_norm_g, swa_sinks,
              lru_conv_w, lru_conv_b, lru_wa, lru_ba, lru_wx, lru_bx, lru_lambda, w_branch, w_out,
              final_norm_g):
    bp = x_prompt.shape[0]
    y_p, y_s = x_prompt, x_sample
    new_p = [[] for _ in range(7)]
    new_s = [[] for _ in range(7)]
    for l in range(DEPTH):
        lp = dict(norm_g=norm_g[l], w_in=w_in[l], mu_shift=mu_shift[l], w0=w0[l],
                  w_decay_up=w_decay_up[l], a0=a0[l], a_icl_up=a_icl_up[l], k_k=k_k[l], k_a=k_a[l],
                  r_k=r_k[l], ln_x_g=ln_x_g[l], ln_x_b=ln_x_b[l], gla_gate_up=gla_gate_up[l],
                  gla_gate_b=gla_gate_b[l], gla_norm_g=gla_norm_g[l], swa_sinks=swa_sinks[l],
                  lru_conv_w=lru_conv_w[l], lru_conv_b=lru_conv_b[l], lru_wa=lru_wa[l],
                  lru_ba=lru_ba[l], lru_wx=lru_wx[l], lru_bx=lru_bx[l], lru_lambda=lru_lambda[l],
                  w_branch=w_branch[l], w_out=w_out[l])
        y_p, st_p = _layer(y_p, lp,
                           jnp.zeros((bp, H_A, HEAD_A, HEAD_A), f32),
                           jnp.zeros((bp, A_COLS), f32),
                           jnp.zeros((bp, H_B, DK_B, DV_B), f32),
                           jnp.zeros((bp, CONV_W - 1, W_BR), f32),
                           jnp.zeros((bp, W_BR), f32),
                           None, None)
        y_s, st_s = _layer(y_s, lp, state_wkv[l], state_shift[l], state_gla[l],
                           state_lru_conv[l], state_lru_h[l], cache_swa_k[l], cache_swa_v[l])
        for i in range(7):
            new_p[i].append(st_p[i])
            new_s[i].append(st_s[i])
    y_prompt = _rmsnorm(y_p, final_norm_g)
    y_sample = _rmsnorm(y_s, final_norm_g)
    wkv_p, shift_p, gla_p, k_p, v_p, conv_p, h_p = [jnp.stack(t) for t in new_p]
    wkv_s, shift_s, gla_s, k_s, v_s, conv_s, h_s = [jnp.stack(t) for t in new_s]
    return (y_prompt, y_sample, wkv_p, wkv_s, shift_p, shift_s, gla_p, gla_s, k_p, k_s, v_p, v_s,
            conv_p, conv_s, h_p, h_s)
```

```cpp
#include <hip/hip_runtime.h>
#include <hip/hip_cooperative_groups.h>
#include <cstdio>
#include <cstdint>
namespace cg = cooperative_groups;

typedef unsigned short bf16_t;
typedef short bf16x8 __attribute__((ext_vector_type(8)));
typedef float f32x4 __attribute__((ext_vector_type(4)));
typedef unsigned u32x4 __attribute__((ext_vector_type(4)));
typedef unsigned u32x2 __attribute__((ext_vector_type(2)));
typedef float f32x2 __attribute__((ext_vector_type(2)));
#define LAS __attribute__((address_space(3)))
#define DEVI __device__ __forceinline__

#ifndef PROBE_SP
#define PROBE_SP -1
#endif
#ifndef USE_CG_SYNC
#define USE_CG_SYNC 0
#endif
#ifndef ONE_LAUNCH
#define ONE_LAUNCH 1
#endif

constexpr int NTOK = 16384, NSAMP = 128, ROWS = 16512, MPAD = 16640, SEQ = 2048;
constexpr int INC = 7248;
constexpr int CA = 0, CB = 832, CC = 1360, CD = 1872, CZ = 2128, CG = 3152;
constexpr int PALD = 2304;
constexpr int NPH = 16;
constexpr int LDS_BYTES = 131072;

constexpr size_t OFF_W1T = 0, SZ_W1T = (size_t)2 * 7424 * 1024 * 2;
constexpr size_t OFF_WBR = OFF_W1T + SZ_W1T, SZ_WBR = (size_t)2 * 4 * 1024 * 256 * 2;
constexpr size_t OFF_WOUT = OFF_WBR + SZ_WBR, SZ_WOUT = (size_t)2 * 1024 * 1024 * 2;
constexpr size_t OFF_XB = OFF_WOUT + SZ_WOUT, SZ_XB = (size_t)MPAD * 1024 * 2;
constexpr size_t OFF_ZY = OFF_XB + SZ_XB;
constexpr size_t OFF_SSQ = OFF_ZY + SZ_XB, SZ_SSQ = (size_t)3 * MPAD * 4;
constexpr size_t OFF_BR = OFF_SSQ + SZ_SSQ, SZ_BR = (size_t)MPAD * 4096 * 2;
constexpr size_t OFF_PA = OFF_BR, SZ_PA = (size_t)MPAD * PALD * 2;
constexpr size_t OFF_RWP = OFF_BR + SZ_PA, SZ_RWP = (size_t)ROWS * 1536 * 2;
constexpr size_t OFF_RWC = OFF_RWP + SZ_RWP, SZ_RWC = (size_t)ROWS * 16 * 4;
constexpr size_t OFF_BAR = OFF_BR + SZ_BR;
constexpr size_t OFF_WLT = OFF_BAR + 4096, SZ_WLT = (size_t)2 * 2 * 4 * 4096 * 2;
constexpr size_t WS_END = OFF_WLT + SZ_WLT;
static_assert(OFF_RWC + SZ_RWC <= WS_END, "ws overlay");

constexpr size_t SO_RWO = 0;
constexpr size_t SO_LH = SO_RWO + (size_t)ROWS * 256;
constexpr size_t SO_LP = SO_LH + (size_t)NTOK * 256;
constexpr size_t SO_GU = SO_LP + (size_t)NTOK * 256;
constexpr size_t SO_GD = SO_GU + (size_t)1024 * 2048;
constexpr size_t SO_LA = SO_GD + (size_t)1024 * 32;
constexpr size_t SO_LB = SO_LA + (size_t)8 * 128 * 256;
static_assert(SO_LB + 8 * 128 * 256 <= (size_t)ROWS * 1024, "out scratch");

constexpr size_t O_Y = 0;
constexpr size_t O_WKVP = (size_t)ROWS * 1024;
constexpr size_t O_WKVS = O_WKVP + 2 * 8 * 4 * 64 * 64;
constexpr size_t O_SHP = O_WKVS + (size_t)2 * 128 * 4 * 64 * 64;
constexpr size_t O_SHS = O_SHP + 2 * 8 * 832;
constexpr size_t O_GLP = O_SHS + 2 * 128 * 832;
constexpr size_t O_GLS = O_GLP + 2 * 8 * 4 * 32 * 64;
constexpr size_t O_KP = O_GLS + 2 * 128 * 4 * 32 * 64;
constexpr size_t O_KS = O_KP + 2 * 8 * 128 * 128;
constexpr size_t O_VP = O_KS + (size_t)2 * 128 * 128 * 128;
constexpr size_t O_VS = O_VP + 2 * 8 * 128 * 128;
constexpr size_t O_CVP = O_VS + (size_t)2 * 128 * 128 * 128;
constexpr size_t O_CVS = O_CVP + 2 * 8 * 3 * 256;
constexpr size_t O_HP = O_CVS + 2 * 128 * 3 * 256;
constexpr size_t O_HS = O_HP + 2 * 8 * 256;
constexpr size_t O_END = O_HS + 2 * 128 * 256;

struct Params {
    const float* in[35];
    float* out;
    unsigned char* ws;
};
enum { I_XP = 0, I_XS, I_SWKV, I_SSHIFT, I_SGLA, I_CK, I_CV, I_SCONV, I_SH, I_NG, I_WIN, I_MU, I_W0, I_WUP, I_A0, I_AUP, I_KK, I_KA, I_RK, I_LNG, I_LNB,
       I_GUP, I_GB, I_GNG, I_SINK, I_CW, I_CBI, I_WA, I_BA, I_WX, I_BX, I_LAM, I_WBR, I_WOUT, I_FNG };

DEVI int tidx() { int t = (int)threadIdx.x; asm volatile("" : "+v"(t)); return t; }
DEVI float bf2f(bf16_t h) { return __uint_as_float(((unsigned)h) << 16); }
DEVI float bflo(unsigned w) { return __uint_as_float(w << 16); }
DEVI float bfhi(unsigned w) { return __uint_as_float(w & 0xffff0000u); }
DEVI unsigned f2bfu(float f) { unsigned u = __float_as_uint(f); return (u + 0x7fffu + ((u >> 16) & 1u)) >> 16; }
DEVI bf16_t f2bf(float f) { return (bf16_t)f2bfu(f); }
DEVI unsigned pk2(float lo, float hi) { return f2bfu(lo) | (f2bfu(hi) << 16); }
template <int CTRL> DEVI float dpp_mov(float v) { return __builtin_bit_cast(float, __builtin_amdgcn_update_dpp(0, __builtin_bit_cast(int, v), CTRL, 0xF, 0xF, true)); }
DEVI float rdlane(float v, int l) { return __builtin_bit_cast(float, __builtin_amdgcn_readlane(__builtin_bit_cast(int, v), l)); }
DEVI float reduce16(float v) { v += dpp_mov<0xB1>(v); v += dpp_mov<0x4E>(v); v += dpp_mov<0x141>(v); v += dpp_mov<0x140>(v); return v; }
DEVI float reduce8(float v) { v += dpp_mov<0xB1>(v); v += dpp_mov<0x4E>(v); v += dpp_mov<0x141>(v); return v; }
DEVI float wave_sum(float v) { v = reduce16(v); return (rdlane(v, 0) + rdlane(v, 16)) + (rdlane(v, 32) + rdlane(v, 48)); }
DEVI float wave_max(float v) { v = fmaxf(v, dpp_mov<0xB1>(v)); v = fmaxf(v, dpp_mov<0x4E>(v)); v = fmaxf(v, dpp_mov<0x141>(v)); v = fmaxf(v, dpp_mov<0x140>(v));
    return fmaxf(fmaxf(rdlane(v, 0), rdlane(v, 16)), fmaxf(rdlane(v, 32), rdlane(v, 48))); }
DEVI float quad_sum(float v) { v += dpp_mov<0xB1>(v); v += dpp_mov<0x4E>(v); return v; }
DEVI float quad_max(float v) { v = fmaxf(v, dpp_mov<0xB1>(v)); v = fmaxf(v, dpp_mov<0x4E>(v)); return v; }
DEVI float frcp(float x) { return __builtin_amdgcn_rcpf(x); }
DEVI float sigm(float x) { return frcp(1.f + __expf(-x)); }
DEVI float silu(float x) { return x * sigm(x); }
DEVI float flog(float x) { return __builtin_amdgcn_logf(x) * 0.6931471806f; }
DEVI float logsig(float x) { return fminf(x, 0.f) - flog(1.f + __expf(-fabsf(x))); }
DEVI float softplus(float x) { return fmaxf(x, 0.f) + flog(1.f + __expf(-fabsf(x))); }
DEVI float logsig_acc(float x) { return fminf(x, 0.f) - log1pf(expf(-fabsf(x))); }
DEVI float ftanh(float x) { const float e = __expf(-2.f * fabsf(x)); const float t = (1.f - e) * frcp(1.f + e); return x < 0.f ? -t : t; }
#define LDS_WAIT() asm volatile("s_waitcnt lgkmcnt(0)" ::: "memory")

DEVI int natcol(int p) { return (p & ~31) | (((p >> 2) & 3) << 3) | (((p >> 4) & 1) << 2) | (p & 3); }
DEVI int w1_src(int n) {
    const int pn = n >> 8, p = n & 255;
    if (pn < 9) { const int c = 256 * pn + natcol(p); return c < CZ ? c : -1; }
    if (pn < 13) return CZ + 256 * (pn - 9) + natcol(p);
    const int q = pn - 13, bj = p >> 7, wc = (p >> 5) & 3, n_ = (p >> 4) & 1, r16 = p & 15;
    return CG + (2 * bj + n_) * 1024 + 64 * q + 16 * wc + r16;
}

namespace g8 {
constexpr int BM = 256, BK = 64, HALF = 128, HTB = HALF * BK * 2;
DEVI int lds_byte(int r, int c) { const int st = (r >> 4) * 2 + (c >> 5), rr = r & 15, cc = c & 31, ob = rr * 64 + cc * 2; return st * 1024 + (ob ^ (((ob >> 9) & 1) << 5)); }
DEVI void stage_rc(int b, int& R, int& C) { const int st = b / 1024, sb = b % 1024, swz = sb ^ (((sb >> 9) & 1) << 5); R = (st >> 1) * 16 + swz / 64; C = (st & 1) * 32 + (swz % 64) / 2; }
struct Unit { const char* a; const char* b; int pm, pn; };
DEVI void tile_of(int L, int nM, int nN, int& pm, int& pn) {
    const int nwg = nM * nN; int wgid = L;
    { const int q = nwg / 8, r = nwg % 8, xcd = wgid % 8, off = wgid / 8; wgid = (xcd < r ? xcd * (q + 1) : r * (q + 1) + (xcd - r) * q) + off; }
    const int nig = 8 * nN, gid = wgid / nig, fm = gid * 8, gsz = (nM - fm) < 8 ? (nM - fm) : 8;
    pm = fm + ((wgid % nig) % gsz); pn = (wgid % nig) / gsz;
}

template <class Sched, class Epi>
DEVI void gemm_phase(LAS unsigned char* lds, const int lda, const int ldb, const int K, const Sched& S, const Epi& E) {
    const int tid = tidx(), wid = __builtin_amdgcn_readfirstlane(tid >> 6), lane = tid & 63, wr = wid >> 2, wc = wid & 3, fr = lane & 15, fq = lane >> 4;
    const int nt = K / BK;
    unsigned voffA[2], voffB[2];
#pragma unroll
    for (int i = 0; i < 2; ++i) { int R, C; stage_rc(tid * 16 + i * 8192, R, C); voffA[i] = (unsigned)(R * lda + C * 2); voffB[i] = (unsigned)(R * ldb + C * 2); }
    const size_t kstep = (size_t)(BK * 2);
    const size_t hstepA = (size_t)HALF * lda, hstepB = (size_t)HALF * ldb;
    const unsigned ldsw = (unsigned)wid * 1024u;
    const int aoff = lds_byte(wr * 64 + fr, fq * 8), boff = lds_byte(wc * 32 + fr, fq * 8);
#define G8_SA(b, h) (((b) * 2 + (h)) * HTB)
#define G8_SB(b, h) ((4 + (b) * 2 + (h)) * HTB)
#define G8_STAGE(bufoff, gbase, voff) do { _Pragma("unroll") for (int _i = 0; _i < 2; ++_i) \
        __builtin_amdgcn_global_load_lds((const unsigned*)((const char*)(gbase) + (voff)[_i]), (LAS unsigned*)(lds + (bufoff) + ldsw + _i * 8192), 16, 0, 0); } while (0)
#define G8_LDA(dst, b, h) do { _Pragma("unroll") for (int m = 0; m < 4; ++m) _Pragma("unroll") for (int k = 0; k < 2; ++k) dst[m][k] = *(const LAS bf16x8*)(lds + G8_SA(b, h) + aoff + m * 2048 + k * 1024); } while (0)
#define G8_LDB(dst, b, h) do { _Pragma("unroll") for (int n = 0; n < 2; ++n) _Pragma("unroll") for (int k = 0; k < 2; ++k) dst[n][k] = *(const LAS bf16x8*)(lds + G8_SB(b, h) + boff + n * 2048 + k * 1024); } while (0)
#define G8_MMA(ai, bj, At, Bt) do { __builtin_amdgcn_s_setprio(1); _Pragma("unroll") for (int m = 0; m < 4; ++m) _Pragma("unroll") for (int n = 0; n < 2; ++n) _Pragma("unroll") for (int k = 0; k < 2; ++k) \
        acc[ai][bj][m][n] = __builtin_amdgcn_mfma_f32_16x16x32_bf16(Bt[n][k], At[m][k], acc[ai][bj][m][n], 0, 0, 0); __builtin_amdgcn_s_setprio(0); } while (0)
#define G8_WAIT_V(n) asm volatile("s_waitcnt vmcnt(" #n ")" ::: "memory")
#define G8_WAIT_L(n) asm volatile("s_waitcnt lgkmcnt(" #n ")" ::: "memory")
#define G8_BAR __builtin_amdgcn_s_barrier()
#define G8_SCHED __builtin_amdgcn_sched_barrier(0)
    Unit cur, nxt; int ui = 0;
    if (!S.next(0, cur)) return;
    f32x4 acc[2][2][4][2];
#pragma unroll
    for (int a = 0; a < 2; ++a)
#pragma unroll
        for (int b = 0; b < 2; ++b)
#pragma unroll
            for (int m = 0; m < 4; ++m)
#pragma unroll
                for (int n = 0; n < 2; ++n) acc[a][b][m][n] = (f32x4){0.f, 0.f, 0.f, 0.f};
    bf16x8 At[4][2], B0[2][2], B1[2][2];
    const char* cA = cur.a; const char* cB = cur.b;
    G8_STAGE(G8_SB(0, 0), cB, voffB); G8_STAGE(G8_SA(0, 0), cA, voffA); G8_STAGE(G8_SB(0, 1), cB + hstepB, voffB); G8_STAGE(G8_SA(0, 1), cA + hstepA, voffA);
    if (wr == 1) G8_BAR;
    G8_WAIT_V(4); G8_BAR;
    G8_STAGE(G8_SB(1, 0), cB + kstep, voffB); G8_STAGE(G8_SA(1, 0), cA + kstep, voffA); G8_STAGE(G8_SB(1, 1), cB + hstepB + kstep, voffB);
    G8_WAIT_V(6); G8_BAR;
    for (;;) {
        const bool has_next = S.next(ui + 1, nxt);
        const char* nA = has_next ? nxt.a : cA; const char* nB = has_next ? nxt.b : cB;
        const bool full = cur.pm != 64;
#pragma nounroll
        for (int t = 0; t < nt; t += 2) {
            const bool last = (t == nt - 2);
            const char* a1 = cA + (size_t)(t + 1) * kstep;
            const char* a2 = last ? nA : cA + (size_t)(t + 2) * kstep; const char* b2 = last ? nB : cB + (size_t)(t + 2) * kstep;
            const char* a3 = a2 + kstep; const char* b3 = b2 + kstep;
            G8_LDB(B0, 0, 0); G8_SCHED; G8_LDA(At, 0, 0); G8_STAGE(G8_SA(1, 1), a1 + hstepA, voffA);
            G8_WAIT_L(8); G8_BAR; G8_WAIT_L(0); G8_MMA(0, 0, At, B0); G8_BAR; G8_SCHED;
            G8_LDB(B1, 0, 1); G8_STAGE(G8_SB(0, 0), b2, voffB);
            G8_BAR; G8_WAIT_L(0); G8_MMA(0, 1, At, B1); G8_BAR;
            G8_LDA(At, 0, 1); G8_STAGE(G8_SA(0, 0), a2, voffA);
            G8_BAR; G8_WAIT_L(0); G8_MMA(1, 0, At, B0); G8_BAR; G8_SCHED;
            G8_STAGE(G8_SB(0, 1), b2 + hstepB, voffB);
            G8_WAIT_V(6); G8_BAR; G8_MMA(1, 1, At, B1); G8_BAR;
            G8_LDB(B0, 1, 0); G8_SCHED; G8_LDA(At, 1, 0); G8_STAGE(G8_SA(0, 1), a2 + hstepA, voffA);
            G8_WAIT_L(8); G8_BAR; G8_WAIT_L(0); G8_MMA(0, 0, At, B0); G8_BAR; G8_SCHED;
            G8_LDB(B1, 1, 1); G8_STAGE(G8_SB(1, 0), b3, voffB);
            G8_BAR; G8_WAIT_L(0); G8_MMA(0, 1, At, B1); G8_BAR;
            G8_LDA(At, 1, 1); G8_STAGE(G8_SA(1, 0), a3, voffA);
            G8_BAR; G8_WAIT_L(0); G8_MMA(1, 0, At, B0); G8_BAR; G8_SCHED;
            G8_STAGE(G8_SB(1, 1), b3 + hstepB, voffB);
            G8_WAIT_V(6); G8_BAR; G8_MMA(1, 1, At, B1); G8_BAR;
        }
        E(acc, cur, wr, wc, fr, fq);
        if (!has_next) break;
#pragma unroll
        for (int a = 0; a < 2; ++a)
#pragma unroll
            for (int b = 0; b < 2; ++b)
#pragma unroll
                for (int m = 0; m < 4; ++m)
#pragma unroll
                    for (int n = 0; n < 2; ++n) acc[a][b][m][n] = (f32x4){0.f, 0.f, 0.f, 0.f};
        cur = nxt; cA = nA; cB = nB; ++ui;
    }
    G8_WAIT_V(0);
    if (wr == 0) G8_BAR;
    G8_BAR;
}
}
using g8::Unit;
typedef f32x4 AccT[2][2][4][2];

struct SchedG1 { const char* A; const char* B; int G, c;
    DEVI bool next(int i, Unit& u) const { const int L = i * G + c; if (L >= 65 * 13) return false; g8::tile_of(L, 65, 13, u.pm, u.pn);
        u.a = A + (size_t)u.pm * 256 * 2048; u.b = B + (size_t)u.pn * 256 * 2048; return true; } };
struct SchedBr { const char* A; const char* B; int G, c;
    DEVI bool next(int i, Unit& u) const { const int L = i * G + c; if (L >= 64 * 16) return false; g8::tile_of(L, 64, 16, u.pm, u.pn);
        const int b = u.pn >> 2, p4 = u.pn & 3; u.a = A + (size_t)u.pm * 256 * 2048 + b * 512; u.b = B + (size_t)b * (1024 * 512) + (size_t)p4 * 256 * 512; return true; } };
struct SchedGate { const char* A; const char* B; int G, c;
    DEVI bool next(int i, Unit& u) const { const int L = i * G + c; if (L >= 64 * 16) return false; g8::tile_of(L, 64, 16, u.pm, u.pn);
        u.a = A + (size_t)u.pm * 256 * 2048; u.b = B + (size_t)(3328 + 256 * u.pn) * 2048; return true; } };
struct SchedOut { const char* A; const char* B; int G, c;
    DEVI bool next(int i, Unit& u) const { const int L = i * G + c; if (L >= 64 * 4) return false; g8::tile_of(L, 64, 4, u.pm, u.pn);
        u.a = A + (size_t)u.pm * 256 * 2048; u.b = B + (size_t)u.pn * 256 * 2048; return true; } };

struct EpiG1 { bf16_t* PA; bf16_t* ZY; const float* ssq;
    DEVI void operator()(const AccT& acc, const Unit& u, int wr, int wc, int fr, int fq) const {
        bf16_t* base; int ld, pnl; if (u.pn < 9) { base = PA; ld = PALD; pnl = u.pn; } else { base = ZY; ld = 1024; pnl = u.pn - 9; }
        float sq[2][4];
#pragma unroll
        for (int ai = 0; ai < 2; ++ai)
#pragma unroll
            for (int m = 0; m < 4; ++m) sq[ai][m] = ssq[256 * u.pm + 128 * ai + 64 * wr + 16 * m + fr];
#pragma unroll
        for (int ai = 0; ai < 2; ++ai)
#pragma unroll
            for (int m = 0; m < 4; ++m) {
                const int r = 256 * u.pm + 128 * ai + 64 * wr + 16 * m + fr;
                const float rs = rsqrtf(sq[ai][m] * (1.f / 1024.f) + 1e-6f);
                bf16_t* rowp = base + (size_t)r * ld + 256 * pnl + 32 * wc + 8 * fq;
#pragma unroll
                for (int bj = 0; bj < 2; ++bj) { const f32x4 v0 = acc[ai][bj][m][0] * rs, v1 = acc[ai][bj][m][1] * rs;
                    u32x4 w; w.x = pk2(v0[0], v0[1]); w.y = pk2(v0[2], v0[3]); w.z = pk2(v1[0], v1[1]); w.w = pk2(v1[2], v1[3]);
                    *(u32x4*)(rowp + 128 * bj) = w; }
            }
    } };
struct EpiBr { bf16_t* BR;
    DEVI void operator()(const AccT& acc, const Unit& u, int wr, int wc, int fr, int fq) const {
        const int b = u.pn >> 2, p4 = u.pn & 3;
#pragma unroll
        for (int ai = 0; ai < 2; ++ai)
#pragma unroll
            for (int m = 0; m < 4; ++m) {
                const int r = 256 * u.pm + 128 * ai + 64 * wr + 16 * m + fr;
                bf16_t* rowp = BR + (size_t)r * 4096 + b * 1024 + 256 * p4 + 32 * wc + 8 * fq;
#pragma unroll
                for (int bj = 0; bj < 2; ++bj) { const f32x4 v0 = acc[ai][bj][m][0], v1 = acc[ai][bj][m][1];
                    u32x4 w; w.x = pk2(v0[0], v0[1]); w.y = pk2(v0[2], v0[3]); w.z = pk2(v1[0], v1[1]); w.w = pk2(v1[2], v1[3]);
                    *(u32x4*)(rowp + 128 * bj) = w; }
            }
    } };
struct EpiGate { const bf16_t* BR; const float* ssq; bf16_t* ZY;
    DEVI void operator()(const AccT& acc, const Unit& u, int wr, int wc, int fr, int fq) const {
        const int c = 64 * u.pn + 16 * wc + 4 * fq;
#pragma unroll
        for (int ai = 0; ai < 2; ++ai) {
            float sq[4]; u32x2 w[4][4];
#pragma unroll
            for (int m = 0; m < 4; ++m) { const int r = 256 * u.pm + 128 * ai + 64 * wr + 16 * m + fr; sq[m] = ssq[r]; const bf16_t* brr = BR + (size_t)r * 4096 + c;
#pragma unroll
                for (int b = 0; b < 4; ++b) w[m][b] = *(const u32x2*)(brr + b * 1024); }
#pragma unroll
            for (int m = 0; m < 4; ++m) {
                const int r = 256 * u.pm + 128 * ai + 64 * wr + 16 * m + fr;
                const float rs = rsqrtf(sq[m] * (1.f / 1024.f) + 1e-6f);
                float o0 = 0.f, o1 = 0.f, o2 = 0.f, o3 = 0.f;
#pragma unroll
                for (int bj = 0; bj < 2; ++bj)
#pragma unroll
                    for (int n = 0; n < 2; ++n) { const u32x2 ww = w[m][2 * bj + n]; const f32x4 g = acc[ai][bj][m][n];
                        o0 += sigm(g[0] * rs) * bflo(ww.x); o1 += sigm(g[1] * rs) * bfhi(ww.x); o2 += sigm(g[2] * rs) * bflo(ww.y); o3 += sigm(g[3] * rs) * bfhi(ww.y); }
                u32x2 o; o.x = pk2(o0, o1); o.y = pk2(o2, o3);
                *(u32x2*)(ZY + (size_t)r * 1024 + c) = o;
            }
        }
    } };
template <int LAYER, bool ATOM = true> struct EpiOut { const float* xp; const float* xs; bf16_t* XB; float* yout; float* ssq;
    DEVI void operator()(const AccT& acc, const Unit& u, int wr, int wc, int fr, int fq) const {
        const int col0 = 256 * u.pn + 32 * wc + 8 * fq;
#pragma unroll
        for (int ai = 0; ai < 2; ++ai) {
            if (256 * u.pm + 128 * ai >= ROWS) continue;
            f32x4 rf[4][2][2]; u32x4 rb[4][2];
#pragma unroll
            for (int m = 0; m < 4; ++m) { const int r = 256 * u.pm + 128 * ai + 64 * wr + 16 * m + fr;
#pragma unroll
                for (int bj = 0; bj < 2; ++bj) { const int col = col0 + 128 * bj;
                    if (LAYER == 0) { const float* xr = (r < NTOK ? xp + (size_t)r * 1024 : xs + (size_t)(r - NTOK) * 1024) + col; rf[m][bj][0] = *(const f32x4*)xr; rf[m][bj][1] = *(const f32x4*)(xr + 4); }
                    else rb[m][bj] = *(const u32x4*)(XB + (size_t)r * 1024 + col); } }
            float part[4];
#pragma unroll
            for (int m = 0; m < 4; ++m) {
                const int r = 256 * u.pm + 128 * ai + 64 * wr + 16 * m + fr;
                float ps = 0.f;
#pragma unroll
                for (int bj = 0; bj < 2; ++bj) { const int col = col0 + 128 * bj; f32x4 v0 = acc[ai][bj][m][0], v1 = acc[ai][bj][m][1];
                    if (LAYER == 0) { v0 += rf[m][bj][0]; v1 += rf[m][bj][1];
                        u32x4 w; w.x = pk2(v0[0], v0[1]); w.y = pk2(v0[2], v0[3]); w.z = pk2(v1[0], v1[1]); w.w = pk2(v1[2], v1[3]);
                        *(u32x4*)(XB + (size_t)r * 1024 + col) = w;
                    } else { const u32x4 w = rb[m][bj];
                        v0[0] += bflo(w.x); v0[1] += bfhi(w.x); v0[2] += bflo(w.y); v0[3] += bfhi(w.y); v1[0] += bflo(w.z); v1[1] += bfhi(w.z); v1[2] += bflo(w.w); v1[3] += bfhi(w.w);
                        *(f32x4*)(yout + (size_t)r * 1024 + col) = v0; *(f32x4*)(yout + (size_t)r * 1024 + col + 4) = v1; }
                    ps += v0[0] * v0[0] + v0[1] * v0[1] + v0[2] * v0[2] + v0[3] * v0[3] + v1[0] * v1[0] + v1[1] * v1[1] + v1[2] * v1[2] + v1[3] * v1[3]; }
                part[m] = ps;
            }
#pragma unroll
            for (int m = 0; m < 4; ++m) { const int r = 256 * u.pm + 128 * ai + 64 * wr + 16 * m + fr; float p = part[m]; p += __shfl_xor(p, 16); p += __shfl_xor(p, 32); if (ATOM && fq == 0) atomicAdd(ssq + r, p); }
        }
    } };

DEVI void transpose_item(const float* W, int ldw, const float* gain, int kind, bf16_t* WT, int K, int n0, int k0, float* scr, int lane) {
    const int nl = lane & 31, n = n0 + nl;
    const int sc = (kind == 0) ? w1_src(n) : ((n & ~255) + natcol(n & 255));
    float tw[32], tg[32];
#pragma unroll
    for (int i = 0; i < 32; ++i) { const int kk = 2 * i + (lane >> 5); tw[i] = (sc >= 0) ? W[(size_t)(k0 + kk) * ldw + sc] : 0.f; tg[i] = gain ? gain[k0 + kk] : 1.f; }
#pragma unroll
    for (int i = 0; i < 32; ++i) { const int kk = 2 * i + (lane >> 5); scr[kk * 33 + nl] = tw[i] * tg[i]; }
    LDS_WAIT();
    const int c = lane & 7;
#pragma unroll
    for (int j = 0; j < 4; ++j) { const int nn = (lane >> 3) + 8 * j; const float* s = scr + (8 * c) * 33 + nn;
        u32x4 o; o.x = pk2(s[0], s[33]); o.y = pk2(s[66], s[99]); o.z = pk2(s[132], s[165]); o.w = pk2(s[198], s[231]);
        *(u32x4*)(WT + (size_t)(n0 + nn) * K + k0 + 8 * c) = o; }
    LDS_WAIT();
}
DEVI void weight_item_one(const Params& P, int it, float* scr, int lane) {
    bf16_t* W1T = (bf16_t*)(P.ws + OFF_W1T); bf16_t* WBR = (bf16_t*)(P.ws + OFF_WBR); bf16_t* WOUT = (bf16_t*)(P.ws + OFF_WOUT);
    constexpr int I1 = 2 * 232 * 16, I2 = 8 * 32 * 4;
    int r = it;
    if (r < I1) { const int l = r / 3712, q = r % 3712, nb = q >> 4, kb = q & 15;
        transpose_item(P.in[I_WIN] + (size_t)l * 1024 * INC, INC, P.in[I_NG] + l * 1024, 0, W1T + (size_t)l * 7424 * 1024, 1024, nb * 32, kb * 64, scr, lane); return; }
    r -= I1;
    if (r < I2) { const int lb = r >> 7, q = r & 127, nb = q >> 2, kb = q & 3;
        transpose_item(P.in[I_WBR] + (size_t)lb * 256 * 1024, 1024, nullptr, 1, WBR + (size_t)lb * 1024 * 256, 256, nb * 32, kb * 64, scr, lane); return; }
    r -= I2;
    { const int l = r >> 9, q = r & 511, nb = q >> 4, kb = q & 15;
        transpose_item(P.in[I_WOUT] + (size_t)l * 1024 * 1024, 1024, nullptr, 2, WOUT + (size_t)l * 1024 * 1024, 1024, nb * 32, kb * 64, scr, lane); }
}
constexpr int WI_LAYER = 3712 + 512 + 512;
DEVI int layer_item(int layer, int j) { return j < 3712 ? layer * 3712 + j : (j < 4224 ? 7424 + layer * 512 + (j - 3712) : 8448 + layer * 512 + (j - 4224)); }
DEVI void weight_items(const Params& P, unsigned char* smem, int mode, int gw, int NGW) {
    const int tid = tidx(), wave = tid >> 6, lane = tid & 63;
    float* scr = (float*)(smem + wave * 16384);
    const int n = mode ? WI_LAYER : 2 * WI_LAYER;
    for (int j = gw; j < n; j += NGW) weight_item_one(P, j < WI_LAYER ? layer_item(0, j) : layer_item(1, j - WI_LAYER), scr, lane);
}
constexpr int WI_EARLY = 104 * 16, WI_ALL = 2 * 232 * 16 + 8 * 32 * 4 + 2 * 32 * 16;
DEVI void phase_p0(const Params& P, unsigned char* smem) {
    const int tid = tidx(), wave = tid >> 6, lane = tid & 63;
    const int gw = blockIdx.x * 8 + wave, NGW = gridDim.x * 8;
    weight_items(P, smem, gridDim.x >= 256 ? 1 : 0, gw, NGW);
    { bf16_t* WLT = (bf16_t*)(P.ws + OFF_WLT);
      for (int i = blockIdx.x * 512 + tid; i < 65536; i += gridDim.x * 512) { const int l = i >> 15, g = (i >> 14) & 1, n = (i >> 12) & 3, dd = (i >> 6) & 63, cc = i & 63;
          WLT[i] = f2bf(P.in[g ? I_WX : I_WA][((l * 4 + n) * 64 + cc) * 64 + dd]); } }
    bf16_t* XB = (bf16_t*)(P.ws + OFF_XB); float* ssq = (float*)(P.ws + OFF_SSQ);
    for (int row = gw; row < MPAD; row += NGW) {
        f32x4 v[4]; float s = 0.f;
        if (row < ROWS) { const f32x4* xr = (const f32x4*)(row < NTOK ? P.in[I_XP] + (size_t)row * 1024 : P.in[I_XS] + (size_t)(row - NTOK) * 1024) + lane;
#pragma unroll
            for (int j = 0; j < 4; ++j) { v[j] = xr[64 * j]; s += v[j][0] * v[j][0] + v[j][1] * v[j][1] + v[j][2] * v[j][2] + v[j][3] * v[j][3]; }
        } else {
#pragma unroll
            for (int j = 0; j < 4; ++j) v[j] = (f32x4){0.f, 0.f, 0.f, 0.f};
        }
        s = wave_sum(s);
        u32x2* o = (u32x2*)(XB + (size_t)row * 1024) + lane;
#pragma unroll
        for (int j = 0; j < 4; ++j) { u32x2 w; w.x = pk2(v[j][0], v[j][1]); w.y = pk2(v[j][2], v[j][3]); o[64 * j] = w; }
        if (lane == 0) { ssq[row] = s; ssq[MPAD + row] = 0.f; ssq[2 * MPAD + row] = 0.f; }
    }
}

DEVI void rwkv_prep(const Params& P, int l, int item) {
    const int tid = tidx(), wave = tid >> 6, lane = tid & 63, slot = wave >> 2, h = wave & 3, c = h * 64 + lane;
    const bf16_t* PA = (const bf16_t*)(P.ws + OFF_PA); bf16_t* RWP = (bf16_t*)(P.ws + OFF_RWP); float* RWC = (float*)(P.ws + OFF_RWC);
    const bool samp = item >= 1024; const int row0 = samp ? NTOK + (item - 1024) * 4 : item * 16, nit = samp ? 2 : 8;
    const float* mu = P.in[I_MU] + l * 832;
    float wup[32], aup[32];
#pragma unroll
    for (int j = 0; j < 32; ++j) { wup[j] = P.in[I_WUP][(l * 32 + j) * 256 + c]; aup[j] = P.in[I_AUP][(l * 32 + j) * 256 + c]; }
    const float w0 = P.in[I_W0][l * 256 + c], a0 = P.in[I_A0][l * 256 + c], kkw = P.in[I_KK][l * 256 + c], kaw = P.in[I_KA][l * 256 + c], rkw = P.in[I_RK][l * 256 + c];
    const float mur = mu[c], muk = mu[256 + c], muv = mu[512 + c], mul = mu[768 + lane];
    float aur[8], auk[8], auv[8], aul[8], apr[8], apk[8], apv[8], apl[8];
#pragma unroll
    for (int it = 0; it < 8; ++it) { const int row = row0 + 2 * (it < nit ? it : 0) + slot; const bf16_t* up = PA + (size_t)row * PALD;
        if (samp) { const float* sp = P.in[I_SSHIFT] + (size_t)(l * 128 + (row - NTOK)) * 832; apr[it] = sp[c]; apk[it] = sp[256 + c]; apv[it] = sp[512 + c]; apl[it] = sp[768 + lane]; }
        else if ((row & 2047) == 0) { apr[it] = apk[it] = apv[it] = apl[it] = 0.f; }
        else { const bf16_t* pp = up - PALD; apr[it] = bf2f(pp[c]); apk[it] = bf2f(pp[256 + c]); apv[it] = bf2f(pp[512 + c]); apl[it] = bf2f(pp[768 + lane]); }
        aur[it] = bf2f(up[c]); auk[it] = bf2f(up[256 + c]); auv[it] = bf2f(up[512 + c]); aul[it] = bf2f(up[768 + lane]); }
#pragma unroll
    for (int it = 0; it < 8; ++it) {
        if (it >= nit) break;
        const int row = row0 + 2 * it + slot;
        const float ur = aur[it], uk = auk[it], uv = auv[it], ul = aul[it], pr = apr[it], pk = apk[it], pv = apv[it], pl = apl[it];
        const float r = ur + (pr - ur) * mur, k = uk + (pk - uk) * muk, v = uv + (pv - uv) * muv;
        float lo = ul + (pl - ul) * mul;
        const float lt = lane < 32 ? ftanh(lo) : lo;
        float wpre = w0, apre = a0;
#pragma unroll
        for (int j = 0; j < 32; ++j) { wpre += rdlane(lt, j) * wup[j]; apre += rdlane(lt, 32 + j) * aup[j]; }
        const float w = -softplus(-wpre) - 0.5f, lw = __expf(w);
        const float a = sigm(apre);
        const float kkr = k * kkw; const float kk = kkr * __builtin_amdgcn_rsqf(fmaxf(wave_sum(kkr * kkr), 1e-24f));
        const float kp = k * (1.f + (a - 1.f) * kaw), ka = kk * a;
        const float kaq = bf2f(f2bf(ka)), kpq = bf2f(f2bf(kp)), rq = bf2f(f2bf(r));
        const float c1 = wave_sum(kaq * rq), c2 = wave_sum(kpq * rq), c3 = wave_sum(r * kp * rkw);
        bf16_t* o = RWP + (size_t)row * 1536 + c;
        o[0] = f2bf(lw); o[256] = f2bf(kk); o[512] = f2bf(ka); o[768] = f2bf(kp); o[1024] = f2bf(r); o[1280] = f2bf(v);
        if (lane == 0) { float* cc = RWC + (size_t)row * 16 + h * 4; cc[0] = c1; cc[1] = c2; cc[2] = c3; }
    }
    if (samp) { for (int i = tid; i < 4 * 832; i += 512) { const int rr = i / 832, cc = i % 832; const int b = row0 - NTOK + rr; P.out[O_SHS + (size_t)(l * 128 + b) * 832 + cc] = bf2f(PA[(size_t)(row0 + rr) * PALD + cc]); } }
    else if (((row0 + 16) & 2047) == 0) { const int b = row0 >> 11; for (int i = tid; i < 832; i += 512) P.out[O_SHP + (size_t)(l * 8 + b) * 832 + i] = bf2f(PA[(size_t)(row0 + 15) * PALD + i]); }
}
DEVI void cache_copy(const Params& P, int l, int b) {
    const bf16_t* PA = (const bf16_t*)(P.ws + OFF_PA);
    for (int i = tidx(); i < 128 * 128; i += 512) { const int j = i >> 7, c = i & 127; const bf16_t* rp = PA + (size_t)(b * 2048 + 1920 + j) * PALD + CC + 256 + c;
        P.out[O_KP + (size_t)((l * 8 + b) * 128 + j) * 128 + c] = bf2f(rp[0]); P.out[O_VP + (size_t)((l * 8 + b) * 128 + j) * 128 + c] = bf2f(rp[128]); }
}
DEVI void lru_prep(const Params& P, int l, int item, float* sm) {
    const int tid = tidx(), b = item >> 6, ck = item & 63, t0 = ck * 32;
    const bf16_t* PA = (const bf16_t*)(P.ws + OFF_PA);
    float* xs = sm; float* xc = sm + 35 * 256;
    __syncthreads();
    { bf16_t tx[18];
#pragma unroll
      for (int k = 0; k < 18; ++k) { const int i = tid + 512 * k, tt = i >> 8, ch = i & 255, tk = t0 - 3 + tt; tx[k] = (i < 35 * 256 && tk >= 0) ? PA[(size_t)(b * 2048 + tk) * PALD + CD + ch] : (bf16_t)0; }
#pragma unroll
      for (int k = 0; k < 18; ++k) { const int i = tid + 512 * k; if (i < 35 * 256) xs[i] = bf2f(tx[k]); } }
    __syncthreads();
    const int d = tid & 255, half = tid >> 8;
    { const float cb = P.in[I_CBI][l * 256 + d], c0 = P.in[I_CW][(l * 4 + 0) * 256 + d], c1 = P.in[I_CW][(l * 4 + 1) * 256 + d], c2 = P.in[I_CW][(l * 4 + 2) * 256 + d], c3 = P.in[I_CW][(l * 4 + 3) * 256 + d];
        for (int t = half; t < 32; t += 2) xc[t * 256 + d] = cb + c0 * xs[t * 256 + d] + c1 * xs[(t + 1) * 256 + d] + c2 * xs[(t + 2) * 256 + d] + c3 * xs[(t + 3) * 256 + d]; }
    __syncthreads();
    const int n = d >> 6, dl = d & 63;
    if (ck == 63) for (int i = tid; i < 768; i += 512) P.out[O_CVP + (size_t)(l * 8 + b) * 768 + i] = xs[32 * 256 + i];
    __syncthreads();
    {
        const int wave = tid >> 6, lane = tid & 63, wn = wave & 3, gate = wave >> 2, lr = lane & 15, lq = lane >> 4;
        float* gp = gate ? (sm + 67 * 256) : xs;
        const bf16_t* WL = (const bf16_t*)(P.ws + OFF_WLT) + (size_t)((l * 2 + gate) * 4 + wn) * 4096;
        bf16x8 bfr[4][2]; float bsv[4];
#pragma unroll
        for (int dt = 0; dt < 4; ++dt) { bsv[dt] = P.in[gate ? I_BX : I_BA][l * 256 + 64 * wn + 16 * dt + lr];
#pragma unroll
            for (int ks2 = 0; ks2 < 2; ++ks2) bfr[dt][ks2] = *(const bf16x8*)(WL + (16 * dt + lr) * 64 + 32 * ks2 + 8 * lq); }
#pragma unroll
        for (int tt = 0; tt < 2; ++tt) {
            bf16x8 afr[2];
#pragma unroll
            for (int ks2 = 0; ks2 < 2; ++ks2) { const float* xr = xc + (16 * tt + lr) * 256 + 64 * wn + 32 * ks2 + 8 * lq; const f32x4 x0 = *(const f32x4*)xr, x1 = *(const f32x4*)(xr + 4);
                u32x4 pk; pk.x = pk2(x0[0], x0[1]); pk.y = pk2(x0[2], x0[3]); pk.z = pk2(x1[0], x1[1]); pk.w = pk2(x1[2], x1[3]); afr[ks2] = __builtin_bit_cast(bf16x8, pk); }
#pragma unroll
            for (int dt = 0; dt < 4; ++dt) { f32x4 acc = {0.f, 0.f, 0.f, 0.f};
                acc = __builtin_amdgcn_mfma_f32_16x16x32_bf16(afr[0], bfr[dt][0], acc, 0, 0, 0); acc = __builtin_amdgcn_mfma_f32_16x16x32_bf16(afr[1], bfr[dt][1], acc, 0, 0, 0);
#pragma unroll
                for (int g = 0; g < 4; ++g) gp[(16 * tt + 4 * lq + g) * 256 + 64 * wn + 16 * dt + lr] = acc[g] + bsv[dt]; }
        }
    }
    __syncthreads();
    const float lsl = 8.f * logsig_acc(P.in[I_LAM][l * 256 + d]);
    float* LH = P.out + SO_LH; float* LP = P.out + SO_LP; float* LA = P.out + SO_LA; float* LB = P.out + SO_LB;
    const float* gr = xs; const float* gi = sm + 67 * 256;
    float hh = 0.f, pp = 1.f;
#pragma nounroll
    for (int tt = 0; tt < 16; ++tt) {
        const int t = half * 16 + tt;
        const float la = lsl * sigm(gr[t * 256 + d]), a = __expf(la), bt = __builtin_amdgcn_sqrtf(fmaxf(1.f - a * a, 0.f)) * sigm(gi[t * 256 + d]) * xc[t * 256 + d];
        hh = a * hh + bt; pp *= a;
        const size_t row = (size_t)b * 2048 + t0 + t; LH[row * 256 + d] = hh; LP[row * 256 + d] = pp;
    }
    const int sub = ck * 2 + half; LA[(size_t)(b * 128 + sub) * 256 + d] = pp; LB[(size_t)(b * 128 + sub) * 256 + d] = hh;
}
DEVI void gla_load_cum(const Params& P, int l, int h, int row0, float* gs, float* gl, float* seg) {
    const int tid = tidx(); const bf16_t* PA = (const bf16_t*)(P.ws + OFF_PA);
    { bf16_t t0 = PA[(size_t)(row0 + (tid >> 4)) * PALD + CB + 512 + (tid & 15)], t1 = PA[(size_t)(row0 + 32 + (tid >> 4)) * PALD + CB + 512 + (tid & 15)]; gl[tid] = bf2f(t0); gl[tid + 512] = bf2f(t1); }
    __syncthreads();
    const int d = tid & 31, sg = tid >> 5;
    float upc[16];
#pragma unroll
    for (int j = 0; j < 16; ++j) upc[j] = P.in[I_GUP][(l * 16 + j) * 128 + h * 32 + d];
    const float bias = P.in[I_GB][l * 128 + h * 32 + d];
    float run = 0.f, gv[4];
#pragma unroll
    for (int tt = 0; tt < 4; ++tt) { const int t = sg * 4 + tt; float x = bias;
#pragma unroll
        for (int j = 0; j < 16; ++j) x += gl[t * 16 + j] * upc[j];
        run += logsig(x) * (1.f / 16.f); gv[tt] = run; }
    seg[sg * 32 + d] = run;
    __syncthreads();
    float pre = 0.f; for (int s2 = 0; s2 < sg; ++s2) pre += seg[s2 * 32 + d];
#pragma unroll
    for (int tt = 0; tt < 4; ++tt) gs[(sg * 4 + tt) * 32 + d] = gv[tt] + pre;
    __syncthreads();
}
DEVI void gla_prep(const Params& P, int l, int item, float* sm) {
    const int tid = tidx(), c = item & 31, h = (item >> 5) & 3, b = item >> 7, row0 = b * 2048 + c * 64;
    const bf16_t* PA = (const bf16_t*)(P.ws + OFF_PA);
    float* gs = sm; float* ks = sm + 2048; float* vs = sm + 4096; float* gl = sm + 8192; float* seg = sm + 9216;
    __syncthreads();
    { bf16_t tk[4], tv[8];
#pragma unroll
      for (int k = 0; k < 4; ++k) { const int i = tid + 512 * k, t = i >> 5, d = i & 31; tk[k] = PA[(size_t)(row0 + t) * PALD + CB + 128 + h * 32 + d]; }
#pragma unroll
      for (int k = 0; k < 8; ++k) { const int i = tid + 512 * k, t = i >> 6, e = i & 63; tv[k] = PA[(size_t)(row0 + t) * PALD + CB + 256 + h * 64 + e]; }
#pragma unroll
      for (int k = 0; k < 4; ++k) ks[tid + 512 * k] = bf2f(tk[k]);
#pragma unroll
      for (int k = 0; k < 8; ++k) vs[tid + 512 * k] = bf2f(tv[k]); }
    gla_load_cum(P, l, h, row0, gs, gl, seg);
    for (int i = tid; i < 2048; i += 512) { const int d = i & 31; ks[i] *= __expf(gs[63 * 32 + d] - gs[i]); }
    __syncthreads();
    { const int d = tid >> 4, e4 = (tid & 15) * 4; f32x4 u = {0.f, 0.f, 0.f, 0.f};
        for (int t = 0; t < 64; ++t) { const float kd = ks[t * 32 + d]; const f32x4 v4 = *(const f32x4*)(vs + t * 64 + e4); u += v4 * kd; }
        *(f32x4*)(P.out + SO_GU + (size_t)item * 2048 + d * 64 + e4) = u; }
    if (tid < 32) P.out[SO_GD + (size_t)item * 32 + tid] = __expf(gs[63 * 32 + tid]);
}

DEVI void rwkv_scan_prompt(const Params& P, int l, int item, float* sm, int defer = -1) {
    const int b = item >> 4, h = (item >> 2) & 3, q = item & 3;
    const int tid = tidx(), wave = tid >> 6, lane = tid & 63;
    const bf16_t* RWP = (const bf16_t*)(P.ws + OFF_RWP); const float* RWC = (const float*)(P.ws + OFF_RWC); float* RWO = P.out + SO_RWO;
    constexpr int T = 32, BUF = 5 * T * 64 + T * 16 + T * 2;
    const size_t rbase = (size_t)b * 2048;
    float* buf0 = sm; float* buf1 = sm + BUF;
    auto load_chunk = [&](int c, float* buf) {
        const int lt = tid - 256, ch = lt & 63, tq = lt >> 6;
        bf16_t raw[8][5], rv[2]; float rc = 0.f;
#pragma unroll
        for (int i = 0; i < 8; ++i) { const int t = tq + 4 * i; const bf16_t* rp = RWP + (rbase + c * T + t) * 1536 + h * 64 + ch;
            raw[i][0] = rp[0]; raw[i][1] = rp[256]; raw[i][2] = rp[512]; raw[i][3] = rp[768]; raw[i][4] = rp[1024]; }
#pragma unroll
        for (int i = 0; i < 2; ++i) { const int t = (lt >> 4) + 16 * i, rr = lt & 15; rv[i] = RWP[(rbase + c * T + t) * 1536 + 1280 + h * 64 + 16 * q + rr]; }
        if (lt < 64) { const int t = lt >> 1, j = lt & 1; rc = RWC[(rbase + c * T + t) * 16 + h * 4 + j]; }
#pragma unroll
        for (int i = 0; i < 8; ++i) { const int t = tq + 4 * i;
            const float lw = bf2f(raw[i][0]), kk = bf2f(raw[i][1]), ka = bf2f(raw[i][2]), kp = bf2f(raw[i][3]), r = bf2f(raw[i][4]); const float dd = __expf(-lw);
            buf[t * 64 + ch] = dd; buf[T * 64 + t * 64 + ch] = dd * r; buf[2 * T * 64 + t * 64 + ch] = kk; buf[3 * T * 64 + t * 64 + ch] = ka; buf[4 * T * 64 + t * 64 + ch] = kp; }
#pragma unroll
        for (int i = 0; i < 2; ++i) { const int t = (lt >> 4) + 16 * i, rr = lt & 15; buf[5 * T * 64 + t * 16 + rr] = bf2f(rv[i]); }
        if (lt < 64) { const int t = lt >> 1, j = lt & 1; buf[5 * T * 64 + T * 16 + t * 2 + j] = rc; }
    };
    __syncthreads();
    if (tid >= 256) load_chunk(0, buf0);
    __syncthreads();
    const int rowgrp = lane >> 4, ks = lane & 15, vloc = 4 * wave + rowgrp, vrow = 16 * q + vloc;
    f32x4 S = {0.f, 0.f, 0.f, 0.f};
    for (int c = 0; c < SEQ / T; ++c) {
        float* cur = (c & 1) ? buf1 : buf0; float* nxt = (c & 1) ? buf0 : buf1;
        if (tid >= 256) { if (c + 1 < SEQ / T) load_chunk(c + 1, nxt);
            if (defer >= 0) { const int j = defer * 4 + (wave - 4) + 512 * c; if (j < WI_LAYER) weight_item_one(P, layer_item(1, j), sm + 2 * BUF + 64 + (wave - 4) * 2112, lane); } }
        else {
            const float* cb = cur + 4 * ks;
            f32x4 d4 = *(const f32x4*)(cb), dr4 = *(const f32x4*)(cb + T * 64), kk4 = *(const f32x4*)(cb + 2 * T * 64), ka4 = *(const f32x4*)(cb + 3 * T * 64), kp4 = *(const f32x4*)(cb + 4 * T * 64);
            float vv = cur[5 * T * 64 + vloc]; f32x2 cc = *(const f32x2*)(cur + 5 * T * 64 + T * 16);
            float* op = RWO + (rbase + (size_t)c * T) * 256 + h * 64 + vrow;
#pragma unroll 16
            for (int t = 0; t < T; ++t) {
                const float* nb = cb + (t + 1) * 64;
                const f32x4 nd4 = *(const f32x4*)(nb), ndr4 = *(const f32x4*)(nb + T * 64), nkk4 = *(const f32x4*)(nb + 2 * T * 64), nka4 = *(const f32x4*)(nb + 3 * T * 64), nkp4 = *(const f32x4*)(nb + 4 * T * 64);
                const float nvv = cur[5 * T * 64 + (t + 1) * 16 + vloc]; const f32x2 ncc = *(const f32x2*)(cur + 5 * T * 64 + T * 16 + (t + 1) * 2);
                const f32x2 t1 = S.lo * kk4.lo + S.hi * kk4.hi, t2 = S.lo * dr4.lo + S.hi * dr4.hi;
                float p1 = t1.x + t1.y, p2 = t2.x + t2.y;
                p1 = reduce16(p1); p2 = reduce16(p2);
                const float sa = -p1;
                S = S * d4 + ka4 * sa + kp4 * vv;
                op[t * 256] = p2 + sa * cc[0] + vv * cc[1];
                d4 = nd4; dr4 = ndr4; kk4 = nkk4; ka4 = nka4; kp4 = nkp4; vv = nvv; cc = ncc;
            }
        }
        __syncthreads();
    }
    if (tid < 256) *(f32x4*)(P.out + O_WKVP + ((size_t)((l * 8 + b) * 4 + h) * 64 + vrow) * 64 + 4 * ks) = S;
}
DEVI void rwkv_scan_sample(const Params& P, int l, int item) {
    const int tid = tidx(), wave = tid >> 6, lane = tid & 63, pair = item * 8 + wave, b = pair >> 2, h = pair & 3;
    const bf16_t* RWP = (const bf16_t*)(P.ws + OFF_RWP); const float* RWC = (const float*)(P.ws + OFF_RWC); float* RWO = P.out + SO_RWO;
    const size_t row = NTOK + b; const int rowgrp = lane >> 4, ks = lane & 15;
    const bf16_t* rp = RWP + row * 1536 + h * 64 + 4 * ks;
    f32x4 d4, dr4, kk4, ka4, kp4;
#pragma unroll
    for (int j = 0; j < 4; ++j) { const float lw = bf2f(rp[j]), r = bf2f(rp[1024 + j]); d4[j] = __expf(-lw); dr4[j] = d4[j] * r; kk4[j] = bf2f(rp[256 + j]); ka4[j] = bf2f(rp[512 + j]); kp4[j] = bf2f(rp[768 + j]); }
    const float c1 = RWC[row * 16 + h * 4], c2 = RWC[row * 16 + h * 4 + 1];
    const float* S0 = P.in[I_SWKV] + (size_t)((l * 128 + b) * 4 + h) * 4096; float* S1 = P.out + O_WKVS + (size_t)((l * 128 + b) * 4 + h) * 4096;
    f32x4 Sv[16]; bf16_t vr[16];
#pragma unroll
    for (int it = 0; it < 16; ++it) { const int vrow = 4 * it + rowgrp; Sv[it] = *(const f32x4*)(S0 + vrow * 64 + 4 * ks); vr[it] = RWP[row * 1536 + 1280 + h * 64 + vrow]; }
#pragma unroll
    for (int it = 0; it < 16; ++it) {
        const int vrow = 4 * it + rowgrp;
        f32x4 S = Sv[it];
        const float vv = bf2f(vr[it]);
        float p1 = (S[0] * kk4[0] + S[1] * kk4[1]) + (S[2] * kk4[2] + S[3] * kk4[3]);
        float p2 = (S[0] * dr4[0] + S[1] * dr4[1]) + (S[2] * dr4[2] + S[3] * dr4[3]);
        p1 = reduce16(p1); p2 = reduce16(p2);
        const float sa = -p1;
        S = S * d4 + ka4 * sa + kp4 * vv;
        *(f32x4*)(S1 + vrow * 64 + 4 * ks) = S;
        RWO[row * 256 + h * 64 + vrow] = p2 + sa * c1 + vv * c2;
    }
}
DEVI void gla_prefix(const Params& P, int l, int bh) {
    const int idx = tidx() * 4, d = idx >> 6;
    float* GU = P.out + SO_GU; const float* GD = P.out + SO_GD;
    f32x4 S = {0.f, 0.f, 0.f, 0.f};
#pragma nounroll
    for (int c0 = 0; c0 < 32; c0 += 8) {
        f32x4 U[8]; float dd[8];
#pragma unroll
        for (int c = 0; c < 8; ++c) { const size_t it = (size_t)bh * 32 + c0 + c; U[c] = *(const f32x4*)(GU + it * 2048 + idx); dd[c] = GD[it * 32 + d]; }
#pragma unroll
        for (int c = 0; c < 8; ++c) { const size_t it = (size_t)bh * 32 + c0 + c; *(f32x4*)(GU + it * 2048 + idx) = S; S = S * dd[c] + U[c]; }
    }
    *(f32x4*)(P.out + O_GLP + (size_t)(l * 32 + bh) * 2048 + idx) = S;
}
DEVI void lru_carry(const Params& P, int l, int b) {
    if (tidx() >= 256) return;
    const int d = tidx(); const float* LA = P.out + SO_LA; float* LB = P.out + SO_LB;
    float carry = 0.f;
#pragma nounroll
    for (int s0 = 0; s0 < 128; s0 += 32) {
        float A[32], Bv[32];
#pragma unroll
        for (int s = 0; s < 32; ++s) { const size_t o = (size_t)(b * 128 + s0 + s) * 256 + d; A[s] = LA[o]; Bv[s] = LB[o]; }
#pragma unroll
        for (int s = 0; s < 32; ++s) { const size_t o = (size_t)(b * 128 + s0 + s) * 256 + d; LB[o] = carry; carry = A[s] * carry + Bv[s]; }
    }
    P.out[O_HP + (size_t)(l * 8 + b) * 256 + d] = carry;
}
template <bool DRY = false> DEVI void swa_prompt(const Params& P, int l, int item, float* sm) {
    const bool dost = !DRY || (P.ws == nullptr);
    const int tid = tidx(), b = item >> 6, kv = (item >> 5) & 1, qb = item & 31, t0 = qb * 64;
    const bf16_t* PA = (const bf16_t*)(P.ws + OFF_PA); bf16_t* ZY = (bf16_t*)(P.ws + OFF_ZY);
    float* Ks = sm; float* Vs = sm + 192 * 68;
    __syncthreads();
    u32x4 kwa[3], vwa[3];
#pragma unroll
    for (int k = 0; k < 3; ++k) { const int i = tid + 512 * k, ls = i >> 3, c8 = (i & 7) * 8, s = t0 - 128 + ls; kwa[k] = (u32x4){0u, 0u, 0u, 0u}; vwa[k] = (u32x4){0u, 0u, 0u, 0u};
        if (s >= 0) { const bf16_t* rp = PA + (size_t)(b * 2048 + s) * PALD + CC + 256 + kv * 64 + c8; kwa[k] = *(const u32x4*)rp; vwa[k] = *(const u32x4*)(rp + 128); } }
#pragma unroll
    for (int k = 0; k < 3; ++k) { const int i = tid + 512 * k, ls = i >> 3, c8 = (i & 7) * 8; const u32x4 kw = kwa[k], vw = vwa[k];
        *(f32x4*)(Ks + ls * 68 + c8) = (f32x4){bflo(kw.x), bfhi(kw.x), bflo(kw.y), bfhi(kw.y)}; *(f32x4*)(Ks + ls * 68 + c8 + 4) = (f32x4){bflo(kw.z), bfhi(kw.z), bflo(kw.w), bfhi(kw.w)};
        *(f32x4*)(Vs + ls * 68 + c8) = (f32x4){bflo(vw.x), bfhi(vw.x), bflo(vw.y), bfhi(vw.y)}; *(f32x4*)(Vs + ls * 68 + c8 + 4) = (f32x4){bflo(vw.z), bfhi(vw.z), bflo(vw.w), bfhi(vw.w)}; }
    __syncthreads();
    const int rowid = tid >> 2, part = tid & 3, g = rowid & 1, qi = rowid >> 1, hh = kv * 2 + g, t = t0 + qi;
    const size_t row = (size_t)b * 2048 + t;
    f32x2 q2[8];
    { const u32x4* qp = (const u32x4*)(PA + row * PALD + CC + hh * 64 + 16 * part);
#pragma unroll
        for (int i = 0; i < 2; ++i) { const u32x4 w = qp[i]; q2[4 * i] = (f32x2){bflo(w.x), bfhi(w.x)} * 0.125f; q2[4 * i + 1] = (f32x2){bflo(w.y), bfhi(w.y)} * 0.125f;
            q2[4 * i + 2] = (f32x2){bflo(w.z), bfhi(w.z)} * 0.125f; q2[4 * i + 3] = (f32x2){bflo(w.w), bfhi(w.w)} * 0.125f; } }
    const float slope = exp2f(-2.f * (float)(hh + 1));
    float m = -1e30f, lsum = 0.f; f32x2 acc2[8];
#pragma unroll
    for (int i = 0; i < 8; ++i) acc2[i] = (f32x2){0.f, 0.f};
    const int j0 = (t < 128) ? (128 - t) : 0;
    for (int j = j0; j <= 128; ++j) {
        const float* kr = Ks + (qi + j) * 68 + 16 * part;
        f32x2 s2 = {0.f, 0.f};
#pragma unroll
        for (int i = 0; i < 4; ++i) { const f32x4 k4 = *(const f32x4*)(kr + 4 * i); s2 += q2[2 * i] * k4.lo; s2 += q2[2 * i + 1] * k4.hi; }
        const float sc = quad_sum(s2.x + s2.y) - slope * (float)(128 - j);
        if (sc > m) { const float corr = __expf(m - sc); lsum *= corr;
#pragma unroll
            for (int i = 0; i < 8; ++i) acc2[i] *= corr;
            m = sc; }
        const float p = __expf(sc - m); lsum += p;
        const float* vr = Vs + (qi + j) * 68 + 16 * part;
#pragma unroll
        for (int i = 0; i < 4; ++i) { const f32x4 v4 = *(const f32x4*)(vr + 4 * i); acc2[2 * i] += v4.lo * p; acc2[2 * i + 1] += v4.hi * p; }
    }
    float acc[16];
#pragma unroll
    for (int i = 0; i < 8; ++i) { acc[2 * i] = acc2[i].x; acc[2 * i + 1] = acc2[i].y; }
    const float sk = P.in[I_SINK][l * 4 + hh], mf = fmaxf(m, sk), e = __expf(m - mf), inv = e * frcp(lsum * e + __expf(sk - mf));
    bf16_t* zp = ZY + row * 1024 + 512 + hh * 64 + 16 * part;
    const u32x4 z0 = *(const u32x4*)zp, z1 = *(const u32x4*)(zp + 8);
    float o[16];
#pragma unroll
    for (int i = 0; i < 16; ++i) o[i] = acc[i] * inv;
    u32x4 w0, w1;
    w0.x = pk2(o[0] * silu(bflo(z0.x)), o[1] * silu(bfhi(z0.x))); w0.y = pk2(o[2] * silu(bflo(z0.y)), o[3] * silu(bfhi(z0.y)));
    w0.z = pk2(o[4] * silu(bflo(z0.z)), o[5] * silu(bfhi(z0.z))); w0.w = pk2(o[6] * silu(bflo(z0.w)), o[7] * silu(bfhi(z0.w)));
    w1.x = pk2(o[8] * silu(bflo(z1.x)), o[9] * silu(bfhi(z1.x))); w1.y = pk2(o[10] * silu(bflo(z1.y)), o[11] * silu(bfhi(z1.y)));
    w1.z = pk2(o[12] * silu(bflo(z1.z)), o[13] * silu(bfhi(z1.z))); w1.w = pk2(o[14] * silu(bflo(z1.w)), o[15] * silu(bfhi(z1.w)));
    if (dost) { *(u32x4*)zp = w0; *(u32x4*)(zp + 8) = w1; }
}
DEVI void swa_sample(const Params& P, int l, int b, float* sm) {
    const int tid = tidx(), wave = tid >> 6, lane = tid & 63; const size_t row = NTOK + b;
    const bf16_t* PA = (const bf16_t*)(P.ws + OFF_PA); bf16_t* ZY = (bf16_t*)(P.ws + OFF_ZY);
    float* qs = sm; float* kn = sm + 256; float* vn = sm + 384; float* sc = sm + 512;
    const float* CK = P.in[I_CK] + (size_t)(l * 128 + b) * 16384; const float* CV = P.in[I_CV] + (size_t)(l * 128 + b) * 16384;
    __syncthreads();
    { const float v = bf2f(PA[row * PALD + CC + tid]); if (tid < 256) qs[tid] = v * 0.125f; else if (tid < 384) kn[tid - 256] = v; else vn[tid - 384] = v; }
    __syncthreads();
    { const int hh = tid >> 7, s = tid & 127, kv = hh >> 1; const f32x4* kp = (const f32x4*)(CK + s * 128 + kv * 64); const float* qh = qs + hh * 64; float d = 0.f;
#pragma unroll
        for (int i = 0; i < 16; ++i) { const f32x4 k4 = kp[i]; d += qh[4 * i] * k4[0] + qh[4 * i + 1] * k4[1] + qh[4 * i + 2] * k4[2] + qh[4 * i + 3] * k4[3]; }
        sc[hh * 132 + s] = d - exp2f(-2.f * (float)(hh + 1)) * (float)(128 - s); }
    if (wave < 4) { const int hh = wave; const float d = wave_sum(qs[hh * 64 + lane] * kn[(hh >> 1) * 64 + lane]); if (lane == 0) sc[hh * 132 + 128] = d; }
    __syncthreads();
    if (wave < 4) { const int hh = wave; const float a0 = sc[hh * 132 + lane], a1 = sc[hh * 132 + 64 + lane], a2 = lane == 0 ? sc[hh * 132 + 128] : -1e30f, sk = P.in[I_SINK][l * 4 + hh];
        const float mx = fmaxf(wave_max(fmaxf(fmaxf(a0, a1), a2)), sk); const float e0 = __expf(a0 - mx), e1 = __expf(a1 - mx), e2 = lane == 0 ? __expf(a2 - mx) : 0.f;
        const float inv = frcp(wave_sum(e0 + e1 + e2) + __expf(sk - mx));
        sc[hh * 132 + lane] = e0 * inv; sc[hh * 132 + 64 + lane] = e1 * inv; if (lane == 0) sc[hh * 132 + 128] = e2 * inv; }
    __syncthreads();
    if (tid < 256) { const int hh = tid >> 6, dd = tid & 63, kv = hh >> 1; const float* pp = sc + hh * 132; float o = pp[128] * vn[kv * 64 + dd];
#pragma nounroll
        for (int s0 = 0; s0 < 128; s0 += 32) { float cvv[32];
#pragma unroll
            for (int s = 0; s < 32; ++s) cvv[s] = CV[(s0 + s) * 128 + kv * 64 + dd];
#pragma unroll
            for (int s = 0; s < 32; ++s) o += pp[s0 + s] * cvv[s]; }
        bf16_t* zp = ZY + row * 1024 + 512 + tid; *zp = f2bf(o * silu(bf2f(*zp))); }
    float* KO = P.out + O_KS + (size_t)(l * 128 + b) * 16384; float* VO = P.out + O_VS + (size_t)(l * 128 + b) * 16384;
    { f32x4 tk[8], tv[8];
#pragma unroll
      for (int k = 0; k < 8; ++k) { const int e = (tid + 512 * k) * 4;
        if (e < 127 * 128) { tk[k] = *(const f32x4*)(CK + 128 + e); tv[k] = *(const f32x4*)(CV + 128 + e); }
        else { tk[k] = *(const f32x4*)(kn + (e - 127 * 128)); tv[k] = *(const f32x4*)(vn + (e - 127 * 128)); } }
#pragma unroll
      for (int k = 0; k < 8; ++k) { const int e = (tid + 512 * k) * 4; *(f32x4*)(KO + e) = tk[k]; *(f32x4*)(VO + e) = tv[k]; } }
}
DEVI void gla_sample(const Params& P, int l, int b, float* sm) {
    const int tid = tidx(); const size_t row = NTOK + b;
    const bf16_t* PA = (const bf16_t*)(P.ws + OFF_PA); bf16_t* ZY = (bf16_t*)(P.ws + OFF_ZY);
    float* qs = sm; float* ks = sm + 128; float* eg = sm + 256; float* gl = sm + 384;
    __syncthreads();
    if (tid < 128) { qs[tid] = bf2f(PA[row * PALD + CB + tid]) * 0.17677669529663687f; ks[tid] = bf2f(PA[row * PALD + CB + 128 + tid]); }
    if (tid >= 128 && tid < 144) gl[tid - 128] = bf2f(PA[row * PALD + CB + 512 + tid - 128]);
    __syncthreads();
    if (tid < 128) { float x = P.in[I_GB][l * 128 + tid];
#pragma unroll
        for (int j = 0; j < 16; ++j) x += gl[j] * P.in[I_GUP][(l * 16 + j) * 128 + tid];
        eg[tid] = __expf(logsig(x) * (1.f / 16.f)); }
    __syncthreads();
    if (tid < 256) { const int h = tid >> 6, e = tid & 63; const float v = bf2f(PA[row * PALD + CB + 256 + tid]);
        const float* S0 = P.in[I_SGLA] + (size_t)((l * 128 + b) * 4 + h) * 2048; float* S1 = P.out + O_GLS + (size_t)((l * 128 + b) * 4 + h) * 2048;
        float o = 0.f, s0v[32];
#pragma unroll
        for (int d = 0; d < 32; ++d) s0v[d] = S0[d * 64 + e];
#pragma unroll
        for (int d = 0; d < 32; ++d) { const float sn = eg[h * 32 + d] * s0v[d] + ks[h * 32 + d] * v; S1[d * 64 + e] = sn; o += qs[h * 32 + d] * sn; }
        const float rr = rsqrtf(wave_sum(o * o) * (1.f / 64.f) + 1e-6f);
        bf16_t* zp = ZY + row * 1024 + 256 + tid; *zp = f2bf(o * rr * P.in[I_GNG][l * 64 + e] * silu(bf2f(*zp))); }
}
DEVI void lru_sample(const Params& P, int l, int item, float* sm) {
    const int tid = tidx(), s = tid >> 8, d = tid & 255, b = item * 2 + s; const size_t row = NTOK + b;
    const bf16_t* PA = (const bf16_t*)(P.ws + OFF_PA); bf16_t* ZY = (bf16_t*)(P.ws + OFF_ZY);
    float* xcs = sm;
    __syncthreads();
    const float x = bf2f(PA[row * PALD + CD + d]); const float* cv = P.in[I_SCONV] + (size_t)(l * 128 + b) * 768;
    const float c0 = cv[d], c1 = cv[256 + d], c2 = cv[512 + d];
    const float xc = P.in[I_CBI][l * 256 + d] + P.in[I_CW][(l * 4 + 0) * 256 + d] * c0 + P.in[I_CW][(l * 4 + 1) * 256 + d] * c1 + P.in[I_CW][(l * 4 + 2) * 256 + d] * c2 + P.in[I_CW][(l * 4 + 3) * 256 + d] * x;
    xcs[s * 256 + d] = xc;
    __syncthreads();
    const int n = d >> 6, dl = d & 63; float rp = P.in[I_BA][l * 256 + d], ip = P.in[I_BX][l * 256 + d];
#pragma unroll 8
    for (int c = 0; c < 64; ++c) { const float xv = xcs[s * 256 + n * 64 + c]; rp += xv * P.in[I_WA][((l * 4 + n) * 64 + c) * 64 + dl]; ip += xv * P.in[I_WX][((l * 4 + n) * 64 + c) * 64 + dl]; }
    const float la = 8.f * logsig_acc(P.in[I_LAM][l * 256 + d]) * sigm(rp), a = __expf(la), bt = __builtin_amdgcn_sqrtf(fmaxf(-expm1f(2.f * la), 0.f)) * sigm(ip) * xc;
    const float hn = a * P.in[I_SH][(size_t)(l * 128 + b) * 256 + d] + bt;
    float* co = P.out + O_CVS + (size_t)(l * 128 + b) * 768; co[d] = c1; co[256 + d] = c2; co[512 + d] = x;
    P.out[O_HS + (size_t)(l * 128 + b) * 256 + d] = hn;
    bf16_t* zp = ZY + row * 1024 + 768 + d; *zp = f2bf(hn * silu(bf2f(*zp)));
}

template <bool DRY = false> DEVI void rwkv_post(const Params& P, int l, int item) {
    const bool dost = !DRY || (P.ws == nullptr);
    const int tid = tidx(), wave = tid >> 6, lane = tid & 63;
    const bf16_t* RWP = (const bf16_t*)(P.ws + OFF_RWP); const float* RWC = (const float*)(P.ws + OFF_RWC); const float* RWO = P.out + SO_RWO; bf16_t* ZY = (bf16_t*)(P.ws + OFF_ZY);
    float o[8], v[8], z[8], c3[8];
#pragma unroll
    for (int k = 0; k < 8; ++k) { const int task = wave * 8 + k, h = task & 3; const size_t row = (size_t)item * 16 + (task >> 2);
        o[k] = RWO[row * 256 + h * 64 + lane]; v[k] = bf2f(RWP[row * 1536 + 1280 + h * 64 + lane]); z[k] = bf2f(ZY[row * 1024 + h * 64 + lane]); c3[k] = RWC[row * 16 + h * 4 + 2]; }
#pragma unroll
    for (int k = 0; k < 8; ++k) { const int task = wave * 8 + k, h = task & 3; const size_t row = (size_t)item * 16 + (task >> 2);
        const float mean = wave_sum(o[k]) * (1.f / 64.f); const float dv = o[k] - mean; const float var = wave_sum(dv * dv) * (1.f / 64.f);
        const float y = dv * rsqrtf(var + 64e-5f) * P.in[I_LNG][l * 256 + h * 64 + lane] + P.in[I_LNB][l * 256 + h * 64 + lane] + c3[k] * v[k];
        if (dost) ZY[row * 1024 + h * 64 + lane] = f2bf(y * silu(z[k])); }
}
template <bool DRY = false> DEVI void lru_final(const Params& P, int l, int item) {
    const bool dost = !DRY || (P.ws == nullptr);
    const int tid = tidx(), b = item >> 6, ck = item & 63, d = tid & 255, half = tid >> 8, sub = ck * 2 + half;
    const float* LH = P.out + SO_LH; const float* LP = P.out + SO_LP; const float* LB = P.out + SO_LB; bf16_t* ZY = (bf16_t*)(P.ws + OFF_ZY);
    const float carry = LB[(size_t)(b * 128 + sub) * 256 + d];
    const size_t r0 = (size_t)b * 2048 + ck * 32 + half * 16;
    float hv[16], z[16];
#pragma unroll
    for (int tt = 0; tt < 16; ++tt) { hv[tt] = LH[(r0 + tt) * 256 + d] + LP[(r0 + tt) * 256 + d] * carry; z[tt] = bf2f(ZY[(r0 + tt) * 1024 + 768 + d]); }
#pragma unroll
    for (int tt = 0; tt < 16; ++tt) if (dost) ZY[(r0 + tt) * 1024 + 768 + d] = f2bf(hv[tt] * silu(z[tt]));
}
template <bool DRY = false> DEVI void gla_out(const Params& P, int l, int item, float* sm) {
    const bool dost = !DRY || (P.ws == nullptr);
    const int tid = tidx(), c = item & 31, h = (item >> 5) & 3, b = item >> 7, row0 = b * 2048 + c * 64;
    const bf16_t* PA = (const bf16_t*)(P.ws + OFF_PA); bf16_t* ZY = (bf16_t*)(P.ws + OFF_ZY);
    float* gs = sm; float* gl = sm + 2048; float* seg = sm + 3072; float* qs = sm + 3584; float* ks = qs + 64 * 36; float* vs = ks + 64 * 36; float* att = vs + 4096; float* Ss = att + 64 * 65;
    __syncthreads();
    { bf16_t tq[4], tk[4], tv[8]; float ts[4];
#pragma unroll
      for (int k = 0; k < 4; ++k) { const int i = tid + 512 * k, t = i >> 5, d = i & 31; const bf16_t* rp = PA + (size_t)(row0 + t) * PALD + CB + h * 32 + d; tq[k] = rp[0]; tk[k] = rp[128]; ts[k] = P.out[SO_GU + (size_t)item * 2048 + i]; }
#pragma unroll
      for (int k = 0; k < 8; ++k) { const int i = tid + 512 * k, t = i >> 6, e = i & 63; tv[k] = PA[(size_t)(row0 + t) * PALD + CB + 256 + h * 64 + e]; }
#pragma unroll
      for (int k = 0; k < 4; ++k) { const int i = tid + 512 * k, t = i >> 5, d = i & 31; qs[t * 36 + d] = bf2f(tq[k]) * 0.17677669529663687f; ks[t * 36 + d] = bf2f(tk[k]); Ss[i] = ts[k]; }
#pragma unroll
      for (int k = 0; k < 8; ++k) vs[tid + 512 * k] = bf2f(tv[k]); }
    gla_load_cum(P, l, h, row0, gs, gl, seg);
    for (int i = tid; i < 2048; i += 512) { const int t = i >> 5, d = i & 31; const float bc = gs[i]; qs[t * 36 + d] *= __expf(bc); ks[t * 36 + d] *= __expf(-bc); }
    __syncthreads();
    const int t = tid >> 3, s8 = (tid & 7) * 8;
    {
        f32x4 qv[8];
#pragma unroll
        for (int d4 = 0; d4 < 8; ++d4) qv[d4] = *(const f32x4*)(qs + t * 36 + 4 * d4);
#pragma unroll
        for (int i = 0; i < 8; ++i) { const int s = 8 * i + (tid & 7); float a = 0.f;
            if (s <= t) { f32x2 a2 = {0.f, 0.f};
#pragma unroll
                for (int d4 = 0; d4 < 8; ++d4) { const f32x4 kv = *(const f32x4*)(ks + s * 36 + 4 * d4); a2 += qv[d4].lo * kv.lo; a2 += qv[d4].hi * kv.hi; }
                a = a2.x + a2.y; }
            att[t * 65 + s] = a; }
    }
    __syncthreads();
    const int e8 = s8; float o[8]; f32x2 o2[4];
#pragma unroll
    for (int i = 0; i < 4; ++i) o2[i] = (f32x2){0.f, 0.f};
#pragma unroll 2
    for (int s = 0; s <= t; ++s) { const float a = att[t * 65 + s]; const f32x4 v0 = *(const f32x4*)(vs + s * 64 + e8), v1 = *(const f32x4*)(vs + s * 64 + e8 + 4);
        o2[0] += v0.lo * a; o2[1] += v0.hi * a; o2[2] += v1.lo * a; o2[3] += v1.hi * a; }
#pragma unroll 8
    for (int d = 0; d < 32; ++d) { const float a = qs[t * 36 + d]; const f32x4 v0 = *(const f32x4*)(Ss + d * 64 + e8), v1 = *(const f32x4*)(Ss + d * 64 + e8 + 4);
        o2[0] += v0.lo * a; o2[1] += v0.hi * a; o2[2] += v1.lo * a; o2[3] += v1.hi * a; }
#pragma unroll
    for (int i = 0; i < 4; ++i) { o[2 * i] = o2[i].x; o[2 * i + 1] = o2[i].y; }
    float ss = 0.f;
#pragma unroll
    for (int i = 0; i < 8; ++i) ss += o[i] * o[i];
    ss = reduce8(ss);
    const float rr = rsqrtf(ss * (1.f / 64.f) + 1e-6f);
    bf16_t* zp = ZY + (size_t)(row0 + t) * 1024 + 256 + h * 64 + e8; const u32x4 z = *(const u32x4*)zp; const float* ng = P.in[I_GNG] + l * 64 + e8;
    u32x4 w; w.x = pk2(o[0] * rr * ng[0] * silu(bflo(z.x)), o[1] * rr * ng[1] * silu(bfhi(z.x))); w.y = pk2(o[2] * rr * ng[2] * silu(bflo(z.y)), o[3] * rr * ng[3] * silu(bfhi(z.y)));
    w.z = pk2(o[4] * rr * ng[4] * silu(bflo(z.z)), o[5] * rr * ng[5] * silu(bfhi(z.z))); w.w = pk2(o[6] * rr * ng[6] * silu(bflo(z.w)), o[7] * rr * ng[7] * silu(bfhi(z.w)));
    if (dost) *(u32x4*)zp = w;
}


DEVI void grid_bar(unsigned* w, unsigned k) {
    asm volatile("s_waitcnt vmcnt(0)" ::: "memory");
    __syncthreads();
    if (tidx() == 0) {
        const unsigned G = gridDim.x;
        __builtin_amdgcn_fence(__ATOMIC_RELEASE, "agent");
        asm volatile("s_waitcnt vmcnt(0)" ::: "memory");
        const unsigned old = __hip_atomic_fetch_add(&w[0], 1u, __ATOMIC_RELAXED, __HIP_MEMORY_SCOPE_AGENT);
        if (old + 1u == k * G) __hip_atomic_store(&w[64], k, __ATOMIC_RELAXED, __HIP_MEMORY_SCOPE_AGENT);
        while (__hip_atomic_load(&w[64], __ATOMIC_RELAXED, __HIP_MEMORY_SCOPE_AGENT) < k) __builtin_amdgcn_s_sleep(1);
        __builtin_amdgcn_fence(__ATOMIC_ACQUIRE, "agent");
        asm volatile("s_waitcnt vmcnt(0)" ::: "memory");
    }
    __syncthreads();
}

template <int NT, class Epi>
DEVI void small_gemm(const bf16_t* A, int lda, const bf16_t* const (&bp)[NT], int ldb, int K, const Epi& E, float* sm) {
    const int tid = tidx(), wave = tid >> 6, lane = tid & 63, lr = lane & 15, lq = lane >> 4;
    const int kw = K >> 3, kbeg = wave * kw;
    const bf16_t* ap = A + (size_t)lr * lda + 8 * lq + kbeg;
    f32x4 acc[NT];
#pragma unroll
    for (int t = 0; t < NT; ++t) acc[t] = (f32x4){0.f, 0.f, 0.f, 0.f};
    if (kw == 128) {
        bf16x8 a[4], b[4][NT];
#pragma unroll
        for (int s2 = 0; s2 < 4; ++s2) { a[s2] = *(const bf16x8*)(ap + 32 * s2);
#pragma unroll
            for (int t = 0; t < NT; ++t) b[s2][t] = *(const bf16x8*)(bp[t] + (size_t)lr * ldb + 8 * lq + kbeg + 32 * s2); }
#pragma unroll
        for (int s2 = 0; s2 < 4; ++s2)
#pragma unroll
            for (int t = 0; t < NT; ++t) acc[t] = __builtin_amdgcn_mfma_f32_16x16x32_bf16(a[s2], b[s2][t], acc[t], 0, 0, 0);
    } else {
        const bf16x8 a = *(const bf16x8*)ap; bf16x8 b[NT];
#pragma unroll
        for (int t = 0; t < NT; ++t) b[t] = *(const bf16x8*)(bp[t] + (size_t)lr * ldb + 8 * lq + kbeg);
#pragma unroll
        for (int t = 0; t < NT; ++t) acc[t] = __builtin_amdgcn_mfma_f32_16x16x32_bf16(a, b[t], acc[t], 0, 0, 0);
    }
    __syncthreads();
    f32x4* red = (f32x4*)sm;
#pragma unroll
    for (int t = 0; t < NT; ++t) red[(wave * NT + t) * 64 + lane] = acc[t];
    __syncthreads();
    if (wave == 0) {
#pragma unroll
        for (int t = 0; t < NT; ++t) { f32x4 v = red[t * 64 + lane];
#pragma unroll
            for (int w = 1; w < 8; ++w) v += red[(w * NT + t) * 64 + lane];
            acc[t] = v; }
        E(acc, lane);
    }
}
DEVI void small_br(const Params& P, int l, int item, float* sm) {
    const int rg = item >> 6, it = item & 63, b = it >> 4, s4 = it & 15;
    const bf16_t* ZY = (const bf16_t*)(P.ws + OFF_ZY) + (size_t)(NTOK + 16 * rg) * 1024 + b * 256;
    const bf16_t* W = (const bf16_t*)(P.ws + OFF_WBR) + (size_t)(l * 4 + b) * 1024 * 256;
    const bf16_t* bp[4] = {W + (size_t)(64 * s4) * 256, W + (size_t)(64 * s4 + 16) * 256, W + (size_t)(64 * s4 + 32) * 256, W + (size_t)(64 * s4 + 48) * 256};
    bf16_t* BR = (bf16_t*)(P.ws + OFF_BR) + (size_t)(NTOK + 16 * rg) * 4096 + b * 1024;
    auto E = [&](const f32x4 (&acc)[4], int lane) {
#pragma unroll
        for (int t = 0; t < 4; ++t) { const int n = 64 * s4 + 16 * t + (lane & 15), col = (n & ~255) + natcol(n & 255);
#pragma unroll
            for (int g = 0; g < 4; ++g) BR[(size_t)((lane >> 4) * 4 + g) * 4096 + col] = f2bf(acc[t][g]); } };
    small_gemm<4>(ZY, 1024, bp, 256, 256, E, sm);
}
DEVI void small_gate(const Params& P, int l, int item, float* sm) {
    const int rg = item >> 6, it = item & 63, q = it >> 2, wc = it & 3;
    const bf16_t* XB = (const bf16_t*)(P.ws + OFF_XB) + (size_t)(NTOK + 16 * rg) * 1024;
    const bf16_t* W = (const bf16_t*)(P.ws + OFF_W1T) + (size_t)l * 7424 * 1024 + (size_t)(3328 + 256 * q + 32 * wc) * 1024;
    const bf16_t* bp[4] = {W, W + (size_t)16 * 1024, W + (size_t)128 * 1024, W + (size_t)144 * 1024};
    const bf16_t* BR = (const bf16_t*)(P.ws + OFF_BR) + (size_t)(NTOK + 16 * rg) * 4096;
    const float* ssq = (const float*)(P.ws + OFF_SSQ) + l * MPAD + NTOK + 16 * rg;
    bf16_t* ZY = (bf16_t*)(P.ws + OFF_ZY) + (size_t)(NTOK + 16 * rg) * 1024;
    auto E = [&](const f32x4 (&acc)[4], int lane) {
        const int col = 64 * q + 16 * wc + (lane & 15);
#pragma unroll
        for (int g = 0; g < 4; ++g) { const int rl = (lane >> 4) * 4 + g; const float rs = rsqrtf(ssq[rl] * (1.f / 1024.f) + 1e-6f); float o = 0.f;
#pragma unroll
            for (int b = 0; b < 4; ++b) o += sigm(acc[b][g] * rs) * bf2f(BR[(size_t)rl * 4096 + b * 1024 + col]);
            ZY[(size_t)rl * 1024 + col] = f2bf(o); } };
    small_gemm<4>(XB, 1024, bp, 1024, 1024, E, sm);
}
template <int LAYER> DEVI void small_out(const Params& P, int l, int item, float* sm) {
    const int rg = item >> 5, it = item & 31;
    const bf16_t* ZY = (const bf16_t*)(P.ws + OFF_ZY) + (size_t)(NTOK + 16 * rg) * 1024;
    const bf16_t* W = (const bf16_t*)(P.ws + OFF_WOUT) + (size_t)l * 1024 * 1024 + (size_t)(32 * it) * 1024;
    const bf16_t* bp[2] = {W, W + (size_t)16 * 1024};
    bf16_t* XB = (bf16_t*)(P.ws + OFF_XB) + (size_t)(NTOK + 16 * rg) * 1024; float* yout = P.out + (size_t)(NTOK + 16 * rg) * 1024; const float* xs = P.in[I_XS] + (size_t)(16 * rg) * 1024;
    float* ssq = (float*)(P.ws + OFF_SSQ) + (LAYER == 0 ? 1 : 2) * MPAD + NTOK + 16 * rg;
    auto E = [&](const f32x4 (&acc)[2], int lane) {
        const int i = lane & 15;
#pragma unroll
        for (int g = 0; g < 4; ++g) { const int rl = (lane >> 4) * 4 + g; float ps = 0.f;
#pragma unroll
            for (int t = 0; t < 2; ++t) { const int col = 32 * it + 8 * (i >> 2) + 4 * t + (i & 3); float v = acc[t][g];
                if (LAYER == 0) { v += xs[(size_t)rl * 1024 + col]; XB[(size_t)rl * 1024 + col] = f2bf(v); }
                else { v += bf2f(XB[(size_t)rl * 1024 + col]); yout[(size_t)rl * 1024 + col] = v; }
                ps += v * v; }
            ps = reduce16(ps);
            if (i == 0) atomicAdd(ssq + rl, ps); } };
    small_gemm<2>(ZY, 1024, bp, 1024, 1024, E, sm);
}

#ifndef PHMASK
#define PHMASK 0xFFFF
#endif
#define PHON(b) ((PHMASK >> (b)) & 1)
DEVI void run_phase(const Params& P, int ph, unsigned char* smem) {
    float* sm = (float*)smem;
    const int G = gridDim.x, c = blockIdx.x;
    if (ph == 0) { if (PHON(0)) phase_p0(P, smem); return; }
    if (ph == NPH - 1) { if (!PHON(8)) return;
        const int wave = tidx() >> 6, lane = tidx() & 63; const float* ssq = (const float*)(P.ws + OFF_SSQ) + 2 * MPAD;
        for (int row = c * 8 + wave; row < ROWS; row += G * 8) { const float rs = rsqrtf(ssq[row] * (1.f / 1024.f) + 1e-6f); f32x4* yp = (f32x4*)(P.out + (size_t)row * 1024) + lane; const f32x4* gp = (const f32x4*)P.in[I_FNG] + lane;
#pragma unroll
            for (int j = 0; j < 4; ++j) yp[64 * j] = yp[64 * j] * rs * gp[64 * j]; }
        return;
    }
    const int l = (ph - 1) / 7, sp = (ph - 1) % 7;
    const char* XB = (const char*)(P.ws + OFF_XB); const char* ZYc = (const char*)(P.ws + OFF_ZY);
    float* ssq = (float*)(P.ws + OFF_SSQ);
    if (sp == 0) { if (!PHON(1)) return; SchedG1 S{XB, (const char*)(P.ws + OFF_W1T) + (size_t)l * 7424 * 2048, G, c}; EpiG1 E{(bf16_t*)(P.ws + OFF_PA), (bf16_t*)(P.ws + OFF_ZY), ssq + l * MPAD};
        g8::gemm_phase((LAS unsigned char*)smem, 2048, 2048, 1024, S, E);
        return; }
    if (sp == 1) { if (!PHON(2)) return;
        constexpr int NA = 1024, NL = 512, NG = 1024, NAS = 32, NC = 8;
        for (int it = c; it < NA + NL + NG + NAS + NC; it += G) { int r = it;
            if (r < NA) { rwkv_prep(P, l, r); continue; } r -= NA;
            if (r < NL) { lru_prep(P, l, r, sm); continue; } r -= NL;
            if (r < NG) { gla_prep(P, l, r, sm); continue; } r -= NG;
            if (r < NAS) { rwkv_prep(P, l, 1024 + r); continue; } r -= NAS;
            cache_copy(P, l, r); }
        return; }
    if (sp == 2) { if (!PHON(3)) return;
        const int nR = G >= 256 ? 128 : (G > 1 ? G / 2 : 0);
        if (c < nR) { if (PROBE_SP != 13) for (int it = c; it < 128; it += nR) { const int slot = it >> 3; rwkv_scan_prompt(P, l, (((it & 7) * 4 + (slot >> 2)) * 4) + (slot & 3), sm, (l == 0 && G >= 256) ? it : -1); } return; }
        constexpr int NSW = 512, NGP = 32, NLC = 8, NRS = 64, NSS = 128, NGS = 128, NLS = 64;
        if (nR == 0) for (int it = 0; it < 128; ++it) rwkv_scan_prompt(P, l, it, sm);
        for (int it = c - nR; it < NSW + NGP + NLC + NRS + NSS + NGS + NLS; it += G - nR) { int r = it;
            if (r < NGP) { gla_prefix(P, l, r); continue; } r -= NGP;
            if (r < NLC) { lru_carry(P, l, r); continue; } r -= NLC;
            if (r < NSW) { swa_prompt(P, l, r, sm); continue; } r -= NSW;
            if (r < NRS) { rwkv_scan_sample(P, l, r); continue; } r -= NRS;
            if (r < NSS) { swa_sample(P, l, r, sm); continue; } r -= NSS;
            if (r < NGS) { gla_sample(P, l, r, sm); continue; } r -= NGS;
            lru_sample(P, l, r, sm); }
        return; }
    if (sp == 3) { if (!PHON(4)) return;
        constexpr int NG = 1024, NL = 512, NR = 1032;
        for (int it = c; it < NG + NL + NR; it += G) { int r = it;
            if (r < NG) { gla_out(P, l, r, sm); continue; } r -= NG;
            if (r < NL) { lru_final(P, l, r); continue; } r -= NL;
            rwkv_post(P, l, r); }
        return; }
    if (sp == 4) { if (!PHON(5)) return; SchedBr S{ZYc, (const char*)(P.ws + OFF_WBR) + (size_t)l * 4 * 1024 * 512, G, c}; EpiBr E{(bf16_t*)(P.ws + OFF_BR)};
        g8::gemm_phase((LAS unsigned char*)smem, 2048, 512, 256, S, E);
        for (int it = G - 1 - c; it < 512; it += G) small_br(P, l, it, sm);
        return; }
    if (sp == 5) { if (!PHON(6)) return; SchedGate S{XB, (const char*)(P.ws + OFF_W1T) + (size_t)l * 7424 * 2048, G, c}; EpiGate E{(const bf16_t*)(P.ws + OFF_BR), ssq + l * MPAD, (bf16_t*)(P.ws + OFF_ZY)};
        g8::gemm_phase((LAS unsigned char*)smem, 2048, 2048, 1024, S, E);
        for (int it = G - 1 - c; it < 512; it += G) small_gate(P, l, it, sm);
        return; }
    if (PHON(7)) { SchedOut S{ZYc, (const char*)(P.ws + OFF_WOUT) + (size_t)l * 1024 * 2048, G, c};
        if (l == 0) { EpiOut<0> E{P.in[I_XP], P.in[I_XS], (bf16_t*)(P.ws + OFF_XB), P.out, ssq + MPAD}; g8::gemm_phase((LAS unsigned char*)smem, 2048, 2048, 1024, S, E); for (int it = G - 1 - c; it < 256; it += G) small_out<0>(P, l, it, sm); }
        else { EpiOut<1> E{P.in[I_XP], P.in[I_XS], (bf16_t*)(P.ws + OFF_XB), P.out, ssq + 2 * MPAD}; g8::gemm_phase((LAS unsigned char*)smem, 2048, 2048, 1024, S, E); for (int it = G - 1 - c; it < 256; it += G) small_out<1>(P, l, it, sm); }
    }
}

__global__ void __launch_bounds__(512) mega_fwd(Params P, int ph_lo, int ph_hi, int cg_mode) {
    extern __shared__ __attribute__((aligned(16))) unsigned char smem[];
    cg::grid_group grid = cg::this_grid();
    unsigned nbar = 0;
    unsigned* barw = (unsigned*)(P.ws + OFF_BAR);
#define GSYNC() do { if (USE_CG_SYNC || cg_mode) grid.sync(); else grid_bar(barw, ++nbar); } while (0)
    for (int ph = ph_lo; ph < ph_hi; ++ph) {
        if (ph > ph_lo) GSYNC();
        __syncthreads();
        unsigned z; asm volatile("s_mov_b32 %0, 0" : "=s"(z));
        const Params* pp = (const Params*)((const char*)(const __attribute__((address_space(4))) char*)__builtin_amdgcn_kernarg_segment_ptr() + z);
        if (PROBE_SP == 13 && ph >= 1 && ph < NPH - 1 && (ph - 1) % 7 == 2) { if (blockIdx.x < 128) rwkv_scan_prompt(*pp, (ph - 1) / 7, blockIdx.x, (float*)smem); GSYNC(); __syncthreads(); }
        run_phase(*pp, ph, smem);
        if (PROBE_SP >= 0) {
            const int spx = (ph >= 1 && ph < NPH - 1) ? (ph - 1) % 7 : -1;
            if ((PROBE_SP < 7 && spx == PROBE_SP) || (PROBE_SP == 7 && ph == 0)) { GSYNC(); __syncthreads(); run_phase(*pp, ph, smem); }
            if (PROBE_SP == 8 && spx == 2) { GSYNC(); __syncthreads(); if (blockIdx.x < 128) rwkv_scan_prompt(*pp, (ph - 1) / 7, blockIdx.x, (float*)smem); }
            if (PROBE_SP == 9) GSYNC();
            if (PROBE_SP == 14 && spx == 2) { GSYNC(); __syncthreads(); if (blockIdx.x >= 128) for (int it = blockIdx.x - 128; it < 512; it += gridDim.x - 128) swa_prompt<true>(*pp, (ph - 1) / 7, it, (float*)smem); }
            if (PROBE_SP >= 15 && PROBE_SP <= 17 && spx == 2) { GSYNC(); __syncthreads(); const int l_ = (ph - 1) / 7;
                if (PROBE_SP == 15) for (int it = blockIdx.x; it < 1024; it += gridDim.x) gla_out<true>(*pp, l_, it, (float*)smem);
                if (PROBE_SP == 16) for (int it = blockIdx.x; it < 512; it += gridDim.x) lru_final<true>(*pp, l_, it);
                if (PROBE_SP == 17) for (int it = blockIdx.x; it < 1032; it += gridDim.x) rwkv_post<true>(*pp, l_, it); }
            if (PROBE_SP == 18 && spx == 5) { GSYNC(); __syncthreads(); const int l_ = (ph - 1) / 7; const int G = gridDim.x, c = blockIdx.x;
                SchedOut S{(const char*)(pp->ws + OFF_ZY), (const char*)(pp->ws + OFF_WOUT) + (size_t)l_ * 1024 * 2048, G, c}; float* ssq = (float*)(pp->ws + OFF_SSQ);
                if (l_ == 0) { EpiOut<0, false> E{pp->in[I_XP], pp->in[I_XS], (bf16_t*)(pp->ws + OFF_XB), pp->out, ssq + MPAD}; g8::gemm_phase((LAS unsigned char*)smem, 2048, 2048, 1024, S, E); }
                else { EpiOut<1, false> E{pp->in[I_XP], pp->in[I_XS], (bf16_t*)(pp->ws + OFF_XB), pp->out, ssq + 2 * MPAD}; g8::gemm_phase((LAS unsigned char*)smem, 2048, 2048, 1024, S, E); } }
            if (PROBE_SP >= 10 && PROBE_SP <= 12 && spx == 1) { GSYNC(); __syncthreads(); const int l_ = (ph - 1) / 7;
                if (PROBE_SP == 10) for (int it = blockIdx.x; it < 1024; it += gridDim.x) gla_prep(*pp, l_, it, (float*)smem);
                if (PROBE_SP == 11) for (int it = blockIdx.x; it < 512; it += gridDim.x) lru_prep(*pp, l_, it, (float*)smem);
                if (PROBE_SP == 12) for (int it = blockIdx.x; it < 1056; it += gridDim.x) rwkv_prep(*pp, l_, it); }
        }
    }
}

extern "C" void kernel_launch(void* const* d_in, const int* in_sizes, int n_in, void* d_out, int out_size, void* d_ws, size_t ws_size, hipStream_t stream) {
    static int grid = 0;
    if (grid == 0) {
        if (n_in != 35 || (size_t)out_size != O_END || ws_size < WS_END) { fprintf(stderr, "kernel_launch: unexpected shapes n_in %d out %d ws %zu (need %zu)\n", n_in, out_size, ws_size, (size_t)WS_END); grid = -1; return; }
        int dev = 0, cus = 0, per_cu = 0;
        hipGetDevice(&dev); hipDeviceGetAttribute(&cus, hipDeviceAttributeMultiprocessorCount, dev);
        if (hipFuncSetAttribute((const void*)mega_fwd, hipFuncAttributeMaxDynamicSharedMemorySize, LDS_BYTES) != hipSuccess) { fprintf(stderr, "kernel_launch: hipFuncSetAttribute failed\n"); grid = -1; return; }
        if (hipOccupancyMaxActiveBlocksPerMultiprocessor(&per_cu, (const void*)mega_fwd, 512, LDS_BYTES) != hipSuccess || per_cu < 1) { fprintf(stderr, "kernel_launch: occupancy query says %d\n", per_cu); per_cu = 1; }
        (void)hipGetLastError();
        grid = cus;
    }
    if (grid < 0) return;
    Params p{};
    for (int i = 0; i < 35; ++i) p.in[i] = (const float*)d_in[i];
    p.out = (float*)d_out; p.ws = (unsigned char*)d_ws;
#if ONE_LAUNCH
    (void)hipMemsetAsync((char*)d_ws + OFF_BAR, 0, 4096, stream);
    int lo = 0, hi = NPH, cgm = 0;
    void* args[] = {&p, &lo, &hi, &cgm};
    hipError_t e = hipLaunchCooperativeKernel((const void*)mega_fwd, dim3(grid), dim3(512), args, LDS_BYTES, stream);
    if (e != hipSuccess) fprintf(stderr, "cooperative launch failed: %s (grid %d)\n", hipGetErrorString(e), grid);
#else
    for (int ph = 0; ph < NPH; ++ph) hipLaunchKernelGGL(mega_fwd, dim3(grid), dim3(512), LDS_BYTES, stream, p, ph, ph + 1, 0);
#endif
}
```

```cpp
#include <hip/hip_runtime.h>
#include <hip/hip_cooperative_groups.h>
#include <cstdio>
#include <cstdint>
namespace cg = cooperative_groups;

typedef unsigned short bf16_t;
typedef short bf16x8 __attribute__((ext_vector_type(8)));
typedef float f32x4 __attribute__((ext_vector_type(4)));
typedef unsigned u32x4 __attribute__((ext_vector_type(4)));
typedef unsigned u32x2 __attribute__((ext_vector_type(2)));
typedef float f32x2 __attribute__((ext_vector_type(2)));
#define LAS __attribute__((address_space(3)))
#define DEVI __device__ __forceinline__

#ifndef PROBE_SP
#define PROBE_SP -1
#endif
#ifndef USE_CG_SYNC
#define USE_CG_SYNC 0
#endif
#ifndef ONE_LAUNCH
#define ONE_LAUNCH 1
#endif

constexpr int NTOK = 16384, NSAMP = 128, ROWS = 16512, MPAD = 16640, SEQ = 2048;
constexpr int INC = 7248;
constexpr int CA = 0, CB = 832, CC = 1360, CD = 1872, CZ = 2128, CG = 3152;
constexpr int PALD = 2304;
constexpr int NPH = 16;
constexpr int LDS_BYTES = 131072;

constexpr size_t OFF_W1T = 0, SZ_W1T = (size_t)2 * 7424 * 1024 * 2;
constexpr size_t OFF_WBR = OFF_W1T + SZ_W1T, SZ_WBR = (size_t)2 * 4 * 1024 * 256 * 2;
constexpr size_t OFF_WOUT = OFF_WBR + SZ_WBR, SZ_WOUT = (size_t)2 * 1024 * 1024 * 2;
constexpr size_t OFF_XB = OFF_WOUT + SZ_WOUT, SZ_XB = (size_t)MPAD * 1024 * 2;
constexpr size_t OFF_ZY = OFF_XB + SZ_XB;
constexpr size_t OFF_SSQ = OFF_ZY + SZ_XB, SZ_SSQ = (size_t)3 * MPAD * 4;
constexpr size_t OFF_BR = OFF_SSQ + SZ_SSQ, SZ_BR = (size_t)MPAD * 4096 * 2;
constexpr size_t OFF_PA = OFF_BR, SZ_PA = (size_t)MPAD * PALD * 2;
constexpr size_t OFF_RWP = OFF_BR + SZ_PA, SZ_RWP = (size_t)ROWS * 1536 * 2;
constexpr size_t OFF_RWC = OFF_RWP + SZ_RWP, SZ_RWC = (size_t)ROWS * 16 * 4;
constexpr size_t OFF_BAR = OFF_BR + SZ_BR;
constexpr size_t OFF_WLT = OFF_BAR + 4096, SZ_WLT = (size_t)2 * 2 * 4 * 4096 * 2;
constexpr size_t WS_END = OFF_WLT + SZ_WLT;
static_assert(OFF_RWC + SZ_RWC <= WS_END, "ws overlay");

constexpr size_t SO_RWO = 0;
constexpr size_t SO_LH = SO_RWO + (size_t)ROWS * 256;
constexpr size_t SO_LP = SO_LH + (size_t)NTOK * 256;
constexpr size_t SO_GU = SO_LP + (size_t)NTOK * 256;
constexpr size_t SO_GD = SO_GU + (size_t)1024 * 2048;
constexpr size_t SO_LA = SO_GD + (size_t)1024 * 32;
constexpr size_t SO_LB = SO_LA + (size_t)8 * 128 * 256;
static_assert(SO_LB + 8 * 128 * 256 <= (size_t)ROWS * 1024, "out scratch");

constexpr size_t O_Y = 0;
constexpr size_t O_WKVP = (size_t)ROWS * 1024;
constexpr size_t O_WKVS = O_WKVP + 2 * 8 * 4 * 64 * 64;
constexpr size_t O_SHP = O_WKVS + (size_t)2 * 128 * 4 * 64 * 64;
constexpr size_t O_SHS = O_SHP + 2 * 8 * 832;
constexpr size_t O_GLP = O_SHS + 2 * 128 * 832;
constexpr size_t O_GLS = O_GLP + 2 * 8 * 4 * 32 * 64;
constexpr size_t O_KP = O_GLS + 2 * 128 * 4 * 32 * 64;
constexpr size_t O_KS = O_KP + 2 * 8 * 128 * 128;
constexpr size_t O_VP = O_KS + (size_t)2 * 128 * 128 * 128;
constexpr size_t O_VS = O_VP + 2 * 8 * 128 * 128;
constexpr size_t O_CVP = O_VS + (size_t)2 * 128 * 128 * 128;
constexpr size_t O_CVS = O_CVP + 2 * 8 * 3 * 256;
constexpr size_t O_HP = O_CVS + 2 * 128 * 3 * 256;
constexpr size_t O_HS = O_HP + 2 * 8 * 256;
constexpr size_t O_END = O_HS + 2 * 128 * 256;

struct Params {
    const float* in[35];
    float* out;
    unsigned char* ws;
};
enum { I_XP = 0, I_XS, I_SWKV, I_SSHIFT, I_SGLA, I_CK, I_CV, I_SCONV, I_SH, I_NG, I_WIN, I_MU, I_W0, I_WUP, I_A0, I_AUP, I_KK, I_KA, I_RK, I_LNG, I_LNB,
       I_GUP, I_GB, I_GNG, I_SINK, I_CW, I_CBI, I_WA, I_BA, I_WX, I_BX, I_LAM, I_WBR, I_WOUT, I_FNG };

DEVI int tidx() { int t = (int)threadIdx.x; asm volatile("" : "+v"(t)); return t; }
DEVI float bf2f(bf16_t h) { return __uint_as_float(((unsigned)h) << 16); }
DEVI float bflo(unsigned w) { return __uint_as_float(w << 16); }
DEVI float bfhi(unsigned w) { return __uint_as_float(w & 0xffff0000u); }
DEVI unsigned f2bfu(float f) { unsigned u = __float_as_uint(f); return (u + 0x7fffu + ((u >> 16) & 1u)) >> 16; }
DEVI bf16_t f2bf(float f) { return (bf16_t)f2bfu(f); }
DEVI unsigned pk2(float lo, float hi) { return f2bfu(lo) | (f2bfu(hi) << 16); }
template <int CTRL> DEVI float dpp_mov(float v) { return __builtin_bit_cast(float, __builtin_amdgcn_update_dpp(0, __builtin_bit_cast(int, v), CTRL, 0xF, 0xF, true)); }
DEVI float rdlane(float v, int l) { return __builtin_bit_cast(float, __builtin_amdgcn_readlane(__builtin_bit_cast(int, v), l)); }
DEVI float reduce16(float v) { v += dpp_mov<0xB1>(v); v += dpp_mov<0x4E>(v); v += dpp_mov<0x141>(v); v += dpp_mov<0x140>(v); return v; }
DEVI float reduce8(float v) { v += dpp_mov<0xB1>(v); v += dpp_mov<0x4E>(v); v += dpp_mov<0x141>(v); return v; }
DEVI float wave_sum(float v) { v = reduce16(v); return (rdlane(v, 0) + rdlane(v, 16)) + (rdlane(v, 32) + rdlane(v, 48)); }
DEVI float wave_max(float v) { v = fmaxf(v, dpp_mov<0xB1>(v)); v = fmaxf(v, dpp_mov<0x4E>(v)); v = fmaxf(v, dpp_mov<0x141>(v)); v = fmaxf(v, dpp_mov<0x140>(v));
    return fmaxf(fmaxf(rdlane(v, 0), rdlane(v, 16)), fmaxf(rdlane(v, 32), rdlane(v, 48))); }
DEVI float quad_sum(float v) { v += dpp_mov<0xB1>(v); v += dpp_mov<0x4E>(v); return v; }
DEVI float quad_max(float v) { v = fmaxf(v, dpp_mov<0xB1>(v)); v = fmaxf(v, dpp_mov<0x4E>(v)); return v; }
DEVI float frcp(float x) { return __builtin_amdgcn_rcpf(x); }
DEVI float sigm(float x) { return frcp(1.f + __expf(-x)); }
DEVI float silu(float x) { return x * sigm(x); }
DEVI float flog(float x) { return __builtin_amdgcn_logf(x) * 0.6931471806f; }
DEVI float logsig(float x) { return fminf(x, 0.f) - flog(1.f + __expf(-fabsf(x))); }
DEVI float softplus(float x) { return fmaxf(x, 0.f) + flog(1.f + __expf(-fabsf(x))); }
DEVI float logsig_acc(float x) { return fminf(x, 0.f) - log1pf(expf(-fabsf(x))); }
DEVI float ftanh(float x) { const float e = __expf(-2.f * fabsf(x)); const float t = (1.f - e) * frcp(1.f + e); return x < 0.f ? -t : t; }
#define LDS_WAIT() asm volatile("s_waitcnt lgkmcnt(0)" ::: "memory")

DEVI int natcol(int p) { return (p & ~31) | (((p >> 2) & 3) << 3) | (((p >> 4) & 1) << 2) | (p & 3); }
DEVI int w1_src(int n) {
    const int pn = n >> 8, p = n & 255;
    if (pn < 9) { const int c = 256 * pn + natcol(p); return c < CZ ? c : -1; }
    if (pn < 13) return CZ + 256 * (pn - 9) + natcol(p);
    const int q = pn - 13, bj = p >> 7, wc = (p >> 5) & 3, n_ = (p >> 4) & 1, r16 = p & 15;
    return CG + (2 * bj + n_) * 1024 + 64 * q + 16 * wc + r16;
}

namespace g8 {
constexpr int BM = 256, BK = 64, HALF = 128, HTB = HALF * BK * 2;
DEVI int lds_byte(int r, int c) { const int st = (r >> 4) * 2 + (c >> 5), rr = r & 15, cc = c & 31, ob = rr * 64 + cc * 2; return st * 1024 + (ob ^ (((ob >> 9) & 1) << 5)); }
DEVI void stage_rc(int b, int& R, int& C) { const int st = b / 1024, sb = b % 1024, swz = sb ^ (((sb >> 9) & 1) << 5); R = (st >> 1) * 16 + swz / 64; C = (st & 1) * 32 + (swz % 64) / 2; }
struct Unit { const char* a; const char* b; int pm, pn; };
DEVI void tile_of(int L, int nM, int nN, int& pm, int& pn) {
    const int nwg = nM * nN; int wgid = L;
    { const int q = nwg / 8, r = nwg % 8, xcd = wgid % 8, off = wgid / 8; wgid = (xcd < r ? xcd * (q + 1) : r * (q + 1) + (xcd - r) * q) + off; }
    const int nig = 8 * nN, gid = wgid / nig, fm = gid * 8, gsz = (nM - fm) < 8 ? (nM - fm) : 8;
    pm = fm + ((wgid % nig) % gsz); pn = (wgid % nig) / gsz;
}

template <class Sched, class Epi>
DEVI void gemm_phase(LAS unsigned char* lds, const int lda, const int ldb, const int K, const Sched& S, const Epi& E) {
    const int tid = tidx(), wid = __builtin_amdgcn_readfirstlane(tid >> 6), lane = tid & 63, wr = wid >> 2, wc = wid & 3, fr = lane & 15, fq = lane >> 4;
    const int nt = K / BK;
    unsigned voffA[2], voffB[2];
#pragma unroll
    for (int i = 0; i < 2; ++i) { int R, C; stage_rc(tid * 16 + i * 8192, R, C); voffA[i] = (unsigned)(R * lda + C * 2); voffB[i] = (unsigned)(R * ldb + C * 2); }
    const size_t kstep = (size_t)(BK * 2);
    const size_t hstepA = (size_t)HALF * lda, hstepB = (size_t)HALF * ldb;
    const unsigned ldsw = (unsigned)wid * 1024u;
    const int aoff = lds_byte(wr * 64 + fr, fq * 8), boff = lds_byte(wc * 32 + fr, fq * 8);
#define G8_SA(b, h) (((b) * 2 + (h)) * HTB)
#define G8_SB(b, h) ((4 + (b) * 2 + (h)) * HTB)
#define G8_STAGE(bufoff, gbase, voff) do { _Pragma("unroll") for (int _i = 0; _i < 2; ++_i) \
        __builtin_amdgcn_global_load_lds((const unsigned*)((const char*)(gbase) + (voff)[_i]), (LAS unsigned*)(lds + (bufoff) + ldsw + _i * 8192), 16, 0, 0); } while (0)
#define G8_LDA(dst, b, h) do { _Pragma("unroll") for (int m = 0; m < 4; ++m) _Pragma("unroll") for (int k = 0; k < 2; ++k) dst[m][k] = *(const LAS bf16x8*)(lds + G8_SA(b, h) + aoff + m * 2048 + k * 1024); } while (0)
#define G8_LDB(dst, b, h) do { _Pragma("unroll") for (int n = 0; n < 2; ++n) _Pragma("unroll") for (int k = 0; k < 2; ++k) dst[n][k] = *(const LAS bf16x8*)(lds + G8_SB(b, h) + boff + n * 2048 + k * 1024); } while (0)
#define G8_MMA(ai, bj, At, Bt) do { __builtin_amdgcn_s_setprio(1); _Pragma("unroll") for (int m = 0; m < 4; ++m) _Pragma("unroll") for (int n = 0; n < 2; ++n) _Pragma("unroll") for (int k = 0; k < 2; ++k) \
        acc[ai][bj][m][n] = __builtin_amdgcn_mfma_f32_16x16x32_bf16(Bt[n][k], At[m][k], acc[ai][bj][m][n], 0, 0, 0); __builtin_amdgcn_s_setprio(0); } while (0)
#define G8_WAIT_V(n) asm volatile("s_waitcnt vmcnt(" #n ")" ::: "memory")
#define G8_WAIT_L(n) asm volatile("s_waitcnt lgkmcnt(" #n ")" ::: "memory")
#define G8_BAR __builtin_amdgcn_s_barrier()
#define G8_SCHED __builtin_amdgcn_sched_barrier(0)
    Unit cur, nxt; int ui = 0;
    if (!S.next(0, cur)) return;
    f32x4 acc[2][2][4][2];
#pragma unroll
    for (int a = 0; a < 2; ++a)
#pragma unroll
        for (int b = 0; b < 2; ++b)
#pragma unroll
            for (int m = 0; m < 4; ++m)
#pragma unroll
                for (int n = 0; n < 2; ++n) acc[a][b][m][n] = (f32x4){0.f, 0.f, 0.f, 0.f};
    bf16x8 At[4][2], B0[2][2], B1[2][2];
    const char* cA = cur.a; const char* cB = cur.b;
    G8_STAGE(G8_SB(0, 0), cB, voffB); G8_STAGE(G8_SA(0, 0), cA, voffA); G8_STAGE(G8_SB(0, 1), cB + hstepB, voffB); G8_STAGE(G8_SA(0, 1), cA + hstepA, voffA);
    if (wr == 1) G8_BAR;
    G8_WAIT_V(4); G8_BAR;
    G8_STAGE(G8_SB(1, 0), cB + kstep, voffB); G8_STAGE(G8_SA(1, 0), cA + kstep, voffA); G8_STAGE(G8_SB(1, 1), cB + hstepB + kstep, voffB);
    G8_WAIT_V(6); G8_BAR;
    for (;;) {
        const bool has_next = S.next(ui + 1, nxt);
        const char* nA = has_next ? nxt.a : cA; const char* nB = has_next ? nxt.b : cB;
        const bool full = cur.pm != 64;
#pragma nounroll
        for (int t = 0; t < nt; t += 2) {
            const bool last = (t == nt - 2);
            const char* a1 = cA + (size_t)(t + 1) * kstep;
            const char* a2 = last ? nA : cA + (size_t)(t + 2) * kstep; const char* b2 = last ? nB : cB + (size_t)(t + 2) * kstep;
            const char* a3 = a2 + kstep; const char* b3 = b2 + kstep;
            G8_LDB(B0, 0, 0); G8_SCHED; G8_LDA(At, 0, 0); G8_STAGE(G8_SA(1, 1), a1 + hstepA, voffA);
            G8_WAIT_L(8); G8_BAR; G8_WAIT_L(0); G8_MMA(0, 0, At, B0); G8_BAR; G8_SCHED;
            G8_LDB(B1, 0, 1); G8_STAGE(G8_SB(0, 0), b2, voffB);
            G8_BAR; G8_WAIT_L(0); G8_MMA(0, 1, At, B1); G8_BAR;
            G8_LDA(At, 0, 1); G8_STAGE(G8_SA(0, 0), a2, voffA);
            G8_BAR; G8_WAIT_L(0); G8_MMA(1, 0, At, B0); G8_BAR; G8_SCHED;
            G8_STAGE(G8_SB(0, 1), b2 + hstepB, voffB);
            G8_WAIT_V(6); G8_BAR; G8_MMA(1, 1, At, B1); G8_BAR;
            G8_LDB(B0, 1, 0); G8_SCHED; G8_LDA(At, 1, 0); G8_STAGE(G8_SA(0, 1), a2 + hstepA, voffA);
            G8_WAIT_L(8); G8_BAR; G8_WAIT_L(0); G8_MMA(0, 0, At, B0); G8_BAR; G8_SCHED;
            G8_LDB(B1, 1, 1); G8_STAGE(G8_SB(1, 0), b3, voffB);
            G8_BAR; G8_WAIT_L(0); G8_MMA(0, 1, At, B1); G8_BAR;
            G8_LDA(At, 1, 1); G8_STAGE(G8_SA(1, 0), a3, voffA);
            G8_BAR; G8_WAIT_L(0); G8_MMA(1, 0, At, B0); G8_BAR; G8_SCHED;
            G8_STAGE(G8_SB(1, 1), b3 + hstepB, voffB);
            G8_WAIT_V(6); G8_BAR; G8_MMA(1, 1, At, B1); G8_BAR;
        }
        E(acc, cur, wr, wc, fr, fq);
        if (!has_next) break;
#pragma unroll
        for (int a = 0; a < 2; ++a)
#pragma unroll
            for (int b = 0; b < 2; ++b)
#pragma unroll
                for (int m = 0; m < 4; ++m)
#pragma unroll
                    for (int n = 0; n < 2; ++n) acc[a][b][m][n] = (f32x4){0.f, 0.f, 0.f, 0.f};
        cur = nxt; cA = nA; cB = nB; ++ui;
    }
    G8_WAIT_V(0);
    if (wr == 0) G8_BAR;
    G8_BAR;
}
}
using g8::Unit;
typedef f32x4 AccT[2][2][4][2];

struct SchedG1 { const char* A; const char* B; int G, c;
    DEVI bool next(int i, Unit& u) const { const int L = i * G + c; if (L >= 65 * 13) return false; g8::tile_of(L, 65, 13, u.pm, u.pn);
        u.a = A + (size_t)u.pm * 256 * 2048; u.b = B + (size_t)u.pn * 256 * 2048; return true; } };
struct SchedBr { const char* A; const char* B; int G, c;
    DEVI bool next(int i, Unit& u) const { const int L = i * G + c; if (L >= 64 * 16) return false; g8::tile_of(L, 64, 16, u.pm, u.pn);
        const int b = u.pn >> 2, p4 = u.pn & 3; u.a = A + (size_t)u.pm * 256 * 2048 + b * 512; u.b = B + (size_t)b * (1024 * 512) + (size_t)p4 * 256 * 512; return true; } };
struct SchedGate { const char* A; const char* B; int G, c;
    DEVI bool next(int i, Unit& u) const { const int L = i * G + c; if (L >= 64 * 16) return false; g8::tile_of(L, 64, 16, u.pm, u.pn);
        u.a = A + (size_t)u.pm * 256 * 2048; u.b = B + (size_t)(3328 + 256 * u.pn) * 2048; return true; } };
struct SchedOut { const char* A; const char* B; int G, c;
    DEVI bool next(int i, Unit& u) const { const int L = i * G + c; if (L >= 64 * 4) return false; g8::tile_of(L, 64, 4, u.pm, u.pn);
        u.a = A + (size_t)u.pm * 256 * 2048; u.b = B + (size_t)u.pn * 256 * 2048; return true; } };

struct EpiG1 { bf16_t* PA; bf16_t* ZY; const float* ssq;
    DEVI void operator()(const AccT& acc, const Unit& u, int wr, int wc, int fr, int fq) const {
        bf16_t* base; int ld, pnl; if (u.pn < 9) { base = PA; ld = PALD; pnl = u.pn; } else { base = ZY; ld = 1024; pnl = u.pn - 9; }
        float sq[2][4];
#pragma unroll
        for (int ai = 0; ai < 2; ++ai)
#pragma unroll
            for (int m = 0; m < 4; ++m) sq[ai][m] = ssq[256 * u.pm + 128 * ai + 64 * wr + 16 * m + fr];
#pragma unroll
        for (int ai = 0; ai < 2; ++ai)
#pragma unroll
            for (int m = 0; m < 4; ++m) {
                const int r = 256 * u.pm + 128 * ai + 64 * wr + 16 * m + fr;
                const float rs = rsqrtf(sq[ai][m] * (1.f / 1024.f) + 1e-6f);
                bf16_t* rowp = base + (size_t)r * ld + 256 * pnl + 32 * wc + 8 * fq;
#pragma unroll
                for (int bj = 0; bj < 2; ++bj) { const f32x4 v0 = acc[ai][bj][m][0] * rs, v1 = acc[ai][bj][m][1] * rs;
                    u32x4 w; w.x = pk2(v0[0], v0[1]); w.y = pk2(v0[2], v0[3]); w.z = pk2(v1[0], v1[1]); w.w = pk2(v1[2], v1[3]);
                    *(u32x4*)(rowp + 128 * bj) = w; }
            }
    } };
struct EpiBr { bf16_t* BR;
    DEVI void operator()(const AccT& acc, const Unit& u, int wr, int wc, int fr, int fq) const {
        const int b = u.pn >> 2, p4 = u.pn & 3;
#pragma unroll
        for (int ai = 0; ai < 2; ++ai)
#pragma unroll
            for (int m = 0; m < 4; ++m) {
                const int r = 256 * u.pm + 128 * ai + 64 * wr + 16 * m + fr;
                bf16_t* rowp = BR + (size_t)r * 4096 + b * 1024 + 256 * p4 + 32 * wc + 8 * fq;
#pragma unroll
                for (int bj = 0; bj < 2; ++bj) { const f32x4 v0 = acc[ai][bj][m][0], v1 = acc[ai][bj][m][1];
                    u32x4 w; w.x = pk2(v0[0], v0[1]); w.y = pk2(v0[2], v0[3]); w.z = pk2(v1[0], v1[1]); w.w = pk2(v1[2], v1[3]);
                    *(u32x4*)(rowp + 128 * bj) = w; }
            }
    } };
struct EpiGate { const bf16_t* BR; const float* ssq; bf16_t* ZY;
    DEVI void operator()(const AccT& acc, const Unit& u, int wr, int wc, int fr, int fq) const {
        const int c = 64 * u.pn + 16 * wc + 4 * fq;
#pragma unroll
        for (int ai = 0; ai < 2; ++ai) {
            float sq[4]; u32x2 w[4][4];
#pragma unroll
            for (int m = 0; m < 4; ++m) { const int r = 256 * u.pm + 128 * ai + 64 * wr + 16 * m + fr; sq[m] = ssq[r]; const bf16_t* brr = BR + (size_t)r * 4096 + c;
#pragma unroll
                for (int b = 0; b < 4; ++b) w[m][b] = *(const u32x2*)(brr + b * 1024); }
#pragma unroll
            for (int m = 0; m < 4; ++m) {
                const int r = 256 * u.pm + 128 * ai + 64 * wr + 16 * m + fr;
                const float rs = rsqrtf(sq[m] * (1.f / 1024.f) + 1e-6f);
                float o0 = 0.f, o1 = 0.f, o2 = 0.f, o3 = 0.f;
#pragma unroll
                for (int bj = 0; bj < 2; ++bj)
#pragma unroll
                    for (int n = 0; n < 2; ++n) { const u32x2 ww = w[m][2 * bj + n]; const f32x4 g = acc[ai][bj][m][n];
                        o0 += sigm(g[0] * rs) * bflo(ww.x); o1 += sigm(g[1] * rs) * bfhi(ww.x); o2 += sigm(g[2] * rs) * bflo(ww.y); o3 += sigm(g[3] * rs) * bfhi(ww.y); }
                u32x2 o; o.x = pk2(o0, o1); o.y = pk2(o2, o3);
                *(u32x2*)(ZY + (size_t)r * 1024 + c) = o;
            }
        }
    } };
template <int LAYER, bool ATOM = true> struct EpiOut { const float* xp; const float* xs; bf16_t* XB; float* yout; float* ssq;
    DEVI void operator()(const AccT& acc, const Unit& u, int wr, int wc, int fr, int fq) const {
        const int col0 = 256 * u.pn + 32 * wc + 8 * fq;
#pragma unroll
        for (int ai = 0; ai < 2; ++ai) {
            if (256 * u.pm + 128 * ai >= ROWS) continue;
            f32x4 rf[4][2][2]; u32x4 rb[4][2];
#pragma unroll
            for (int m = 0; m < 4; ++m) { const int r = 256 * u.pm + 128 * ai + 64 * wr + 16 * m + fr;
#pragma unroll
                for (int bj = 0; bj < 2; ++bj) { const int col = col0 + 128 * bj;
                    if (LAYER == 0) { const float* xr = (r < NTOK ? xp + (size_t)r * 1024 : xs + (size_t)(r - NTOK) * 1024) + col; rf[m][bj][0] = *(const f32x4*)xr; rf[m][bj][1] = *(const f32x4*)(xr + 4); }
                    else rb[m][bj] = *(const u32x4*)(XB + (size_t)r * 1024 + col); } }
            float part[4];
#pragma unroll
            for (int m = 0; m < 4; ++m) {
                const int r = 256 * u.pm + 128 * ai + 64 * wr + 16 * m + fr;
                float ps = 0.f;
#pragma unroll
                for (int bj = 0; bj < 2; ++bj) { const int col = col0 + 128 * bj; f32x4 v0 = acc[ai][bj][m][0], v1 = acc[ai][bj][m][1];
                    if (LAYER == 0) { v0 += rf[m][bj][0]; v1 += rf[m][bj][1];
                        u32x4 w; w.x = pk2(v0[0], v0[1]); w.y = pk2(v0[2], v0[3]); w.z = pk2(v1[0], v1[1]); w.w = pk2(v1[2], v1[3]);
                        *(u32x4*)(XB + (size_t)r * 1024 + col) = w;
                    } else { const u32x4 w = rb[m][bj];
                        v0[0] += bflo(w.x); v0[1] += bfhi(w.x); v0[2] += bflo(w.y); v0[3] += bfhi(w.y); v1[0] += bflo(w.z); v1[1] += bfhi(w.z); v1[2] += bflo(w.w); v1[3] += bfhi(w.w);
                        *(f32x4*)(yout + (size_t)r * 1024 + col) = v0; *(f32x4*)(yout + (size_t)r * 1024 + col + 4) = v1; }
                    ps += v0[0] * v0[0] + v0[1] * v0[1] + v0[2] * v0[2] + v0[3] * v0[3] + v1[0] * v1[0] + v1[1] * v1[1] + v1[2] * v1[2] + v1[3] * v1[3]; }
                part[m] = ps;
            }
#pragma unroll
            for (int m = 0; m < 4; ++m) { const int r = 256 * u.pm + 128 * ai + 64 * wr + 16 * m + fr; float p = part[m]; p += __shfl_xor(p, 16); p += __shfl_xor(p, 32); if (ATOM && fq == 0) atomicAdd(ssq + r, p); }
        }
    } };

DEVI void transpose_item(const float* W, int ldw, const float* gain, int kind, bf16_t* WT, int K, int n0, int k0, float* scr, int lane) {
    const int nl = lane & 31, n = n0 + nl;
    const int sc = (kind == 0) ? w1_src(n) : ((n & ~255) + natcol(n & 255));
    float tw[32], tg[32];
#pragma unroll
    for (int i = 0; i < 32; ++i) { const int kk = 2 * i + (lane >> 5); tw[i] = (sc >= 0) ? W[(size_t)(k0 + kk) * ldw + sc] : 0.f; tg[i] = gain ? gain[k0 + kk] : 1.f; }
#pragma unroll
    for (int i = 0; i < 32; ++i) { const int kk = 2 * i + (lane >> 5); scr[kk * 33 + nl] = tw[i] * tg[i]; }
    LDS_WAIT();
    const int c = lane & 7;
#pragma unroll
    for (int j = 0; j < 4; ++j) { const int nn = (lane >> 3) + 8 * j; const float* s = scr + (8 * c) * 33 + nn;
        u32x4 o; o.x = pk2(s[0], s[33]); o.y = pk2(s[66], s[99]); o.z = pk2(s[132], s[165]); o.w = pk2(s[198], s[231]);
        *(u32x4*)(WT + (size_t)(n0 + nn) * K + k0 + 8 * c) = o; }
    LDS_WAIT();
}
DEVI void weight_items(const Params& P, unsigned char* smem, int it0, int it1, int gw, int NGW) {
    const int tid = tidx(), wave = tid >> 6, lane = tid & 63;
    float* scr = (float*)(smem + wave * 16384);
    bf16_t* W1T = (bf16_t*)(P.ws + OFF_W1T); bf16_t* WBR = (bf16_t*)(P.ws + OFF_WBR); bf16_t* WOUT = (bf16_t*)(P.ws + OFF_WOUT);
    constexpr int I1 = 2 * 232 * 16, I2 = 8 * 32 * 4;
    for (int it = it0 + gw; it < it1; it += NGW) {
        int r = it;
        if (r < I1) { const int l = r / 3712, q = r % 3712, nb = q >> 4, kb = q & 15;
            transpose_item(P.in[I_WIN] + (size_t)l * 1024 * INC, INC, P.in[I_NG] + l * 1024, 0, W1T + (size_t)l * 7424 * 1024, 1024, nb * 32, kb * 64, scr, lane); continue; }
        r -= I1;
        if (r < I2) { const int lb = r >> 7, q = r & 127, nb = q >> 2, kb = q & 3;
            transpose_item(P.in[I_WBR] + (size_t)lb * 256 * 1024, 1024, nullptr, 1, WBR + (size_t)lb * 1024 * 256, 256, nb * 32, kb * 64, scr, lane); continue; }
        r -= I2;
        { const int l = r >> 9, q = r & 511, nb = q >> 4, kb = q & 15;
            transpose_item(P.in[I_WOUT] + (size_t)l * 1024 * 1024, 1024, nullptr, 2, WOUT + (size_t)l * 1024 * 1024, 1024, nb * 32, kb * 64, scr, lane); }
    }
}
constexpr int WI_EARLY = 104 * 16, WI_ALL = 2 * 232 * 16 + 8 * 32 * 4 + 2 * 32 * 16;
DEVI void phase_p0(const Params& P, unsigned char* smem) {
    const int tid = tidx(), wave = tid >> 6, lane = tid & 63;
    const int gw = blockIdx.x * 8 + wave, NGW = gridDim.x * 8;
    weight_items(P, smem, 0, WI_ALL, gw, NGW);
    { bf16_t* WLT = (bf16_t*)(P.ws + OFF_WLT);
      for (int i = blockIdx.x * 512 + tid; i < 65536; i += gridDim.x * 512) { const int l = i >> 15, g = (i >> 14) & 1, n = (i >> 12) & 3, dd = (i >> 6) & 63, cc = i & 63;
          WLT[i] = f2bf(P.in[g ? I_WX : I_WA][((l * 4 + n) * 64 + cc) * 64 + dd]); } }
    bf16_t* XB = (bf16_t*)(P.ws + OFF_XB); float* ssq = (float*)(P.ws + OFF_SSQ);
    for (int row = gw; row < MPAD; row += NGW) {
        f32x4 v[4]; float s = 0.f;
        if (row < ROWS) { const f32x4* xr = (const f32x4*)(row < NTOK ? P.in[I_XP] + (size_t)row * 1024 : P.in[I_XS] + (size_t)(row - NTOK) * 1024) + lane;
#pragma unroll
            for (int j = 0; j < 4; ++j) { v[j] = xr[64 * j]; s += v[j][0] * v[j][0] + v[j][1] * v[j][1] + v[j][2] * v[j][2] + v[j][3] * v[j][3]; }
        } else {
#pragma unroll
            for (int j = 0; j < 4; ++j) v[j] = (f32x4){0.f, 0.f, 0.f, 0.f};
        }
        s = wave_sum(s);
        u32x2* o = (u32x2*)(XB + (size_t)row * 1024) + lane;
#pragma unroll
        for (int j = 0; j < 4; ++j) { u32x2 w; w.x = pk2(v[j][0], v[j][1]); w.y = pk2(v[j][2], v[j][3]); o[64 * j] = w; }
        if (lane == 0) { ssq[row] = s; ssq[MPAD + row] = 0.f; ssq[2 * MPAD + row] = 0.f; }
    }
}

DEVI void rwkv_prep(const Params& P, int l, int item) {
    const int tid = tidx(), wave = tid >> 6, lane = tid & 63, slot = wave >> 2, h = wave & 3, c = h * 64 + lane;
    const bf16_t* PA = (const bf16_t*)(P.ws + OFF_PA); bf16_t* RWP = (bf16_t*)(P.ws + OFF_RWP); float* RWC = (float*)(P.ws + OFF_RWC);
    const bool samp = item >= 1024; const int row0 = samp ? NTOK + (item - 1024) * 4 : item * 16, nit = samp ? 2 : 8;
    const float* mu = P.in[I_MU] + l * 832;
    float wup[32], aup[32];
#pragma unroll
    for (int j = 0; j < 32; ++j) { wup[j] = P.in[I_WUP][(l * 32 + j) * 256 + c]; aup[j] = P.in[I_AUP][(l * 32 + j) * 256 + c]; }
    const float w0 = P.in[I_W0][l * 256 + c], a0 = P.in[I_A0][l * 256 + c], kkw = P.in[I_KK][l * 256 + c], kaw = P.in[I_KA][l * 256 + c], rkw = P.in[I_RK][l * 256 + c];
    const float mur = mu[c], muk = mu[256 + c], muv = mu[512 + c], mul = mu[768 + lane];
    float aur[8], auk[8], auv[8], aul[8], apr[8], apk[8], apv[8], apl[8];
#pragma unroll
    for (int it = 0; it < 8; ++it) { const int row = row0 + 2 * (it < nit ? it : 0) + slot; const bf16_t* up = PA + (size_t)row * PALD;
        if (samp) { const float* sp = P.in[I_SSHIFT] + (size_t)(l * 128 + (row - NTOK)) * 832; apr[it] = sp[c]; apk[it] = sp[256 + c]; apv[it] = sp[512 + c]; apl[it] = sp[768 + lane]; }
        else if ((row & 2047) == 0) { apr[it] = apk[it] = apv[it] = apl[it] = 0.f; }
        else { const bf16_t* pp = up - PALD; apr[it] = bf2f(pp[c]); apk[it] = bf2f(pp[256 + c]); apv[it] = bf2f(pp[512 + c]); apl[it] = bf2f(pp[768 + lane]); }
        aur[it] = bf2f(up[c]); auk[it] = bf2f(up[256 + c]); auv[it] = bf2f(up[512 + c]); aul[it] = bf2f(up[768 + lane]); }
#pragma unroll
    for (int it = 0; it < 8; ++it) {
        if (it >= nit) break;
        const int row = row0 + 2 * it + slot;
        const float ur = aur[it], uk = auk[it], uv = auv[it], ul = aul[it], pr = apr[it], pk = apk[it], pv = apv[it], pl = apl[it];
        const float r = ur + (pr - ur) * mur, k = uk + (pk - uk) * muk, v = uv + (pv - uv) * muv;
        float lo = ul + (pl - ul) * mul;
        const float lt = lane < 32 ? ftanh(lo) : lo;
        float wpre = w0, apre = a0;
#pragma unroll
        for (int j = 0; j < 32; ++j) { wpre += rdlane(lt, j) * wup[j]; apre += rdlane(lt, 32 + j) * aup[j]; }
        const float w = -softplus(-wpre) - 0.5f, lw = __expf(w);
        const float a = sigm(apre);
        const float kkr = k * kkw; const float kk = kkr * __builtin_amdgcn_rsqf(fmaxf(wave_sum(kkr * kkr), 1e-24f));
        const float kp = k * (1.f + (a - 1.f) * kaw), ka = kk * a;
        const float kaq = bf2f(f2bf(ka)), kpq = bf2f(f2bf(kp)), rq = bf2f(f2bf(r));
        const float c1 = wave_sum(kaq * rq), c2 = wave_sum(kpq * rq), c3 = wave_sum(r * kp * rkw);
        bf16_t* o = RWP + (size_t)row * 1536 + c;
        o[0] = f2bf(lw); o[256] = f2bf(kk); o[512] = f2bf(ka); o[768] = f2bf(kp); o[1024] = f2bf(r); o[1280] = f2bf(v);
        if (lane == 0) { float* cc = RWC + (size_t)row * 16 + h * 4; cc[0] = c1; cc[1] = c2; cc[2] = c3; }
    }
    if (samp) { for (int i = tid; i < 4 * 832; i += 512) { const int rr = i / 832, cc = i % 832; const int b = row0 - NTOK + rr; P.out[O_SHS + (size_t)(l * 128 + b) * 832 + cc] = bf2f(PA[(size_t)(row0 + rr) * PALD + cc]); } }
    else if (((row0 + 16) & 2047) == 0) { const int b = row0 >> 11; for (int i = tid; i < 832; i += 512) P.out[O_SHP + (size_t)(l * 8 + b) * 832 + i] = bf2f(PA[(size_t)(row0 + 15) * PALD + i]); }
}
DEVI void cache_copy(const Params& P, int l, int b) {
    const bf16_t* PA = (const bf16_t*)(P.ws + OFF_PA);
    for (int i = tidx(); i < 128 * 128; i += 512) { const int j = i >> 7, c = i & 127; const bf16_t* rp = PA + (size_t)(b * 2048 + 1920 + j) * PALD + CC + 256 + c;
        P.out[O_KP + (size_t)((l * 8 + b) * 128 + j) * 128 + c] = bf2f(rp[0]); P.out[O_VP + (size_t)((l * 8 + b) * 128 + j) * 128 + c] = bf2f(rp[128]); }
}
DEVI void lru_prep(const Params& P, int l, int item, float* sm) {
    const int tid = tidx(), b = item >> 6, ck = item & 63, t0 = ck * 32;
    const bf16_t* PA = (const bf16_t*)(P.ws + OFF_PA);
    float* xs = sm; float* xc = sm + 35 * 256;
    __syncthreads();
    { bf16_t tx[18];
#pragma unroll
      for (int k = 0; k < 18; ++k) { const int i = tid + 512 * k, tt = i >> 8, ch = i & 255, tk = t0 - 3 + tt; tx[k] = (i < 35 * 256 && tk >= 0) ? PA[(size_t)(b * 2048 + tk) * PALD + CD + ch] : (bf16_t)0; }
#pragma unroll
      for (int k = 0; k < 18; ++k) { const int i = tid + 512 * k; if (i < 35 * 256) xs[i] = bf2f(tx[k]); } }
    __syncthreads();
    const int d = tid & 255, half = tid >> 8;
    { const float cb = P.in[I_CBI][l * 256 + d], c0 = P.in[I_CW][(l * 4 + 0) * 256 + d], c1 = P.in[I_CW][(l * 4 + 1) * 256 + d], c2 = P.in[I_CW][(l * 4 + 2) * 256 + d], c3 = P.in[I_CW][(l * 4 + 3) * 256 + d];
        for (int t = half; t < 32; t += 2) xc[t * 256 + d] = cb + c0 * xs[t * 256 + d] + c1 * xs[(t + 1) * 256 + d] + c2 * xs[(t + 2) * 256 + d] + c3 * xs[(t + 3) * 256 + d]; }
    __syncthreads();
    const int n = d >> 6, dl = d & 63;
    if (ck == 63) for (int i = tid; i < 768; i += 512) P.out[O_CVP + (size_t)(l * 8 + b) * 768 + i] = xs[32 * 256 + i];
    __syncthreads();
    {
        const int wave = tid >> 6, lane = tid & 63, wn = wave & 3, gate = wave >> 2, lr = lane & 15, lq = lane >> 4;
        float* gp = gate ? (sm + 67 * 256) : xs;
        const bf16_t* WL = (const bf16_t*)(P.ws + OFF_WLT) + (size_t)((l * 2 + gate) * 4 + wn) * 4096;
        bf16x8 bfr[4][2]; float bsv[4];
#pragma unroll
        for (int dt = 0; dt < 4; ++dt) { bsv[dt] = P.in[gate ? I_BX : I_BA][l * 256 + 64 * wn + 16 * dt + lr];
#pragma unroll
            for (int ks2 = 0; ks2 < 2; ++ks2) bfr[dt][ks2] = *(const bf16x8*)(WL + (16 * dt + lr) * 64 + 32 * ks2 + 8 * lq); }
#pragma unroll
        for (int tt = 0; tt < 2; ++tt) {
            bf16x8 afr[2];
#pragma unroll
            for (int ks2 = 0; ks2 < 2; ++ks2) { const float* xr = xc + (16 * tt + lr) * 256 + 64 * wn + 32 * ks2 + 8 * lq; const f32x4 x0 = *(const f32x4*)xr, x1 = *(const f32x4*)(xr + 4);
                u32x4 pk; pk.x = pk2(x0[0], x0[1]); pk.y = pk2(x0[2], x0[3]); pk.z = pk2(x1[0], x1[1]); pk.w = pk2(x1[2], x1[3]); afr[ks2] = __builtin_bit_cast(bf16x8, pk); }
#pragma unroll
            for (int dt = 0; dt < 4; ++dt) { f32x4 acc = {0.f, 0.f, 0.f, 0.f};
                acc = __builtin_amdgcn_mfma_f32_16x16x32_bf16(afr[0], bfr[dt][0], acc, 0, 0, 0); acc = __builtin_amdgcn_mfma_f32_16x16x32_bf16(afr[1], bfr[dt][1], acc, 0, 0, 0);
#pragma unroll
                for (int g = 0; g < 4; ++g) gp[(16 * tt + 4 * lq + g) * 256 + 64 * wn + 16 * dt + lr] = acc[g] + bsv[dt]; }
        }
    }
    __syncthreads();
    const float lsl = 8.f * logsig_acc(P.in[I_LAM][l * 256 + d]);
    float* LH = P.out + SO_LH; float* LP = P.out + SO_LP; float* LA = P.out + SO_LA; float* LB = P.out + SO_LB;
    const float* gr = xs; const float* gi = sm + 67 * 256;
    float hh = 0.f, pp = 1.f;
#pragma nounroll
    for (int tt = 0; tt < 16; ++tt) {
        const int t = half * 16 + tt;
        const float la = lsl * sigm(gr[t * 256 + d]), a = __expf(la), bt = __builtin_amdgcn_sqrtf(fmaxf(1.f - a * a, 0.f)) * sigm(gi[t * 256 + d]) * xc[t * 256 + d];
        hh = a * hh + bt; pp *= a;
        const size_t row = (size_t)b * 2048 + t0 + t; LH[row * 256 + d] = hh; LP[row * 256 + d] = pp;
    }
    const int sub = ck * 2 + half; LA[(size_t)(b * 128 + sub) * 256 + d] = pp; LB[(size_t)(b * 128 + sub) * 256 + d] = hh;
}
DEVI void gla_load_cum(const Params& P, int l, int h, int row0, float* gs, float* gl, float* seg) {
    const int tid = tidx(); const bf16_t* PA = (const bf16_t*)(P.ws + OFF_PA);
    { bf16_t t0 = PA[(size_t)(row0 + (tid >> 4)) * PALD + CB + 512 + (tid & 15)], t1 = PA[(size_t)(row0 + 32 + (tid >> 4)) * PALD + CB + 512 + (tid & 15)]; gl[tid] = bf2f(t0); gl[tid + 512] = bf2f(t1); }
    __syncthreads();
    const int d = tid & 31, sg = tid >> 5;
    float upc[16];
#pragma unroll
    for (int j = 0; j < 16; ++j) upc[j] = P.in[I_GUP][(l * 16 + j) * 128 + h * 32 + d];
    const float bias = P.in[I_GB][l * 128 + h * 32 + d];
    float run = 0.f, gv[4];
#pragma unroll
    for (int tt = 0; tt < 4; ++tt) { const int t = sg * 4 + tt; float x = bias;
#pragma unroll
        for (int j = 0; j < 16; ++j) x += gl[t * 16 + j] * upc[j];
        run += logsig(x) * (1.f / 16.f); gv[tt] = run; }
    seg[sg * 32 + d] = run;
    __syncthreads();
    float pre = 0.f; for (int s2 = 0; s2 < sg; ++s2) pre += seg[s2 * 32 + d];
#pragma unroll
    for (int tt = 0; tt < 4; ++tt) gs[(sg * 4 + tt) * 32 + d] = gv[tt] + pre;
    __syncthreads();
}
DEVI void gla_prep(const Params& P, int l, int item, float* sm) {
    const int tid = tidx(), c = item & 31, h = (item >> 5) & 3, b = item >> 7, row0 = b * 2048 + c * 64;
    const bf16_t* PA = (const bf16_t*)(P.ws + OFF_PA);
    float* gs = sm; float* ks = sm + 2048; float* vs = sm + 4096; float* gl = sm + 8192; float* seg = sm + 9216;
    __syncthreads();
    { bf16_t tk[4], tv[8];
#pragma unroll
      for (int k = 0; k < 4; ++k) { const int i = tid + 512 * k, t = i >> 5, d = i & 31; tk[k] = PA[(size_t)(row0 + t) * PALD + CB + 128 + h * 32 + d]; }
#pragma unroll
      for (int k = 0; k < 8; ++k) { const int i = tid + 512 * k, t = i >> 6, e = i & 63; tv[k] = PA[(size_t)(row0 + t) * PALD + CB + 256 + h * 64 + e]; }
#pragma unroll
      for (int k = 0; k < 4; ++k) ks[tid + 512 * k] = bf2f(tk[k]);
#pragma unroll
      for (int k = 0; k < 8; ++k) vs[tid + 512 * k] = bf2f(tv[k]); }
    gla_load_cum(P, l, h, row0, gs, gl, seg);
    for (int i = tid; i < 2048; i += 512) { const int d = i & 31; ks[i] *= __expf(gs[63 * 32 + d] - gs[i]); }
    __syncthreads();
    { const int d = tid >> 4, e4 = (tid & 15) * 4; f32x4 u = {0.f, 0.f, 0.f, 0.f};
        for (int t = 0; t < 64; ++t) { const float kd = ks[t * 32 + d]; const f32x4 v4 = *(const f32x4*)(vs + t * 64 + e4); u += v4 * kd; }
        *(f32x4*)(P.out + SO_GU + (size_t)item * 2048 + d * 64 + e4) = u; }
    if (tid < 32) P.out[SO_GD + (size_t)item * 32 + tid] = __expf(gs[63 * 32 + tid]);
}

DEVI void rwkv_scan_prompt(const Params& P, int l, int item, float* sm) {
    const int b = item >> 4, h = (item >> 2) & 3, q = item & 3;
    const int tid = tidx(), wave = tid >> 6, lane = tid & 63;
    const bf16_t* RWP = (const bf16_t*)(P.ws + OFF_RWP); const float* RWC = (const float*)(P.ws + OFF_RWC); float* RWO = P.out + SO_RWO;
    constexpr int T = 32, BUF = 5 * T * 64 + T * 16 + T * 2;
    const size_t rbase = (size_t)b * 2048;
    float* buf0 = sm; float* buf1 = sm + BUF;
    auto load_chunk = [&](int c, float* buf) {
        const int lt = tid - 256, ch = lt & 63, tq = lt >> 6;
        bf16_t raw[8][5], rv[2]; float rc = 0.f;
#pragma unroll
        for (int i = 0; i < 8; ++i) { const int t = tq + 4 * i; const bf16_t* rp = RWP + (rbase + c * T + t) * 1536 + h * 64 + ch;
            raw[i][0] = rp[0]; raw[i][1] = rp[256]; raw[i][2] = rp[512]; raw[i][3] = rp[768]; raw[i][4] = rp[1024]; }
#pragma unroll
        for (int i = 0; i < 2; ++i) { const int t = (lt >> 4) + 16 * i, rr = lt & 15; rv[i] = RWP[(rbase + c * T + t) * 1536 + 1280 + h * 64 + 16 * q + rr]; }
        if (lt < 64) { const int t = lt >> 1, j = lt & 1; rc = RWC[(rbase + c * T + t) * 16 + h * 4 + j]; }
#pragma unroll
        for (int i = 0; i < 8; ++i) { const int t = tq + 4 * i;
            const float lw = bf2f(raw[i][0]), kk = bf2f(raw[i][1]), ka = bf2f(raw[i][2]), kp = bf2f(raw[i][3]), r = bf2f(raw[i][4]); const float dd = __expf(-lw);
            buf[t * 64 + ch] = dd; buf[T * 64 + t * 64 + ch] = dd * r; buf[2 * T * 64 + t * 64 + ch] = kk; buf[3 * T * 64 + t * 64 + ch] = ka; buf[4 * T * 64 + t * 64 + ch] = kp; }
#pragma unroll
        for (int i = 0; i < 2; ++i) { const int t = (lt >> 4) + 16 * i, rr = lt & 15; buf[5 * T * 64 + t * 16 + rr] = bf2f(rv[i]); }
        if (lt < 64) { const int t = lt >> 1, j = lt & 1; buf[5 * T * 64 + T * 16 + t * 2 + j] = rc; }
    };
    __syncthreads();
    if (tid >= 256) load_chunk(0, buf0);
    __syncthreads();
    const int rowgrp = lane >> 4, ks = lane & 15, vloc = 4 * wave + rowgrp, vrow = 16 * q + vloc;
    f32x4 S = {0.f, 0.f, 0.f, 0.f};
    for (int c = 0; c < SEQ / T; ++c) {
        float* cur = (c & 1) ? buf1 : buf0; float* nxt = (c & 1) ? buf0 : buf1;
        if (tid >= 256) { if (c + 1 < SEQ / T) load_chunk(c + 1, nxt); }
        else {
            const float* cb = cur + 4 * ks;
            f32x4 d4 = *(const f32x4*)(cb), dr4 = *(const f32x4*)(cb + T * 64), kk4 = *(const f32x4*)(cb + 2 * T * 64), ka4 = *(const f32x4*)(cb + 3 * T * 64), kp4 = *(const f32x4*)(cb + 4 * T * 64);
            float vv = cur[5 * T * 64 + vloc]; f32x2 cc = *(const f32x2*)(cur + 5 * T * 64 + T * 16);
            float* op = RWO + (rbase + (size_t)c * T) * 256 + h * 64 + vrow;
#pragma unroll 16
            for (int t = 0; t < T; ++t) {
                const float* nb = cb + (t + 1) * 64;
                const f32x4 nd4 = *(const f32x4*)(nb), ndr4 = *(const f32x4*)(nb + T * 64), nkk4 = *(const f32x4*)(nb + 2 * T * 64), nka4 = *(const f32x4*)(nb + 3 * T * 64), nkp4 = *(const f32x4*)(nb + 4 * T * 64);
                const float nvv = cur[5 * T * 64 + (t + 1) * 16 + vloc]; const f32x2 ncc = *(const f32x2*)(cur + 5 * T * 64 + T * 16 + (t + 1) * 2);
                const f32x2 t1 = S.lo * kk4.lo + S.hi * kk4.hi, t2 = S.lo * dr4.lo + S.hi * dr4.hi;
                float p1 = t1.x + t1.y, p2 = t2.x + t2.y;
                p1 = reduce16(p1); p2 = reduce16(p2);
                const float sa = -p1;
                S = S * d4 + ka4 * sa + kp4 * vv;
                op[t * 256] = p2 + sa * cc[0] + vv * cc[1];
                d4 = nd4; dr4 = ndr4; kk4 = nkk4; ka4 = nka4; kp4 = nkp4; vv = nvv; cc = ncc;
            }
        }
        __syncthreads();
    }
    if (tid < 256) *(f32x4*)(P.out + O_WKVP + ((size_t)((l * 8 + b) * 4 + h) * 64 + vrow) * 64 + 4 * ks) = S;
}
DEVI void rwkv_scan_sample(const Params& P, int l, int item) {
    const int tid = tidx(), wave = tid >> 6, lane = tid & 63, pair = item * 8 + wave, b = pair >> 2, h = pair & 3;
    const bf16_t* RWP = (const bf16_t*)(P.ws + OFF_RWP); const float* RWC = (const float*)(P.ws + OFF_RWC); float* RWO = P.out + SO_RWO;
    const size_t row = NTOK + b; const int rowgrp = lane >> 4, ks = lane & 15;
    const bf16_t* rp = RWP + row * 1536 + h * 64 + 4 * ks;
    f32x4 d4, dr4, kk4, ka4, kp4;
#pragma unroll
    for (int j = 0; j < 4; ++j) { const float lw = bf2f(rp[j]), r = bf2f(rp[1024 + j]); d4[j] = __expf(-lw); dr4[j] = d4[j] * r; kk4[j] = bf2f(rp[256 + j]); ka4[j] = bf2f(rp[512 + j]); kp4[j] = bf2f(rp[768 + j]); }
    const float c1 = RWC[row * 16 + h * 4], c2 = RWC[row * 16 + h * 4 + 1];
    const float* S0 = P.in[I_SWKV] + (size_t)((l * 128 + b) * 4 + h) * 4096; float* S1 = P.out + O_WKVS + (size_t)((l * 128 + b) * 4 + h) * 4096;
    f32x4 Sv[16]; bf16_t vr[16];
#pragma unroll
    for (int it = 0; it < 16; ++it) { const int vrow = 4 * it + rowgrp; Sv[it] = *(const f32x4*)(S0 + vrow * 64 + 4 * ks); vr[it] = RWP[row * 1536 + 1280 + h * 64 + vrow]; }
#pragma unroll
    for (int it = 0; it < 16; ++it) {
        const int vrow = 4 * it + rowgrp;
        f32x4 S = Sv[it];
        const float vv = bf2f(vr[it]);
        float p1 = (S[0] * kk4[0] + S[1] * kk4[1]) + (S[2] * kk4[2] + S[3] * kk4[3]);
        float p2 = (S[0] * dr4[0] + S[1] * dr4[1]) + (S[2] * dr4[2] + S[3] * dr4[3]);
        p1 = reduce16(p1); p2 = reduce16(p2);
        const float sa = -p1;
        S = S * d4 + ka4 * sa + kp4 * vv;
        *(f32x4*)(S1 + vrow * 64 + 4 * ks) = S;
        RWO[row * 256 + h * 64 + vrow] = p2 + sa * c1 + vv * c2;
    }
}
DEVI void gla_prefix(const Params& P, int l, int bh) {
    const int idx = tidx() * 4, d = idx >> 6;
    float* GU = P.out + SO_GU; const float* GD = P.out + SO_GD;
    f32x4 S = {0.f, 0.f, 0.f, 0.f};
#pragma nounroll
    for (int c0 = 0; c0 < 32; c0 += 8) {
        f32x4 U[8]; float dd[8];
#pragma unroll
        for (int c = 0; c < 8; ++c) { const size_t it = (size_t)bh * 32 + c0 + c; U[c] = *(const f32x4*)(GU + it * 2048 + idx); dd[c] = GD[it * 32 + d]; }
#pragma unroll
        for (int c = 0; c < 8; ++c) { const size_t it = (size_t)bh * 32 + c0 + c; *(f32x4*)(GU + it * 2048 + idx) = S; S = S * dd[c] + U[c]; }
    }
    *(f32x4*)(P.out + O_GLP + (size_t)(l * 32 + bh) * 2048 + idx) = S;
}
DEVI void lru_carry(const Params& P, int l, int b) {
    if (tidx() >= 256) return;
    const int d = tidx(); const float* LA = P.out + SO_LA; float* LB = P.out + SO_LB;
    float carry = 0.f;
#pragma nounroll
    for (int s0 = 0; s0 < 128; s0 += 32) {
        float A[32], Bv[32];
#pragma unroll
        for (int s = 0; s < 32; ++s) { const size_t o = (size_t)(b * 128 + s0 + s) * 256 + d; A[s] = LA[o]; Bv[s] = LB[o]; }
#pragma unroll
        for (int s = 0; s < 32; ++s) { const size_t o = (size_t)(b * 128 + s0 + s) * 256 + d; LB[o] = carry; carry = A[s] * carry + Bv[s]; }
    }
    P.out[O_HP + (size_t)(l * 8 + b) * 256 + d] = carry;
}
template <bool DRY = false> DEVI void swa_prompt(const Params& P, int l, int item, float* sm) {
    const bool dost = !DRY || (P.ws == nullptr);
    const int tid = tidx(), b = item >> 6, kv = (item >> 5) & 1, qb = item & 31, t0 = qb * 64;
    const bf16_t* PA = (const bf16_t*)(P.ws + OFF_PA); bf16_t* ZY = (bf16_t*)(P.ws + OFF_ZY);
    float* Ks = sm; float* Vs = sm + 192 * 68;
    __syncthreads();
    u32x4 kwa[3], vwa[3];
#pragma unroll
    for (int k = 0; k < 3; ++k) { const int i = tid + 512 * k, ls = i >> 3, c8 = (i & 7) * 8, s = t0 - 128 + ls; kwa[k] = (u32x4){0u, 0u, 0u, 0u}; vwa[k] = (u32x4){0u, 0u, 0u, 0u};
        if (s >= 0) { const bf16_t* rp = PA + (size_t)(b * 2048 + s) * PALD + CC + 256 + kv * 64 + c8; kwa[k] = *(const u32x4*)rp; vwa[k] = *(const u32x4*)(rp + 128); } }
#pragma unroll
    for (int k = 0; k < 3; ++k) { const int i = tid + 512 * k, ls = i >> 3, c8 = (i & 7) * 8; const u32x4 kw = kwa[k], vw = vwa[k];
        *(f32x4*)(Ks + ls * 68 + c8) = (f32x4){bflo(kw.x), bfhi(kw.x), bflo(kw.y), bfhi(kw.y)}; *(f32x4*)(Ks + ls * 68 + c8 + 4) = (f32x4){bflo(kw.z), bfhi(kw.z), bflo(kw.w), bfhi(kw.w)};
        *(f32x4*)(Vs + ls * 68 + c8) = (f32x4){bflo(vw.x), bfhi(vw.x), bflo(vw.y), bfhi(vw.y)}; *(f32x4*)(Vs + ls * 68 + c8 + 4) = (f32x4){bflo(vw.z), bfhi(vw.z), bflo(vw.w), bfhi(vw.w)}; }
    __syncthreads();
    const int rowid = tid >> 2, part = tid & 3, g = rowid & 1, qi = rowid >> 1, hh = kv * 2 + g, t = t0 + qi;
    const size_t row = (size_t)b * 2048 + t;
    f32x2 q2[8];
    { const u32x4* qp = (const u32x4*)(PA + row * PALD + CC + hh * 64 + 16 * part);
#pragma unroll
        for (int i = 0; i < 2; ++i) { const u32x4 w = qp[i]; q2[4 * i] = (f32x2){bflo(w.x), bfhi(w.x)} * 0.125f; q2[4 * i + 1] = (f32x2){bflo(w.y), bfhi(w.y)} * 0.125f;
            q2[4 * i + 2] = (f32x2){bflo(w.z), bfhi(w.z)} * 0.125f; q2[4 * i + 3] = (f32x2){bflo(w.w), bfhi(w.w)} * 0.125f; } }
    const float slope = exp2f(-2.f * (float)(hh + 1));
    float m = -1e30f, lsum = 0.f; f32x2 acc2[8];
#pragma unroll
    for (int i = 0; i < 8; ++i) acc2[i] = (f32x2){0.f, 0.f};
    const int j0 = (t < 128) ? (128 - t) : 0;
    for (int j = j0; j <= 128; ++j) {
        const float* kr = Ks + (qi + j) * 68 + 16 * part;
        f32x2 s2 = {0.f, 0.f};
#pragma unroll
        for (int i = 0; i < 4; ++i) { const f32x4 k4 = *(const f32x4*)(kr + 4 * i); s2 += q2[2 * i] * k4.lo; s2 += q2[2 * i + 1] * k4.hi; }
        const float sc = quad_sum(s2.x + s2.y) - slope * (float)(128 - j);
        if (sc > m) { const float corr = __expf(m - sc); lsum *= corr;
#pragma unroll
            for (int i = 0; i < 8; ++i) acc2[i] *= corr;
            m = sc; }
        const float p = __expf(sc - m); lsum += p;
        const float* vr = Vs + (qi + j) * 68 + 16 * part;
#pragma unroll
        for (int i = 0; i < 4; ++i) { const f32x4 v4 = *(const f32x4*)(vr + 4 * i); acc2[2 * i] += v4.lo * p; acc2[2 * i + 1] += v4.hi * p; }
    }
    float acc[16];
#pragma unroll
    for (int i = 0; i < 8; ++i) { acc[2 * i] = acc2[i].x; acc[2 * i + 1] = acc2[i].y; }
    const float sk = P.in[I_SINK][l * 4 + hh], mf = fmaxf(m, sk), e = __expf(m - mf), inv = e * frcp(lsum * e + __expf(sk - mf));
    bf16_t* zp = ZY + row * 1024 + 512 + hh * 64 + 16 * part;
    const u32x4 z0 = *(const u32x4*)zp, z1 = *(const u32x4*)(zp + 8);
    float o[16];
#pragma unroll
    for (int i = 0; i < 16; ++i) o[i] = acc[i] * inv;
    u32x4 w0, w1;
    w0.x = pk2(o[0] * silu(bflo(z0.x)), o[1] * silu(bfhi(z0.x))); w0.y = pk2(o[2] * silu(bflo(z0.y)), o[3] * silu(bfhi(z0.y)));
    w0.z = pk2(o[4] * silu(bflo(z0.z)), o[5] * silu(bfhi(z0.z))); w0.w = pk2(o[6] * silu(bflo(z0.w)), o[7] * silu(bfhi(z0.w)));
    w1.x = pk2(o[8] * silu(bflo(z1.x)), o[9] * silu(bfhi(z1.x))); w1.y = pk2(o[10] * silu(bflo(z1.y)), o[11] * silu(bfhi(z1.y)));
    w1.z = pk2(o[12] * silu(bflo(z1.z)), o[13] * silu(bfhi(z1.z))); w1.w = pk2(o[14] * silu(bflo(z1.w)), o[15] * silu(bfhi(z1.w)));
    if (dost) { *(u32x4*)zp = w0; *(u32x4*)(zp + 8) = w1; }
}
DEVI void swa_sample(const Params& P, int l, int b, float* sm) {
    const int tid = tidx(), wave = tid >> 6, lane = tid & 63; const size_t row = NTOK + b;
    const bf16_t* PA = (const bf16_t*)(P.ws + OFF_PA); bf16_t* ZY = (bf16_t*)(P.ws + OFF_ZY);
    float* qs = sm; float* kn = sm + 256; float* vn = sm + 384; float* sc = sm + 512;
    const float* CK = P.in[I_CK] + (size_t)(l * 128 + b) * 16384; const float* CV = P.in[I_CV] + (size_t)(l * 128 + b) * 16384;
    __syncthreads();
    { const float v = bf2f(PA[row * PALD + CC + tid]); if (tid < 256) qs[tid] = v * 0.125f; else if (tid < 384) kn[tid - 256] = v; else vn[tid - 384] = v; }
    __syncthreads();
    { const int hh = tid >> 7, s = tid & 127, kv = hh >> 1; const f32x4* kp = (const f32x4*)(CK + s * 128 + kv * 64); const float* qh = qs + hh * 64; float d = 0.f;
#pragma unroll
        for (int i = 0; i < 16; ++i) { const f32x4 k4 = kp[i]; d += qh[4 * i] * k4[0] + qh[4 * i + 1] * k4[1] + qh[4 * i + 2] * k4[2] + qh[4 * i + 3] * k4[3]; }
        sc[hh * 132 + s] = d - exp2f(-2.f * (float)(hh + 1)) * (float)(128 - s); }
    if (wave < 4) { const int hh = wave; const float d = wave_sum(qs[hh * 64 + lane] * kn[(hh >> 1) * 64 + lane]); if (lane == 0) sc[hh * 132 + 128] = d; }
    __syncthreads();
    if (wave < 4) { const int hh = wave; const float a0 = sc[hh * 132 + lane], a1 = sc[hh * 132 + 64 + lane], a2 = lane == 0 ? sc[hh * 132 + 128] : -1e30f, sk = P.in[I_SINK][l * 4 + hh];
        const float mx = fmaxf(wave_max(fmaxf(fmaxf(a0, a1), a2)), sk); const float e0 = __expf(a0 - mx), e1 = __expf(a1 - mx), e2 = lane == 0 ? __expf(a2 - mx) : 0.f;
        const float inv = frcp(wave_sum(e0 + e1 + e2) + __expf(sk - mx));
        sc[hh * 132 + lane] = e0 * inv; sc[hh * 132 + 64 + lane] = e1 * inv; if (lane == 0) sc[hh * 132 + 128] = e2 * inv; }
    __syncthreads();
    if (tid < 256) { const int hh = tid >> 6, dd = tid & 63, kv = hh >> 1; const float* pp = sc + hh * 132; float o = pp[128] * vn[kv * 64 + dd];
#pragma nounroll
        for (int s0 = 0; s0 < 128; s0 += 32) { float cvv[32];
#pragma unroll
            for (int s = 0; s < 32; ++s) cvv[s] = CV[(s0 + s) * 128 + kv * 64 + dd];
#pragma unroll
            for (int s = 0; s < 32; ++s) o += pp[s0 + s] * cvv[s]; }
        bf16_t* zp = ZY + row * 1024 + 512 + tid; *zp = f2bf(o * silu(bf2f(*zp))); }
    float* KO = P.out + O_KS + (size_t)(l * 128 + b) * 16384; float* VO = P.out + O_VS + (size_t)(l * 128 + b) * 16384;
    { f32x4 tk[8], tv[8];
#pragma unroll
      for (int k = 0; k < 8; ++k) { const int e = (tid + 512 * k) * 4;
        if (e < 127 * 128) { tk[k] = *(const f32x4*)(CK + 128 + e); tv[k] = *(const f32x4*)(CV + 128 + e); }
        else { tk[k] = *(const f32x4*)(kn + (e - 127 * 128)); tv[k] = *(const f32x4*)(vn + (e - 127 * 128)); } }
#pragma unroll
      for (int k = 0; k < 8; ++k) { const int e = (tid + 512 * k) * 4; *(f32x4*)(KO + e) = tk[k]; *(f32x4*)(VO + e) = tv[k]; } }
}
DEVI void gla_sample(const Params& P, int l, int b, float* sm) {
    const int tid = tidx(); const size_t row = NTOK + b;
    const bf16_t* PA = (const bf16_t*)(P.ws + OFF_PA); bf16_t* ZY = (bf16_t*)(P.ws + OFF_ZY);
    float* qs = sm; float* ks = sm + 128; float* eg = sm + 256; float* gl = sm + 384;
    __syncthreads();
    if (tid < 128) { qs[tid] = bf2f(PA[row * PALD + CB + tid]) * 0.17677669529663687f; ks[tid] = bf2f(PA[row * PALD + CB + 128 + tid]); }
    if (tid >= 128 && tid < 144) gl[tid - 128] = bf2f(PA[row * PALD + CB + 512 + tid - 128]);
    __syncthreads();
    if (tid < 128) { float x = P.in[I_GB][l * 128 + tid];
#pragma unroll
        for (int j = 0; j < 16; ++j) x += gl[j] * P.in[I_GUP][(l * 16 + j) * 128 + tid];
        eg[tid] = __expf(logsig(x) * (1.f / 16.f)); }
    __syncthreads();
    if (tid < 256) { const int h = tid >> 6, e = tid & 63; const float v = bf2f(PA[row * PALD + CB + 256 + tid]);
        const float* S0 = P.in[I_SGLA] + (size_t)((l * 128 + b) * 4 + h) * 2048; float* S1 = P.out + O_GLS + (size_t)((l * 128 + b) * 4 + h) * 2048;
        float o = 0.f, s0v[32];
#pragma unroll
        for (int d = 0; d < 32; ++d) s0v[d] = S0[d * 64 + e];
#pragma unroll
        for (int d = 0; d < 32; ++d) { const float sn = eg[h * 32 + d] * s0v[d] + ks[h * 32 + d] * v; S1[d * 64 + e] = sn; o += qs[h * 32 + d] * sn; }
        const float rr = rsqrtf(wave_sum(o * o) * (1.f / 64.f) + 1e-6f);
        bf16_t* zp = ZY + row * 1024 + 256 + tid; *zp = f2bf(o * rr * P.in[I_GNG][l * 64 + e] * silu(bf2f(*zp))); }
}
DEVI void lru_sample(const Params& P, int l, int item, float* sm) {
    const int tid = tidx(), s = tid >> 8, d = tid & 255, b = item * 2 + s; const size_t row = NTOK + b;
    const bf16_t* PA = (const bf16_t*)(P.ws + OFF_PA); bf16_t* ZY = (bf16_t*)(P.ws + OFF_ZY);
    float* xcs = sm;
    __syncthreads();
    const float x = bf2f(PA[row * PALD + CD + d]); const float* cv = P.in[I_SCONV] + (size_t)(l * 128 + b) * 768;
    const float c0 = cv[d], c1 = cv[256 + d], c2 = cv[512 + d];
    const float xc = P.in[I_CBI][l * 256 + d] + P.in[I_CW][(l * 4 + 0) * 256 + d] * c0 + P.in[I_CW][(l * 4 + 1) * 256 + d] * c1 + P.in[I_CW][(l * 4 + 2) * 256 + d] * c2 + P.in[I_CW][(l * 4 + 3) * 256 + d] * x;
    xcs[s * 256 + d] = xc;
    __syncthreads();
    const int n = d >> 6, dl = d & 63; float rp = P.in[I_BA][l * 256 + d], ip = P.in[I_BX][l * 256 + d];
#pragma unroll 8
    for (int c = 0; c < 64; ++c) { const float xv = xcs[s * 256 + n * 64 + c]; rp += xv * P.in[I_WA][((l * 4 + n) * 64 + c) * 64 + dl]; ip += xv * P.in[I_WX][((l * 4 + n) * 64 + c) * 64 + dl]; }
    const float la = 8.f * logsig_acc(P.in[I_LAM][l * 256 + d]) * sigm(rp), a = __expf(la), bt = __builtin_amdgcn_sqrtf(fmaxf(-expm1f(2.f * la), 0.f)) * sigm(ip) * xc;
    const float hn = a * P.in[I_SH][(size_t)(l * 128 + b) * 256 + d] + bt;
    float* co = P.out + O_CVS + (size_t)(l * 128 + b) * 768; co[d] = c1; co[256 + d] = c2; co[512 + d] = x;
    P.out[O_HS + (size_t)(l * 128 + b) * 256 + d] = hn;
    bf16_t* zp = ZY + row * 1024 + 768 + d; *zp = f2bf(hn * silu(bf2f(*zp)));
}

template <bool DRY = false> DEVI void rwkv_post(const Params& P, int l, int item) {
    const bool dost = !DRY || (P.ws == nullptr);
    const int tid = tidx(), wave = tid >> 6, lane = tid & 63;
    const bf16_t* RWP = (const bf16_t*)(P.ws + OFF_RWP); const float* RWC = (const float*)(P.ws + OFF_RWC); const float* RWO = P.out + SO_RWO; bf16_t* ZY = (bf16_t*)(P.ws + OFF_ZY);
    float o[8], v[8], z[8], c3[8];
#pragma unroll
    for (int k = 0; k < 8; ++k) { const int task = wave * 8 + k, h = task & 3; const size_t row = (size_t)item * 16 + (task >> 2);
        o[k] = RWO[row * 256 + h * 64 + lane]; v[k] = bf2f(RWP[row * 1536 + 1280 + h * 64 + lane]); z[k] = bf2f(ZY[row * 1024 + h * 64 + lane]); c3[k] = RWC[row * 16 + h * 4 + 2]; }
#pragma unroll
    for (int k = 0; k < 8; ++k) { const int task = wave * 8 + k, h = task & 3; const size_t row = (size_t)item * 16 + (task >> 2);
        const float mean = wave_sum(o[k]) * (1.f / 64.f); const float dv = o[k] - mean; const float var = wave_sum(dv * dv) * (1.f / 64.f);
        const float y = dv * rsqrtf(var + 64e-5f) * P.in[I_LNG][l * 256 + h * 64 + lane] + P.in[I_LNB][l * 256 + h * 64 + lane] + c3[k] * v[k];
        if (dost) ZY[row * 1024 + h * 64 + lane] = f2bf(y * silu(z[k])); }
}
template <bool DRY = false> DEVI void lru_final(const Params& P, int l, int item) {
    const bool dost = !DRY || (P.ws == nullptr);
    const int tid = tidx(), b = item >> 6, ck = item & 63, d = tid & 255, half = tid >> 8, sub = ck * 2 + half;
    const float* LH = P.out + SO_LH; const float* LP = P.out + SO_LP; const float* LB = P.out + SO_LB; bf16_t* ZY = (bf16_t*)(P.ws + OFF_ZY);
    const float carry = LB[(size_t)(b * 128 + sub) * 256 + d];
    const size_t r0 = (size_t)b * 2048 + ck * 32 + half * 16;
    float hv[16], z[16];
#pragma unroll
    for (int tt = 0; tt < 16; ++tt) { hv[tt] = LH[(r0 + tt) * 256 + d] + LP[(r0 + tt) * 256 + d] * carry; z[tt] = bf2f(ZY[(r0 + tt) * 1024 + 768 + d]); }
#pragma unroll
    for (int tt = 0; tt < 16; ++tt) if (dost) ZY[(r0 + tt) * 1024 + 768 + d] = f2bf(hv[tt] * silu(z[tt]));
}
template <bool DRY = false> DEVI void gla_out(const Params& P, int l, int item, float* sm) {
    const bool dost = !DRY || (P.ws == nullptr);
    const int tid = tidx(), c = item & 31, h = (item >> 5) & 3, b = item >> 7, row0 = b * 2048 + c * 64;
    const bf16_t* PA = (const bf16_t*)(P.ws + OFF_PA); bf16_t* ZY = (bf16_t*)(P.ws + OFF_ZY);
    float* gs = sm; float* gl = sm + 2048; float* seg = sm + 3072; float* qs = sm + 3584; float* ks = qs + 64 * 36; float* vs = ks + 64 * 36; float* att = vs + 4096; float* Ss = att + 64 * 65;
    __syncthreads();
    { bf16_t tq[4], tk[4], tv[8]; float ts[4];
#pragma unroll
      for (int k = 0; k < 4; ++k) { const int i = tid + 512 * k, t = i >> 5, d = i & 31; const bf16_t* rp = PA + (size_t)(row0 + t) * PALD + CB + h * 32 + d; tq[k] = rp[0]; tk[k] = rp[128]; ts[k] = P.out[SO_GU + (size_t)item * 2048 + i]; }
#pragma unroll
      for (int k = 0; k < 8; ++k) { const int i = tid + 512 * k, t = i >> 6, e = i & 63; tv[k] = PA[(size_t)(row0 + t) * PALD + CB + 256 + h * 64 + e]; }
#pragma unroll
      for (int k = 0; k < 4; ++k) { const int i = tid + 512 * k, t = i >> 5, d = i & 31; qs[t * 36 + d] = bf2f(tq[k]) * 0.17677669529663687f; ks[t * 36 + d] = bf2f(tk[k]); Ss[i] = ts[k]; }
#pragma unroll
      for (int k = 0; k < 8; ++k) vs[tid + 512 * k] = bf2f(tv[k]); }
    gla_load_cum(P, l, h, row0, gs, gl, seg);
    for (int i = tid; i < 2048; i += 512) { const int t = i >> 5, d = i & 31; const float bc = gs[i]; qs[t * 36 + d] *= __expf(bc); ks[t * 36 + d] *= __expf(-bc); }
    __syncthreads();
    const int t = tid >> 3, s8 = (tid & 7) * 8;
    {
        f32x4 qv[8];
#pragma unroll
        for (int d4 = 0; d4 < 8; ++d4) qv[d4] = *(const f32x4*)(qs + t * 36 + 4 * d4);
#pragma unroll
        for (int i = 0; i < 8; ++i) { const int s = 8 * i + (tid & 7); float a = 0.f;
            if (s <= t) { f32x2 a2 = {0.f, 0.f};
#pragma unroll
                for (int d4 = 0; d4 < 8; ++d4) { const f32x4 kv = *(const f32x4*)(ks + s * 36 + 4 * d4); a2 += qv[d4].lo * kv.lo; a2 += qv[d4].hi * kv.hi; }
                a = a2.x + a2.y; }
            att[t * 65 + s] = a; }
    }
    __syncthreads();
    const int e8 = s8; float o[8]; f32x2 o2[4];
#pragma unroll
    for (int i = 0; i < 4; ++i) o2[i] = (f32x2){0.f, 0.f};
#pragma unroll 2
    for (int s = 0; s <= t; ++s) { const float a = att[t * 65 + s]; const f32x4 v0 = *(const f32x4*)(vs + s * 64 + e8), v1 = *(const f32x4*)(vs + s * 64 + e8 + 4);
        o2[0] += v0.lo * a; o2[1] += v0.hi * a; o2[2] += v1.lo * a; o2[3] += v1.hi * a; }
#pragma unroll 8
    for (int d = 0; d < 32; ++d) { const float a = qs[t * 36 + d]; const f32x4 v0 = *(const f32x4*)(Ss + d * 64 + e8), v1 = *(const f32x4*)(Ss + d * 64 + e8 + 4);
        o2[0] += v0.lo * a; o2[1] += v0.hi * a; o2[2] += v1.lo * a; o2[3] += v1.hi * a; }
#pragma unroll
    for (int i = 0; i < 4; ++i) { o[2 * i] = o2[i].x; o[2 * i + 1] = o2[i].y; }
    float ss = 0.f;
#pragma unroll
    for (int i = 0; i < 8; ++i) ss += o[i] * o[i];
    ss = reduce8(ss);
    const float rr = rsqrtf(ss * (1.f / 64.f) + 1e-6f);
    bf16_t* zp = ZY + (size_t)(row0 + t) * 1024 + 256 + h * 64 + e8; const u32x4 z = *(const u32x4*)zp; const float* ng = P.in[I_GNG] + l * 64 + e8;
    u32x4 w; w.x = pk2(o[0] * rr * ng[0] * silu(bflo(z.x)), o[1] * rr * ng[1] * silu(bfhi(z.x))); w.y = pk2(o[2] * rr * ng[2] * silu(bflo(z.y)), o[3] * rr * ng[3] * silu(bfhi(z.y)));
    w.z = pk2(o[4] * rr * ng[4] * silu(bflo(z.z)), o[5] * rr * ng[5] * silu(bfhi(z.z))); w.w = pk2(o[6] * rr * ng[6] * silu(bflo(z.w)), o[7] * rr * ng[7] * silu(bfhi(z.w)));
    if (dost) *(u32x4*)zp = w;
}


DEVI void grid_bar(unsigned* w, unsigned k) {
    asm volatile("s_waitcnt vmcnt(0)" ::: "memory");
    __syncthreads();
    if (tidx() == 0) {
        const unsigned G = gridDim.x;
        __builtin_amdgcn_fence(__ATOMIC_RELEASE, "agent");
        asm volatile("s_waitcnt vmcnt(0)" ::: "memory");
        const unsigned old = __hip_atomic_fetch_add(&w[0], 1u, __ATOMIC_RELAXED, __HIP_MEMORY_SCOPE_AGENT);
        if (old + 1u == k * G) __hip_atomic_store(&w[512], k, __ATOMIC_RELAXED, __HIP_MEMORY_SCOPE_AGENT);
        while (__hip_atomic_load(&w[512], __ATOMIC_RELAXED, __HIP_MEMORY_SCOPE_AGENT) < k) __builtin_amdgcn_s_sleep(1);
        __builtin_amdgcn_fence(__ATOMIC_ACQUIRE, "agent");
        asm volatile("s_waitcnt vmcnt(0)" ::: "memory");
    }
    __syncthreads();
}

template <int NT, class Epi>
DEVI void small_gemm(const bf16_t* A, int lda, const bf16_t* const (&bp)[NT], int ldb, int K, const Epi& E, float* sm) {
    const int tid = tidx(), wave = tid >> 6, lane = tid & 63, lr = lane & 15, lq = lane >> 4;
    const int kw = K >> 3, kbeg = wave * kw;
    const bf16_t* ap = A + (size_t)lr * lda + 8 * lq + kbeg;
    f32x4 acc[NT];
#pragma unroll
    for (int t = 0; t < NT; ++t) acc[t] = (f32x4){0.f, 0.f, 0.f, 0.f};
    if (kw == 128) {
        bf16x8 a[4], b[4][NT];
#pragma unroll
        for (int s2 = 0; s2 < 4; ++s2) { a[s2] = *(const bf16x8*)(ap + 32 * s2);
#pragma unroll
            for (int t = 0; t < NT; ++t) b[s2][t] = *(const bf16x8*)(bp[t] + (size_t)lr * ldb + 8 * lq + kbeg + 32 * s2); }
#pragma unroll
        for (int s2 = 0; s2 < 4; ++s2)
#pragma unroll
            for (int t = 0; t < NT; ++t) acc[t] = __builtin_amdgcn_mfma_f32_16x16x32_bf16(a[s2], b[s2][t], acc[t], 0, 0, 0);
    } else {
        const bf16x8 a = *(const bf16x8*)ap; bf16x8 b[NT];
#pragma unroll
        for (int t = 0; t < NT; ++t) b[t] = *(const bf16x8*)(bp[t] + (size_t)lr * ldb + 8 * lq + kbeg);
#pragma unroll
        for (int t = 0; t < NT; ++t) acc[t] = __builtin_amdgcn_mfma_f32_16x16x32_bf16(a, b[t], acc[t], 0, 0, 0);
    }
    __syncthreads();
    f32x4* red = (f32x4*)sm;
#pragma unroll
    for (int t = 0; t < NT; ++t) red[(wave * NT + t) * 64 + lane] = acc[t];
    __syncthreads();
    if (wave == 0) {
#pragma unroll
        for (int t = 0; t < NT; ++t) { f32x4 v = red[t * 64 + lane];
#pragma unroll
            for (int w = 1; w < 8; ++w) v += red[(w * NT + t) * 64 + lane];
            acc[t] = v; }
        E(acc, lane);
    }
}
DEVI void small_br(const Params& P, int l, int item, float* sm) {
    const int rg = item >> 6, it = item & 63, b = it >> 4, s4 = it & 15;
    const bf16_t* ZY = (const bf16_t*)(P.ws + OFF_ZY) + (size_t)(NTOK + 16 * rg) * 1024 + b * 256;
    const bf16_t* W = (const bf16_t*)(P.ws + OFF_WBR) + (size_t)(l * 4 + b) * 1024 * 256;
    const bf16_t* bp[4] = {W + (size_t)(64 * s4) * 256, W + (size_t)(64 * s4 + 16) * 256, W + (size_t)(64 * s4 + 32) * 256, W + (size_t)(64 * s4 + 48) * 256};
    bf16_t* BR = (bf16_t*)(P.ws + OFF_BR) + (size_t)(NTOK + 16 * rg) * 4096 + b * 1024;
    auto E = [&](const f32x4 (&acc)[4], int lane) {
#pragma unroll
        for (int t = 0; t < 4; ++t) { const int n = 64 * s4 + 16 * t + (lane & 15), col = (n & ~255) + natcol(n & 255);
#pragma unroll
            for (int g = 0; g < 4; ++g) BR[(size_t)((lane >> 4) * 4 + g) * 4096 + col] = f2bf(acc[t][g]); } };
    small_gemm<4>(ZY, 1024, bp, 256, 256, E, sm);
}
DEVI void small_gate(const Params& P, int l, int item, float* sm) {
    const int rg = item >> 6, it = item & 63, q = it >> 2, wc = it & 3;
    const bf16_t* XB = (const bf16_t*)(P.ws + OFF_XB) + (size_t)(NTOK + 16 * rg) * 1024;
    const bf16_t* W = (const bf16_t*)(P.ws + OFF_W1T) + (size_t)l * 7424 * 1024 + (size_t)(3328 + 256 * q + 32 * wc) * 1024;
    const bf16_t* bp[4] = {W, W + (size_t)16 * 1024, W + (size_t)128 * 1024, W + (size_t)144 * 1024};
    const bf16_t* BR = (const bf16_t*)(P.ws + OFF_BR) + (size_t)(NTOK + 16 * rg) * 4096;
    const float* ssq = (const float*)(P.ws + OFF_SSQ) + l * MPAD + NTOK + 16 * rg;
    bf16_t* ZY = (bf16_t*)(P.ws + OFF_ZY) + (size_t)(NTOK + 16 * rg) * 1024;
    auto E = [&](const f32x4 (&acc)[4], int lane) {
        const int col = 64 * q + 16 * wc + (lane & 15);
#pragma unroll
        for (int g = 0; g < 4; ++g) { const int rl = (lane >> 4) * 4 + g; const float rs = rsqrtf(ssq[rl] * (1.f / 1024.f) + 1e-6f); float o = 0.f;
#pragma unroll
            for (int b = 0; b < 4; ++b) o += sigm(acc[b][g] * rs) * bf2f(BR[(size_t)rl * 4096 + b * 1024 + col]);
            ZY[(size_t)rl * 1024 + col] = f2bf(o); } };
    small_gemm<4>(XB, 1024, bp, 1024, 1024, E, sm);
}
template <int LAYER> DEVI void small_out(const Params& P, int l, int item, float* sm) {
    const int rg = item >> 5, it = item & 31;
    const bf16_t* ZY = (const bf16_t*)(P.ws + OFF_ZY) + (size_t)(NTOK + 16 * rg) * 1024;
    const bf16_t* W = (const bf16_t*)(P.ws + OFF_WOUT) + (size_t)l * 1024 * 1024 + (size_t)(32 * it) * 1024;
    const bf16_t* bp[2] = {W, W + (size_t)16 * 1024};
    bf16_t* XB = (bf16_t*)(P.ws + OFF_XB) + (size_t)(NTOK + 16 * rg) * 1024; float* yout = P.out + (size_t)(NTOK + 16 * rg) * 1024; const float* xs = P.in[I_XS] + (size_t)(16 * rg) * 1024;
    float* ssq = (float*)(P.ws + OFF_SSQ) + (LAYER == 0 ? 1 : 2) * MPAD + NTOK + 16 * rg;
    auto E = [&](const f32x4 (&acc)[2], int lane) {
        const int i = lane & 15;
#pragma unroll
        for (int g = 0; g < 4; ++g) { const int rl = (lane >> 4) * 4 + g; float ps = 0.f;
#pragma unroll
            for (int t = 0; t < 2; ++t) { const int col = 32 * it + 8 * (i >> 2) + 4 * t + (i & 3); float v = acc[t][g];
                if (LAYER == 0) { v += xs[(size_t)rl * 1024 + col]; XB[(size_t)rl * 1024 + col] = f2bf(v); }
                else { v += bf2f(XB[(size_t)rl * 1024 + col]); yout[(size_t)rl * 1024 + col] = v; }
                ps += v * v; }
            ps = reduce16(ps);
            if (i == 0) atomicAdd(ssq + rl, ps); } };
    small_gemm<2>(ZY, 1024, bp, 1024, 1024, E, sm);
}

#ifndef PHMASK
#define PHMASK 0xFFFF
#endif
#define PHON(b) ((PHMASK >> (b)) & 1)
DEVI void run_phase(const Params& P, int ph, unsigned char* smem) {
    float* sm = (float*)smem;
    const int G = gridDim.x, c = blockIdx.x;
    if (ph == 0) { if (PHON(0)) phase_p0(P, smem); return; }
    if (ph == NPH - 1) { if (!PHON(8)) return;
        const int wave = tidx() >> 6, lane = tidx() & 63; const float* ssq = (const float*)(P.ws + OFF_SSQ) + 2 * MPAD;
        for (int row = c * 8 + wave; row < ROWS; row += G * 8) { const float rs = rsqrtf(ssq[row] * (1.f / 1024.f) + 1e-6f); f32x4* yp = (f32x4*)(P.out + (size_t)row * 1024) + lane; const f32x4* gp = (const f32x4*)P.in[I_FNG] + lane;
#pragma unroll
            for (int j = 0; j < 4; ++j) yp[64 * j] = yp[64 * j] * rs * gp[64 * j]; }
        return;
    }
    const int l = (ph - 1) / 7, sp = (ph - 1) % 7;
    const char* XB = (const char*)(P.ws + OFF_XB); const char* ZYc = (const char*)(P.ws + OFF_ZY);
    float* ssq = (float*)(P.ws + OFF_SSQ);
    if (sp == 0) { if (!PHON(1)) return; SchedG1 S{XB, (const char*)(P.ws + OFF_W1T) + (size_t)l * 7424 * 2048, G, c}; EpiG1 E{(bf16_t*)(P.ws + OFF_PA), (bf16_t*)(P.ws + OFF_ZY), ssq + l * MPAD};
        g8::gemm_phase((LAS unsigned char*)smem, 2048, 2048, 1024, S, E);
        if (l == 0) { const int nfull = 65 * 13 - 3 * G;
            if (false && c >= nfull) { __syncthreads(); weight_items(P, smem, WI_EARLY, WI_ALL, (c - nfull) * 8 + (tidx() >> 6), (G - nfull) * 8); } }
        return; }
    if (sp == 1) { if (!PHON(2)) return;
        constexpr int NA = 1024, NL = 512, NG = 1024, NAS = 32, NC = 8;
        for (int it = c; it < NA + NL + NG + NAS + NC; it += G) { int r = it;
            if (r < NA) { rwkv_prep(P, l, r); continue; } r -= NA;
            if (r < NL) { lru_prep(P, l, r, sm); continue; } r -= NL;
            if (r < NG) { gla_prep(P, l, r, sm); continue; } r -= NG;
            if (r < NAS) { rwkv_prep(P, l, 1024 + r); continue; } r -= NAS;
            cache_copy(P, l, r); }
        return; }
    if (sp == 2) { if (!PHON(3)) return;
        const int nR = G >= 256 ? 128 : (G > 1 ? G / 2 : 0);
        if (c < nR) { if (PROBE_SP != 13) for (int it = c; it < 128; it += nR) { const int slot = it >> 3; rwkv_scan_prompt(P, l, (((it & 7) * 4 + (slot >> 2)) * 4) + (slot & 3), sm); } return; }
        constexpr int NSW = 512, NGP = 32, NLC = 8, NRS = 64, NSS = 128, NGS = 128, NLS = 64;
        if (nR == 0) for (int it = 0; it < 128; ++it) rwkv_scan_prompt(P, l, it, sm);
        for (int it = c - nR; it < NSW + NGP + NLC + NRS + NSS + NGS + NLS; it += G - nR) { int r = it;
            if (r < NGP) { gla_prefix(P, l, r); continue; } r -= NGP;
            if (r < NLC) { lru_carry(P, l, r); continue; } r -= NLC;
            if (r < NSW) { swa_prompt(P, l, r, sm); continue; } r -= NSW;
            if (r < NRS) { rwkv_scan_sample(P, l, r); continue; } r -= NRS;
            if (r < NSS) { swa_sample(P, l, r, sm); continue; } r -= NSS;
            if (r < NGS) { gla_sample(P, l, r, sm); continue; } r -= NGS;
            lru_sample(P, l, r, sm); }
        return; }
    if (sp == 3) { if (!PHON(4)) return;
        constexpr int NG = 1024, NL = 512, NR = 1032;
        for (int it = c; it < NG + NL + NR; it += G) { int r = it;
            if (r < NG) { gla_out(P, l, r, sm); continue; } r -= NG;
            if (r < NL) { lru_final(P, l, r); continue; } r -= NL;
            rwkv_post(P, l, r); }
        return; }
    if (sp == 4) { if (!PHON(5)) return; SchedBr S{ZYc, (const char*)(P.ws + OFF_WBR) + (size_t)l * 4 * 1024 * 512, G, c}; EpiBr E{(bf16_t*)(P.ws + OFF_BR)};
        g8::gemm_phase((LAS unsigned char*)smem, 2048, 512, 256, S, E);
        for (int it = G - 1 - c; it < 512; it += G) small_br(P, l, it, sm);
        return; }
    if (sp == 5) { if (!PHON(6)) return; SchedGate S{XB, (const char*)(P.ws + OFF_W1T) + (size_t)l * 7424 * 2048, G, c}; EpiGate E{(const bf16_t*)(P.ws + OFF_BR), ssq + l * MPAD, (bf16_t*)(P.ws + OFF_ZY)};
        g8::gemm_phase((LAS unsigned char*)smem, 2048, 2048, 1024, S, E);
        for (int it = G - 1 - c; it < 512; it += G) small_gate(P, l, it, sm);
        return; }
    if (PHON(7)) { SchedOut S{ZYc, (const char*)(P.ws + OFF_WOUT) + (size_t)l * 1024 * 2048, G, c};
        if (l == 0) { EpiOut<0> E{P.in[I_XP], P.in[I_XS], (bf16_t*)(P.ws + OFF_XB), P.out, ssq + MPAD}; g8::gemm_phase((LAS unsigned char*)smem, 2048, 2048, 1024, S, E); for (int it = G - 1 - c; it < 256; it += G) small_out<0>(P, l, it, sm); }
        else { EpiOut<1> E{P.in[I_XP], P.in[I_XS], (bf16_t*)(P.ws + OFF_XB), P.out, ssq + 2 * MPAD}; g8::gemm_phase((LAS unsigned char*)smem, 2048, 2048, 1024, S, E); for (int it = G - 1 - c; it < 256; it += G) small_out<1>(P, l, it, sm); }
    }
}

__global__ void __launch_bounds__(512) mega_fwd(Params P, int ph_lo, int ph_hi, int cg_mode) {
    extern __shared__ __attribute__((aligned(16))) unsigned char smem[];
    cg::grid_group grid = cg::this_grid();
    unsigned nbar = 0;
    unsigned* barw = (unsigned*)(P.ws + OFF_BAR);
#define GSYNC() do { if (USE_CG_SYNC || cg_mode) grid.sync(); else grid_bar(barw, ++nbar); } while (0)
    for (int ph = ph_lo; ph < ph_hi; ++ph) {
        if (ph > ph_lo) GSYNC();
        __syncthreads();
        unsigned z; asm volatile("s_mov_b32 %0, 0" : "=s"(z));
        const Params* pp = (const Params*)((const char*)(const __attribute__((address_space(4))) char*)__builtin_amdgcn_kernarg_segment_ptr() + z);
        if (PROBE_SP == 13 && ph >= 1 && ph < NPH - 1 && (ph - 1) % 7 == 2) { if (blockIdx.x < 128) rwkv_scan_prompt(*pp, (ph - 1) / 7, blockIdx.x, (float*)smem); GSYNC(); __syncthreads(); }
        run_phase(*pp, ph, smem);
        if (PROBE_SP >= 0) {
            const int spx = (ph >= 1 && ph < NPH - 1) ? (ph - 1) % 7 : -1;
            if ((PROBE_SP < 7 && spx == PROBE_SP) || (PROBE_SP == 7 && ph == 0)) { GSYNC(); __syncthreads(); run_phase(*pp, ph, smem); }
            if (PROBE_SP == 8 && spx == 2) { GSYNC(); __syncthreads(); if (blockIdx.x < 128) rwkv_scan_prompt(*pp, (ph - 1) / 7, blockIdx.x, (float*)smem); }
            if (PROBE_SP == 9) GSYNC();
            if (PROBE_SP == 14 && spx == 2) { GSYNC(); __syncthreads(); if (blockIdx.x >= 128) for (int it = blockIdx.x - 128; it < 512; it += gridDim.x - 128) swa_prompt<true>(*pp, (ph - 1) / 7, it, (float*)smem); }
            if (PROBE_SP >= 15 && PROBE_SP <= 17 && spx == 2) { GSYNC(); __syncthreads(); const int l_ = (ph - 1) / 7;
                if (PROBE_SP == 15) for (int it = blockIdx.x; it < 1024; it += gridDim.x) gla_out<true>(*pp, l_, it, (float*)smem);
                if (PROBE_SP == 16) for (int it = blockIdx.x; it < 512; it += gridDim.x) lru_final<true>(*pp, l_, it);
                if (PROBE_SP == 17) for (int it = blockIdx.x; it < 1032; it += gridDim.x) rwkv_post<true>(*pp, l_, it); }
            if (PROBE_SP == 18 && spx == 5) { GSYNC(); __syncthreads(); const int l_ = (ph - 1) / 7; const int G = gridDim.x, c = blockIdx.x;
                SchedOut S{(const char*)(pp->ws + OFF_ZY), (const char*)(pp->ws + OFF_WOUT) + (size_t)l_ * 1024 * 2048, G, c}; float* ssq = (float*)(pp->ws + OFF_SSQ);
                if (l_ == 0) { EpiOut<0, false> E{pp->in[I_XP], pp->in[I_XS], (bf16_t*)(pp->ws + OFF_XB), pp->out, ssq + MPAD}; g8::gemm_phase((LAS unsigned char*)smem, 2048, 2048, 1024, S, E); }
                else { EpiOut<1, false> E{pp->in[I_XP], pp->in[I_XS], (bf16_t*)(pp->ws + OFF_XB), pp->out, ssq + 2 * MPAD}; g8::gemm_phase((LAS unsigned char*)smem, 2048, 2048, 1024, S, E); } }
            if (PROBE_SP >= 10 && PROBE_SP <= 12 && spx == 1) { GSYNC(); __syncthreads(); const int l_ = (ph - 1) / 7;
                if (PROBE_SP == 10) for (int it = blockIdx.x; it < 1024; it += gridDim.x) gla_prep(*pp, l_, it, (float*)smem);
                if (PROBE_SP == 11) for (int it = blockIdx.x; it < 512; it += gridDim.x) lru_prep(*pp, l_, it, (float*)smem);
                if (PROBE_SP == 12) for (int it = blockIdx.x; it < 1056; it += gridDim.x) rwkv_prep(*pp, l_, it); }
        }
    }
}

extern "C" void kernel_launch(void* const* d_in, const int* in_sizes, int n_in, void* d_out, int out_size, void* d_ws, size_t ws_size, hipStream_t stream) {
    static int grid = 0;
    if (grid == 0) {
        if (n_in != 35 || (size_t)out_size != O_END || ws_size < WS_END) { fprintf(stderr, "kernel_launch: unexpected shapes n_in %d out %d ws %zu (need %zu)\n", n_in, out_size, ws_size, (size_t)WS_END); grid = -1; return; }
        int dev = 0, cus = 0, per_cu = 0;
        hipGetDevice(&dev); hipDeviceGetAttribute(&cus, hipDeviceAttributeMultiprocessorCount, dev);
        if (hipFuncSetAttribute((const void*)mega_fwd, hipFuncAttributeMaxDynamicSharedMemorySize, LDS_BYTES) != hipSuccess) { fprintf(stderr, "kernel_launch: hipFuncSetAttribute failed\n"); grid = -1; return; }
        if (hipOccupancyMaxActiveBlocksPerMultiprocessor(&per_cu, (const void*)mega_fwd, 512, LDS_BYTES) != hipSuccess || per_cu < 1) { fprintf(stderr, "kernel_launch: occupancy query says %d\n", per_cu); per_cu = 1; }
        (void)hipGetLastError();
        grid = cus;
    }
    if (grid < 0) return;
    Params p{};
    for (int i = 0; i < 35; ++i) p.in[i] = (const float*)d_in[i];
    p.out = (float*)d_out; p.ws = (unsigned char*)d_ws;
#if ONE_LAUNCH
    (void)hipMemsetAsync((char*)d_ws + OFF_BAR, 0, 4096, stream);
    int lo = 0, hi = NPH, cgm = 0;
    void* args[] = {&p, &lo, &hi, &cgm};
    hipError_t e = hipLaunchCooperativeKernel((const void*)mega_fwd, dim3(grid), dim3(512), args, LDS_BYTES, stream);
    if (e != hipSuccess) fprintf(stderr, "cooperative launch failed: %s (grid %d)\n", hipGetErrorString(e), grid);
#else
    for (int ph = 0; ph < NPH; ++ph) hipLaunchKernelGGL(mega_fwd, dim3(grid), dim3(512), LDS_BYTES, stream, p, ph, ph + 1, 0);
#endif
}
```

```cpp
#include <hip/hip_runtime.h>
#include <hip/hip_cooperative_groups.h>
#include <cstdio>
#include <cstdint>
namespace cg = cooperative_groups;

typedef unsigned short bf16_t;
typedef short bf16x8 __attribute__((ext_vector_type(8)));
typedef float f32x4 __attribute__((ext_vector_type(4)));
typedef unsigned u32x4 __attribute__((ext_vector_type(4)));
typedef unsigned u32x2 __attribute__((ext_vector_type(2)));
typedef float f32x2 __attribute__((ext_vector_type(2)));
#define LAS __attribute__((address_space(3)))
#define DEVI __device__ __forceinline__

#ifndef PROBE_SP
#define PROBE_SP -1
#endif
#ifndef USE_CG_SYNC
#define USE_CG_SYNC 0
#endif
#ifndef ONE_LAUNCH
#define ONE_LAUNCH 1
#endif

constexpr int NTOK = 16384, NSAMP = 128, ROWS = 16512, MPAD = 16640, SEQ = 2048;
constexpr int INC = 7248;
constexpr int CA = 0, CB = 832, CC = 1360, CD = 1872, CZ = 2128, CG = 3152;
constexpr int PALD = 2304;
constexpr int NPH = 16;
constexpr int LDS_BYTES = 131072;

constexpr size_t OFF_W1T = 0, SZ_W1T = (size_t)2 * 7424 * 1024 * 2;
constexpr size_t OFF_WBR = OFF_W1T + SZ_W1T, SZ_WBR = (size_t)2 * 4 * 1024 * 256 * 2;
constexpr size_t OFF_WOUT = OFF_WBR + SZ_WBR, SZ_WOUT = (size_t)2 * 1024 * 1024 * 2;
constexpr size_t OFF_XB = OFF_WOUT + SZ_WOUT, SZ_XB = (size_t)MPAD * 1024 * 2;
constexpr size_t OFF_ZY = OFF_XB + SZ_XB;
constexpr size_t OFF_SSQ = OFF_ZY + SZ_XB, SZ_SSQ = (size_t)3 * MPAD * 4;
constexpr size_t OFF_BR = OFF_SSQ + SZ_SSQ, SZ_BR = (size_t)MPAD * 4096 * 2;
constexpr size_t OFF_PA = OFF_BR, SZ_PA = (size_t)MPAD * PALD * 2;
constexpr size_t OFF_RWP = OFF_BR + SZ_PA, SZ_RWP = (size_t)ROWS * 1536 * 2;
constexpr size_t OFF_RWC = OFF_RWP + SZ_RWP, SZ_RWC = (size_t)ROWS * 16 * 4;
constexpr size_t OFF_BAR = OFF_BR + SZ_BR;
constexpr size_t OFF_WLT = OFF_BAR + 4096, SZ_WLT = (size_t)2 * 2 * 4 * 4096 * 2;
constexpr size_t WS_END = OFF_WLT + SZ_WLT;
static_assert(OFF_RWC + SZ_RWC <= WS_END, "ws overlay");

constexpr size_t SO_RWO = 0;
constexpr size_t SO_LH = SO_RWO + (size_t)ROWS * 256;
constexpr size_t SO_LP = SO_LH + (size_t)NTOK * 256;
constexpr size_t SO_GU = SO_LP + (size_t)NTOK * 256;
constexpr size_t SO_GD = SO_GU + (size_t)1024 * 2048;
constexpr size_t SO_LA = SO_GD + (size_t)1024 * 32;
constexpr size_t SO_LB = SO_LA + (size_t)8 * 128 * 256;
static_assert(SO_LB + 8 * 128 * 256 <= (size_t)ROWS * 1024, "out scratch");

constexpr size_t O_Y = 0;
constexpr size_t O_WKVP = (size_t)ROWS * 1024;
constexpr size_t O_WKVS = O_WKVP + 2 * 8 * 4 * 64 * 64;
constexpr size_t O_SHP = O_WKVS + (size_t)2 * 128 * 4 * 64 * 64;
constexpr size_t O_SHS = O_SHP + 2 * 8 * 832;
constexpr size_t O_GLP = O_SHS + 2 * 128 * 832;
constexpr size_t O_GLS = O_GLP + 2 * 8 * 4 * 32 * 64;
constexpr size_t O_KP = O_GLS + 2 * 128 * 4 * 32 * 64;
constexpr size_t O_KS = O_KP + 2 * 8 * 128 * 128;
constexpr size_t O_VP = O_KS + (size_t)2 * 128 * 128 * 128;
constexpr size_t O_VS = O_VP + 2 * 8 * 128 * 128;
constexpr size_t O_CVP = O_VS + (size_t)2 * 128 * 128 * 128;
constexpr size_t O_CVS = O_CVP + 2 * 8 * 3 * 256;
constexpr size_t O_HP = O_CVS + 2 * 128 * 3 * 256;
constexpr size_t O_HS = O_HP + 2 * 8 * 256;
constexpr size_t O_END = O_HS + 2 * 128 * 256;

struct Params {
    const float* in[35];
    float* out;
    unsigned char* ws;
};
enum { I_XP = 0, I_XS, I_SWKV, I_SSHIFT, I_SGLA, I_CK, I_CV, I_SCONV, I_SH, I_NG, I_WIN, I_MU, I_W0, I_WUP, I_A0, I_AUP, I_KK, I_KA, I_RK, I_LNG, I_LNB,
       I_GUP, I_GB, I_GNG, I_SINK, I_CW, I_CBI, I_WA, I_BA, I_WX, I_BX, I_LAM, I_WBR, I_WOUT, I_FNG };

DEVI int tidx() { int t = (int)threadIdx.x; asm volatile("" : "+v"(t)); return t; }
DEVI float bf2f(bf16_t h) { return __uint_as_float(((unsigned)h) << 16); }
DEVI float bflo(unsigned w) { return __uint_as_float(w << 16); }
DEVI float bfhi(unsigned w) { return __uint_as_float(w & 0xffff0000u); }
DEVI unsigned f2bfu(float f) { unsigned u = __float_as_uint(f); return (u + 0x7fffu + ((u >> 16) & 1u)) >> 16; }
DEVI bf16_t f2bf(float f) { return (bf16_t)f2bfu(f); }
DEVI unsigned pk2(float lo, float hi) { return f2bfu(lo) | (f2bfu(hi) << 16); }
template <int CTRL> DEVI float dpp_mov(float v) { return __builtin_bit_cast(float, __builtin_amdgcn_update_dpp(0, __builtin_bit_cast(int, v), CTRL, 0xF, 0xF, true)); }
DEVI float rdlane(float v, int l) { return __builtin_bit_cast(float, __builtin_amdgcn_readlane(__builtin_bit_cast(int, v), l)); }
DEVI float reduce16(float v) { v += dpp_mov<0xB1>(v); v += dpp_mov<0x4E>(v); v += dpp_mov<0x141>(v); v += dpp_mov<0x140>(v); return v; }
DEVI float reduce8(float v) { v += dpp_mov<0xB1>(v); v += dpp_mov<0x4E>(v); v += dpp_mov<0x141>(v); return v; }
DEVI float wave_sum(float v) { v = reduce16(v); return (rdlane(v, 0) + rdlane(v, 16)) + (rdlane(v, 32) + rdlane(v, 48)); }
DEVI float wave_max(float v) { v = fmaxf(v, dpp_mov<0xB1>(v)); v = fmaxf(v, dpp_mov<0x4E>(v)); v = fmaxf(v, dpp_mov<0x141>(v)); v = fmaxf(v, dpp_mov<0x140>(v));
    return fmaxf(fmaxf(rdlane(v, 0), rdlane(v, 16)), fmaxf(rdlane(v, 32), rdlane(v, 48))); }
DEVI float quad_sum(float v) { v += dpp_mov<0xB1>(v); v += dpp_mov<0x4E>(v); return v; }
DEVI float quad_max(float v) { v = fmaxf(v, dpp_mov<0xB1>(v)); v = fmaxf(v, dpp_mov<0x4E>(v)); return v; }
DEVI float frcp(float x) { return __builtin_amdgcn_rcpf(x); }
DEVI float sigm(float x) { return frcp(1.f + __expf(-x)); }
DEVI float silu(float x) { return x * sigm(x); }
DEVI float flog(float x) { return __builtin_amdgcn_logf(x) * 0.6931471806f; }
DEVI float logsig(float x) { return fminf(x, 0.f) - flog(1.f + __expf(-fabsf(x))); }
DEVI float softplus(float x) { return fmaxf(x, 0.f) + flog(1.f + __expf(-fabsf(x))); }
DEVI float logsig_acc(float x) { return fminf(x, 0.f) - log1pf(expf(-fabsf(x))); }
DEVI float ftanh(float x) { const float e = __expf(-2.f * fabsf(x)); const float t = (1.f - e) * frcp(1.f + e); return x < 0.f ? -t : t; }
#define LDS_WAIT() asm volatile("s_waitcnt lgkmcnt(0)" ::: "memory")

DEVI int natcol(int p) { return (p & ~31) | (((p >> 2) & 3) << 3) | (((p >> 4) & 1) << 2) | (p & 3); }
DEVI int w1_src(int n) {
    const int pn = n >> 8, p = n & 255;
    if (pn < 9) { const int c = 256 * pn + natcol(p); return c < CZ ? c : -1; }
    if (pn < 13) return CZ + 256 * (pn - 9) + natcol(p);
    const int q = pn - 13, bj = p >> 7, wc = (p >> 5) & 3, n_ = (p >> 4) & 1, r16 = p & 15;
    return CG + (2 * bj + n_) * 1024 + 64 * q + 16 * wc + r16;
}

namespace g8 {
constexpr int BM = 256, BK = 64, HALF = 128, HTB = HALF * BK * 2;
DEVI int lds_byte(int r, int c) { const int st = (r >> 4) * 2 + (c >> 5), rr = r & 15, cc = c & 31, ob = rr * 64 + cc * 2; return st * 1024 + (ob ^ (((ob >> 9) & 1) << 5)); }
DEVI void stage_rc(int b, int& R, int& C) { const int st = b / 1024, sb = b % 1024, swz = sb ^ (((sb >> 9) & 1) << 5); R = (st >> 1) * 16 + swz / 64; C = (st & 1) * 32 + (swz % 64) / 2; }
struct Unit { const char* a; const char* b; int pm, pn; };
DEVI void tile_of(int L, int nM, int nN, int& pm, int& pn) {
    const int nwg = nM * nN; int wgid = L;
    { const int q = nwg / 8, r = nwg % 8, xcd = wgid % 8, off = wgid / 8; wgid = (xcd < r ? xcd * (q + 1) : r * (q + 1) + (xcd - r) * q) + off; }
    const int nig = 8 * nN, gid = wgid / nig, fm = gid * 8, gsz = (nM - fm) < 8 ? (nM - fm) : 8;
    pm = fm + ((wgid % nig) % gsz); pn = (wgid % nig) / gsz;
}

template <class Sched, class Epi>
DEVI void gemm_phase(LAS unsigned char* lds, const int lda, const int ldb, const int K, const Sched& S, const Epi& E) {
    const int tid = tidx(), wid = __builtin_amdgcn_readfirstlane(tid >> 6), lane = tid & 63, wr = wid >> 2, wc = wid & 3, fr = lane & 15, fq = lane >> 4;
    const int nt = K / BK;
    unsigned voffA[2], voffB[2];
#pragma unroll
    for (int i = 0; i < 2; ++i) { int R, C; stage_rc(tid * 16 + i * 8192, R, C); voffA[i] = (unsigned)(R * lda + C * 2); voffB[i] = (unsigned)(R * ldb + C * 2); }
    const size_t kstep = (size_t)(BK * 2);
    const size_t hstepA = (size_t)HALF * lda, hstepB = (size_t)HALF * ldb;
    const unsigned ldsw = (unsigned)wid * 1024u;
    const int aoff = lds_byte(wr * 64 + fr, fq * 8), boff = lds_byte(wc * 32 + fr, fq * 8);
#define G8_SA(b, h) (((b) * 2 + (h)) * HTB)
#define G8_SB(b, h) ((4 + (b) * 2 + (h)) * HTB)
#define G8_STAGE(bufoff, gbase, voff) do { _Pragma("unroll") for (int _i = 0; _i < 2; ++_i) \
        __builtin_amdgcn_global_load_lds((const unsigned*)((const char*)(gbase) + (voff)[_i]), (LAS unsigned*)(lds + (bufoff) + ldsw + _i * 8192), 16, 0, 0); } while (0)
#define G8_LDA(dst, b, h) do { _Pragma("unroll") for (int m = 0; m < 4; ++m) _Pragma("unroll") for (int k = 0; k < 2; ++k) dst[m][k] = *(const LAS bf16x8*)(lds + G8_SA(b, h) + aoff + m * 2048 + k * 1024); } while (0)
#define G8_LDB(dst, b, h) do { _Pragma("unroll") for (int n = 0; n < 2; ++n) _Pragma("unroll") for (int k = 0; k < 2; ++k) dst[n][k] = *(const LAS bf16x8*)(lds + G8_SB(b, h) + boff + n * 2048 + k * 1024); } while (0)
#define G8_MMA(ai, bj, At, Bt) do { __builtin_amdgcn_s_setprio(1); _Pragma("unroll") for (int m = 0; m < 4; ++m) _Pragma("unroll") for (int n = 0; n < 2; ++n) _Pragma("unroll") for (int k = 0; k < 2; ++k) \
        acc[ai][bj][m][n] = __builtin_amdgcn_mfma_f32_16x16x32_bf16(Bt[n][k], At[m][k], acc[ai][bj][m][n], 0, 0, 0); __builtin_amdgcn_s_setprio(0); } while (0)
#define G8_WAIT_V(n) asm volatile("s_waitcnt vmcnt(" #n ")" ::: "memory")
#define G8_WAIT_L(n) asm volatile("s_waitcnt lgkmcnt(" #n ")" ::: "memory")
#define G8_BAR __builtin_amdgcn_s_barrier()
#define G8_SCHED __builtin_amdgcn_sched_barrier(0)
    Unit cur, nxt; int ui = 0;
    if (!S.next(0, cur)) return;
    f32x4 acc[2][2][4][2];
#pragma unroll
    for (int a = 0; a < 2; ++a)
#pragma unroll
        for (int b = 0; b < 2; ++b)
#pragma unroll
            for (int m = 0; m < 4; ++m)
#pragma unroll
                for (int n = 0; n < 2; ++n) acc[a][b][m][n] = (f32x4){0.f, 0.f, 0.f, 0.f};
    bf16x8 At[4][2], B0[2][2], B1[2][2];
    const char* cA = cur.a; const char* cB = cur.b;
    G8_STAGE(G8_SB(0, 0), cB, voffB); G8_STAGE(G8_SA(0, 0), cA, voffA); G8_STAGE(G8_SB(0, 1), cB + hstepB, voffB); G8_STAGE(G8_SA(0, 1), cA + hstepA, voffA);
    if (wr == 1) G8_BAR;
    G8_WAIT_V(4); G8_BAR;
    G8_STAGE(G8_SB(1, 0), cB + kstep, voffB); G8_STAGE(G8_SA(1, 0), cA + kstep, voffA); G8_STAGE(G8_SB(1, 1), cB + hstepB + kstep, voffB);
    G8_WAIT_V(6); G8_BAR;
    for (;;) {
        const bool has_next = S.next(ui + 1, nxt);
        const char* nA = has_next ? nxt.a : cA; const char* nB = has_next ? nxt.b : cB;
        const bool full = cur.pm != 64;
#pragma nounroll
        for (int t = 0; t < nt; t += 2) {
            const bool last = (t == nt - 2);
            const char* a1 = cA + (size_t)(t + 1) * kstep;
            const char* a2 = last ? nA : cA + (size_t)(t + 2) * kstep; const char* b2 = last ? nB : cB + (size_t)(t + 2) * kstep;
            const char* a3 = a2 + kstep; const char* b3 = b2 + kstep;
            G8_LDB(B0, 0, 0); G8_SCHED; G8_LDA(At, 0, 0); G8_STAGE(G8_SA(1, 1), a1 + hstepA, voffA);
            G8_WAIT_L(8); G8_BAR; G8_WAIT_L(0); G8_MMA(0, 0, At, B0); G8_BAR; G8_SCHED;
            G8_LDB(B1, 0, 1); G8_STAGE(G8_SB(0, 0), b2, voffB);
            G8_BAR; G8_WAIT_L(0); G8_MMA(0, 1, At, B1); G8_BAR;
            G8_LDA(At, 0, 1); G8_STAGE(G8_SA(0, 0), a2, voffA);
            G8_BAR; G8_WAIT_L(0); G8_MMA(1, 0, At, B0); G8_BAR; G8_SCHED;
            G8_STAGE(G8_SB(0, 1), b2 + hstepB, voffB);
            G8_WAIT_V(6); G8_BAR; G8_MMA(1, 1, At, B1); G8_BAR;
            G8_LDB(B0, 1, 0); G8_SCHED; G8_LDA(At, 1, 0); G8_STAGE(G8_SA(0, 1), a2 + hstepA, voffA);
            G8_WAIT_L(8); G8_BAR; G8_WAIT_L(0); G8_MMA(0, 0, At, B0); G8_BAR; G8_SCHED;
            G8_LDB(B1, 1, 1); G8_STAGE(G8_SB(1, 0), b3, voffB);
            G8_BAR; G8_WAIT_L(0); G8_MMA(0, 1, At, B1); G8_BAR;
            G8_LDA(At, 1, 1); G8_STAGE(G8_SA(1, 0), a3, voffA);
            G8_BAR; G8_WAIT_L(0); G8_MMA(1, 0, At, B0); G8_BAR; G8_SCHED;
            G8_STAGE(G8_SB(1, 1), b3 + hstepB, voffB);
            G8_WAIT_V(6); G8_BAR; G8_MMA(1, 1, At, B1); G8_BAR;
        }
        E(acc, cur, wr, wc, fr, fq);
        if (!has_next) break;
#pragma unroll
        for (int a = 0; a < 2; ++a)
#pragma unroll
            for (int b = 0; b < 2; ++b)
#pragma unroll
                for (int m = 0; m < 4; ++m)
#pragma unroll
                    for (int n = 0; n < 2; ++n) acc[a][b][m][n] = (f32x4){0.f, 0.f, 0.f, 0.f};
        cur = nxt; cA = nA; cB = nB; ++ui;
    }
    G8_WAIT_V(0);
    if (wr == 0) G8_BAR;
    G8_BAR;
}
}
using g8::Unit;
typedef f32x4 AccT[2][2][4][2];

struct SchedG1 { const char* A; const char* B; int G, c;
    DEVI bool next(int i, Unit& u) const { const int L = i * G + c; if (L >= 65 * 13) return false; g8::tile_of(L, 65, 13, u.pm, u.pn);
        u.a = A + (size_t)u.pm * 256 * 2048; u.b = B + (size_t)u.pn * 256 * 2048; return true; } };
struct SchedBr { const char* A; const char* B; int G, c;
    DEVI bool next(int i, Unit& u) const { const int L = i * G + c; if (L >= 64 * 16) return false; g8::tile_of(L, 64, 16, u.pm, u.pn);
        const int b = u.pn >> 2, p4 = u.pn & 3; u.a = A + (size_t)u.pm * 256 * 2048 + b * 512; u.b = B + (size_t)b * (1024 * 512) + (size_t)p4 * 256 * 512; return true; } };
struct SchedGate { const char* A; const char* B; int G, c;
    DEVI bool next(int i, Unit& u) const { const int L = i * G + c; if (L >= 64 * 16) return false; g8::tile_of(L, 64, 16, u.pm, u.pn);
        u.a = A + (size_t)u.pm * 256 * 2048; u.b = B + (size_t)(3328 + 256 * u.pn) * 2048; return true; } };
struct SchedOut { const char* A; const char* B; int G, c;
    DEVI bool next(int i, Unit& u) const { const int L = i * G + c; if (L >= 64 * 4) return false; g8::tile_of(L, 64, 4, u.pm, u.pn);
        u.a = A + (size_t)u.pm * 256 * 2048; u.b = B + (size_t)u.pn * 256 * 2048; return true; } };

struct EpiG1 { bf16_t* PA; bf16_t* ZY; const float* ssq;
    DEVI void operator()(const AccT& acc, const Unit& u, int wr, int wc, int fr, int fq) const {
        bf16_t* base; int ld, pnl; if (u.pn < 9) { base = PA; ld = PALD; pnl = u.pn; } else { base = ZY; ld = 1024; pnl = u.pn - 9; }
        float sq[2][4];
#pragma unroll
        for (int ai = 0; ai < 2; ++ai)
#pragma unroll
            for (int m = 0; m < 4; ++m) sq[ai][m] = ssq[256 * u.pm + 128 * ai + 64 * wr + 16 * m + fr];
#pragma unroll
        for (int ai = 0; ai < 2; ++ai)
#pragma unroll
            for (int m = 0; m < 4; ++m) {
                const int r = 256 * u.pm + 128 * ai + 64 * wr + 16 * m + fr;
                const float rs = rsqrtf(sq[ai][m] * (1.f / 1024.f) + 1e-6f);
                bf16_t* rowp = base + (size_t)r * ld + 256 * pnl + 32 * wc + 8 * fq;
#pragma unroll
                for (int bj = 0; bj < 2; ++bj) { const f32x4 v0 = acc[ai][bj][m][0] * rs, v1 = acc[ai][bj][m][1] * rs;
                    u32x4 w; w.x = pk2(v0[0], v0[1]); w.y = pk2(v0[2], v0[3]); w.z = pk2(v1[0], v1[1]); w.w = pk2(v1[2], v1[3]);
                    *(u32x4*)(rowp + 128 * bj) = w; }
            }
    } };
struct EpiBr { bf16_t* BR;
    DEVI void operator()(const AccT& acc, const Unit& u, int wr, int wc, int fr, int fq) const {
        const int b = u.pn >> 2, p4 = u.pn & 3;
#pragma unroll
        for (int ai = 0; ai < 2; ++ai)
#pragma unroll
            for (int m = 0; m < 4; ++m) {
                const int r = 256 * u.pm + 128 * ai + 64 * wr + 16 * m + fr;
                bf16_t* rowp = BR + (size_t)r * 4096 + b * 1024 + 256 * p4 + 32 * wc + 8 * fq;
#pragma unroll
                for (int bj = 0; bj < 2; ++bj) { const f32x4 v0 = acc[ai][bj][m][0], v1 = acc[ai][bj][m][1];
                    u32x4 w; w.x = pk2(v0[0], v0[1]); w.y = pk2(v0[2], v0[3]); w.z = pk2(v1[0], v1[1]); w.w = pk2(v1[2], v1[3]);
                    *(u32x4*)(rowp + 128 * bj) = w; }
            }
    } };
struct EpiGate { const bf16_t* BR; const float* ssq; bf16_t* ZY;
    DEVI void operator()(const AccT& acc, const Unit& u, int wr, int wc, int fr, int fq) const {
        const int c = 64 * u.pn + 16 * wc + 4 * fq;
#pragma unroll
        for (int ai = 0; ai < 2; ++ai) {
            float sq[4]; u32x2 w[4][4];
#pragma unroll
            for (int m = 0; m < 4; ++m) { const int r = 256 * u.pm + 128 * ai + 64 * wr + 16 * m + fr; sq[m] = ssq[r]; const bf16_t* brr = BR + (size_t)r * 4096 + c;
#pragma unroll
                for (int b = 0; b < 4; ++b) w[m][b] = *(const u32x2*)(brr + b * 1024); }
#pragma unroll
            for (int m = 0; m < 4; ++m) {
                const int r = 256 * u.pm + 128 * ai + 64 * wr + 16 * m + fr;
                const float rs = rsqrtf(sq[m] * (1.f / 1024.f) + 1e-6f);
                float o0 = 0.f, o1 = 0.f, o2 = 0.f, o3 = 0.f;
#pragma unroll
                for (int bj = 0; bj < 2; ++bj)
#pragma unroll
                    for (int n = 0; n < 2; ++n) { const u32x2 ww = w[m][2 * bj + n]; const f32x4 g = acc[ai][bj][m][n];
                        o0 += sigm(g[0] * rs) * bflo(ww.x); o1 += sigm(g[1] * rs) * bfhi(ww.x); o2 += sigm(g[2] * rs) * bflo(ww.y); o3 += sigm(g[3] * rs) * bfhi(ww.y); }
                u32x2 o; o.x = pk2(o0, o1); o.y = pk2(o2, o3);
                *(u32x2*)(ZY + (size_t)r * 1024 + c) = o;
            }
        }
    } };
template <int LAYER, bool ATOM = true> struct EpiOut { const float* xp; const float* xs; bf16_t* XB; float* yout; float* ssq;
    DEVI void operator()(const AccT& acc, const Unit& u, int wr, int wc, int fr, int fq) const {
        const int col0 = 256 * u.pn + 32 * wc + 8 * fq;
#pragma unroll
        for (int ai = 0; ai < 2; ++ai) {
            if (256 * u.pm + 128 * ai >= ROWS) continue;
            f32x4 rf[4][2][2]; u32x4 rb[4][2];
#pragma unroll
            for (int m = 0; m < 4; ++m) { const int r = 256 * u.pm + 128 * ai + 64 * wr + 16 * m + fr;
#pragma unroll
                for (int bj = 0; bj < 2; ++bj) { const int col = col0 + 128 * bj;
                    if (LAYER == 0) { const float* xr = (r < NTOK ? xp + (size_t)r * 1024 : xs + (size_t)(r - NTOK) * 1024) + col; rf[m][bj][0] = *(const f32x4*)xr; rf[m][bj][1] = *(const f32x4*)(xr + 4); }
                    else rb[m][bj] = *(const u32x4*)(XB + (size_t)r * 1024 + col); } }
            float part[4];
#pragma unroll
            for (int m = 0; m < 4; ++m) {
                const int r = 256 * u.pm + 128 * ai + 64 * wr + 16 * m + fr;
                float ps = 0.f;
#pragma unroll
                for (int bj = 0; bj < 2; ++bj) { const int col = col0 + 128 * bj; f32x4 v0 = acc[ai][bj][m][0], v1 = acc[ai][bj][m][1];
                    if (LAYER == 0) { v0 += rf[m][bj][0]; v1 += rf[m][bj][1];
                        u32x4 w; w.x = pk2(v0[0], v0[1]); w.y = pk2(v0[2], v0[3]); w.z = pk2(v1[0], v1[1]); w.w = pk2(v1[2], v1[3]);
                        *(u32x4*)(XB + (size_t)r * 1024 + col) = w;
                    } else { const u32x4 w = rb[m][bj];
                        v0[0] += bflo(w.x); v0[1] += bfhi(w.x); v0[2] += bflo(w.y); v0[3] += bfhi(w.y); v1[0] += bflo(w.z); v1[1] += bfhi(w.z); v1[2] += bflo(w.w); v1[3] += bfhi(w.w);
                        *(f32x4*)(yout + (size_t)r * 1024 + col) = v0; *(f32x4*)(yout + (size_t)r * 1024 + col + 4) = v1; }
                    ps += v0[0] * v0[0] + v0[1] * v0[1] + v0[2] * v0[2] + v0[3] * v0[3] + v1[0] * v1[0] + v1[1] * v1[1] + v1[2] * v1[2] + v1[3] * v1[3]; }
                part[m] = ps;
            }
#pragma unroll
            for (int m = 0; m < 4; ++m) { const int r = 256 * u.pm + 128 * ai + 64 * wr + 16 * m + fr; float p = part[m]; p += __shfl_xor(p, 16); p += __shfl_xor(p, 32); if (ATOM && fq == 0) atomicAdd(ssq + r, p); }
        }
    } };

DEVI void transpose_item(const float* W, int ldw, const float* gain, int kind, bf16_t* WT, int K, int n0, int k0, float* scr, int lane) {
    const int nl = lane & 31, n = n0 + nl;
    const int sc = (kind == 0) ? w1_src(n) : ((n & ~255) + natcol(n & 255));
    float tw[32], tg[32];
#pragma unroll
    for (int i = 0; i < 32; ++i) { const int kk = 2 * i + (lane >> 5); tw[i] = (sc >= 0) ? W[(size_t)(k0 + kk) * ldw + sc] : 0.f; tg[i] = gain ? gain[k0 + kk] : 1.f; }
#pragma unroll
    for (int i = 0; i < 32; ++i) { const int kk = 2 * i + (lane >> 5); scr[kk * 33 + nl] = tw[i] * tg[i]; }
    LDS_WAIT();
    const int c = lane & 7;
#pragma unroll
    for (int j = 0; j < 4; ++j) { const int nn = (lane >> 3) + 8 * j; const float* s = scr + (8 * c) * 33 + nn;
        u32x4 o; o.x = pk2(s[0], s[33]); o.y = pk2(s[66], s[99]); o.z = pk2(s[132], s[165]); o.w = pk2(s[198], s[231]);
        *(u32x4*)(WT + (size_t)(n0 + nn) * K + k0 + 8 * c) = o; }
    LDS_WAIT();
}
DEVI void weight_items(const Params& P, unsigned char* smem, int it0, int it1, int gw, int NGW) {
    const int tid = tidx(), wave = tid >> 6, lane = tid & 63;
    float* scr = (float*)(smem + wave * 16384);
    bf16_t* W1T = (bf16_t*)(P.ws + OFF_W1T); bf16_t* WBR = (bf16_t*)(P.ws + OFF_WBR); bf16_t* WOUT = (bf16_t*)(P.ws + OFF_WOUT);
    constexpr int I1 = 2 * 232 * 16, I2 = 8 * 32 * 4;
    for (int it = it0 + gw; it < it1; it += NGW) {
        int r = it;
        if (r < I1) { const int l = r / 3712, q = r % 3712, nb = q >> 4, kb = q & 15;
            transpose_item(P.in[I_WIN] + (size_t)l * 1024 * INC, INC, P.in[I_NG] + l * 1024, 0, W1T + (size_t)l * 7424 * 1024, 1024, nb * 32, kb * 64, scr, lane); continue; }
        r -= I1;
        if (r < I2) { const int lb = r >> 7, q = r & 127, nb = q >> 2, kb = q & 3;
            transpose_item(P.in[I_WBR] + (size_t)lb * 256 * 1024, 1024, nullptr, 1, WBR + (size_t)lb * 1024 * 256, 256, nb * 32, kb * 64, scr, lane); continue; }
        r -= I2;
        { const int l = r >> 9, q = r & 511, nb = q >> 4, kb = q & 15;
            transpose_item(P.in[I_WOUT] + (size_t)l * 1024 * 1024, 1024, nullptr, 2, WOUT + (size_t)l * 1024 * 1024, 1024, nb * 32, kb * 64, scr, lane); }
    }
}
constexpr int WI_EARLY = 104 * 16, WI_ALL = 2 * 232 * 16 + 8 * 32 * 4 + 2 * 32 * 16;
DEVI void phase_p0(const Params& P, unsigned char* smem) {
    const int tid = tidx(), wave = tid >> 6, lane = tid & 63;
    const int gw = blockIdx.x * 8 + wave, NGW = gridDim.x * 8;
    weight_items(P, smem, 0, WI_ALL, gw, NGW);
    { bf16_t* WLT = (bf16_t*)(P.ws + OFF_WLT);
      for (int i = blockIdx.x * 512 + tid; i < 65536; i += gridDim.x * 512) { const int l = i >> 15, g = (i >> 14) & 1, n = (i >> 12) & 3, dd = (i >> 6) & 63, cc = i & 63;
          WLT[i] = f2bf(P.in[g ? I_WX : I_WA][((l * 4 + n) * 64 + cc) * 64 + dd]); } }
    bf16_t* XB = (bf16_t*)(P.ws + OFF_XB); float* ssq = (float*)(P.ws + OFF_SSQ);
    for (int row = gw; row < MPAD; row += NGW) {
        f32x4 v[4]; float s = 0.f;
        if (row < ROWS) { const f32x4* xr = (const f32x4*)(row < NTOK ? P.in[I_XP] + (size_t)row * 1024 : P.in[I_XS] + (size_t)(row - NTOK) * 1024) + lane;
#pragma unroll
            for (int j = 0; j < 4; ++j) { v[j] = xr[64 * j]; s += v[j][0] * v[j][0] + v[j][1] * v[j][1] + v[j][2] * v[j][2] + v[j][3] * v[j][3]; }
        } else {
#pragma unroll
            for (int j = 0; j < 4; ++j) v[j] = (f32x4){0.f, 0.f, 0.f, 0.f};
        }
        s = wave_sum(s);
        u32x2* o = (u32x2*)(XB + (size_t)row * 1024) + lane;
#pragma unroll
        for (int j = 0; j < 4; ++j) { u32x2 w; w.x = pk2(v[j][0], v[j][1]); w.y = pk2(v[j][2], v[j][3]); o[64 * j] = w; }
        if (lane == 0) { ssq[row] = s; ssq[MPAD + row] = 0.f; ssq[2 * MPAD + row] = 0.f; }
    }
}

DEVI void rwkv_prep(const Params& P, int l, int item) {
    const int tid = tidx(), wave = tid >> 6, lane = tid & 63, slot = wave >> 2, h = wave & 3, c = h * 64 + lane;
    const bf16_t* PA = (const bf16_t*)(P.ws + OFF_PA); bf16_t* RWP = (bf16_t*)(P.ws + OFF_RWP); float* RWC = (float*)(P.ws + OFF_RWC);
    const bool samp = item >= 1024; const int row0 = samp ? NTOK + (item - 1024) * 4 : item * 16, nit = samp ? 2 : 8;
    const float* mu = P.in[I_MU] + l * 832;
    float wup[32], aup[32];
#pragma unroll
    for (int j = 0; j < 32; ++j) { wup[j] = P.in[I_WUP][(l * 32 + j) * 256 + c]; aup[j] = P.in[I_AUP][(l * 32 + j) * 256 + c]; }
    const float w0 = P.in[I_W0][l * 256 + c], a0 = P.in[I_A0][l * 256 + c], kkw = P.in[I_KK][l * 256 + c], kaw = P.in[I_KA][l * 256 + c], rkw = P.in[I_RK][l * 256 + c];
    const float mur = mu[c], muk = mu[256 + c], muv = mu[512 + c], mul = mu[768 + lane];
    float aur[8], auk[8], auv[8], aul[8], apr[8], apk[8], apv[8], apl[8];
#pragma unroll
    for (int it = 0; it < 8; ++it) { const int row = row0 + 2 * (it < nit ? it : 0) + slot; const bf16_t* up = PA + (size_t)row * PALD;
        if (samp) { const float* sp = P.in[I_SSHIFT] + (size_t)(l * 128 + (row - NTOK)) * 832; apr[it] = sp[c]; apk[it] = sp[256 + c]; apv[it] = sp[512 + c]; apl[it] = sp[768 + lane]; }
        else if ((row & 2047) == 0) { apr[it] = apk[it] = apv[it] = apl[it] = 0.f; }
        else { const bf16_t* pp = up - PALD; apr[it] = bf2f(pp[c]); apk[it] = bf2f(pp[256 + c]); apv[it] = bf2f(pp[512 + c]); apl[it] = bf2f(pp[768 + lane]); }
        aur[it] = bf2f(up[c]); auk[it] = bf2f(up[256 + c]); auv[it] = bf2f(up[512 + c]); aul[it] = bf2f(up[768 + lane]); }
#pragma unroll
    for (int it = 0; it < 8; ++it) {
        if (it >= nit) break;
        const int row = row0 + 2 * it + slot;
        const float ur = aur[it], uk = auk[it], uv = auv[it], ul = aul[it], pr = apr[it], pk = apk[it], pv = apv[it], pl = apl[it];
        const float r = ur + (pr - ur) * mur, k = uk + (pk - uk) * muk, v = uv + (pv - uv) * muv;
        float lo = ul + (pl - ul) * mul;
        const float lt = lane < 32 ? ftanh(lo) : lo;
        float wpre = w0, apre = a0;
#pragma unroll
        for (int j = 0; j < 32; ++j) { wpre += rdlane(lt, j) * wup[j]; apre += rdlane(lt, 32 + j) * aup[j]; }
        const float w = -softplus(-wpre) - 0.5f, lw = __expf(w);
        const float a = sigm(apre);
        const float kkr = k * kkw; const float kk = kkr * __builtin_amdgcn_rsqf(fmaxf(wave_sum(kkr * kkr), 1e-24f));
        const float kp = k * (1.f + (a - 1.f) * kaw), ka = kk * a;
        const float kaq = bf2f(f2bf(ka)), kpq = bf2f(f2bf(kp)), rq = bf2f(f2bf(r));
        const float c1 = wave_sum(kaq * rq), c2 = wave_sum(kpq * rq), c3 = wave_sum(r * kp * rkw);
        bf16_t* o = RWP + (size_t)row * 1536 + c;
        o[0] = f2bf(lw); o[256] = f2bf(kk); o[512] = f2bf(ka); o[768] = f2bf(kp); o[1024] = f2bf(r); o[1280] = f2bf(v);
        if (lane == 0) { float* cc = RWC + (size_t)row * 16 + h * 4; cc[0] = c1; cc[1] = c2; cc[2] = c3; }
    }
    if (samp) { for (int i = tid; i < 4 * 832; i += 512) { const int rr = i / 832, cc = i % 832; const int b = row0 - NTOK + rr; P.out[O_SHS + (size_t)(l * 128 + b) * 832 + cc] = bf2f(PA[(size_t)(row0 + rr) * PALD + cc]); } }
    else if (((row0 + 16) & 2047) == 0) { const int b = row0 >> 11; for (int i = tid; i < 832; i += 512) P.out[O_SHP + (size_t)(l * 8 + b) * 832 + i] = bf2f(PA[(size_t)(row0 + 15) * PALD + i]); }
}
DEVI void cache_copy(const Params& P, int l, int b) {
    const bf16_t* PA = (const bf16_t*)(P.ws + OFF_PA);
    for (int i = tidx(); i < 128 * 128; i += 512) { const int j = i >> 7, c = i & 127; const bf16_t* rp = PA + (size_t)(b * 2048 + 1920 + j) * PALD + CC + 256 + c;
        P.out[O_KP + (size_t)((l * 8 + b) * 128 + j) * 128 + c] = bf2f(rp[0]); P.out[O_VP + (size_t)((l * 8 + b) * 128 + j) * 128 + c] = bf2f(rp[128]); }
}
DEVI void lru_prep(const Params& P, int l, int item, float* sm) {
    const int tid = tidx(), b = item >> 6, ck = item & 63, t0 = ck * 32;
    const bf16_t* PA = (const bf16_t*)(P.ws + OFF_PA);
    float* xs = sm; float* xc = sm + 35 * 256;
    __syncthreads();
    { bf16_t tx[18];
#pragma unroll
      for (int k = 0; k < 18; ++k) { const int i = tid + 512 * k, tt = i >> 8, ch = i & 255, tk = t0 - 3 + tt; tx[k] = (i < 35 * 256 && tk >= 0) ? PA[(size_t)(b * 2048 + tk) * PALD + CD + ch] : (bf16_t)0; }
#pragma unroll
      for (int k = 0; k < 18; ++k) { const int i = tid + 512 * k; if (i < 35 * 256) xs[i] = bf2f(tx[k]); } }
    __syncthreads();
    const int d = tid & 255, half = tid >> 8;
    { const float cb = P.in[I_CBI][l * 256 + d], c0 = P.in[I_CW][(l * 4 + 0) * 256 + d], c1 = P.in[I_CW][(l * 4 + 1) * 256 + d], c2 = P.in[I_CW][(l * 4 + 2) * 256 + d], c3 = P.in[I_CW][(l * 4 + 3) * 256 + d];
        for (int t = half; t < 32; t += 2) xc[t * 256 + d] = cb + c0 * xs[t * 256 + d] + c1 * xs[(t + 1) * 256 + d] + c2 * xs[(t + 2) * 256 + d] + c3 * xs[(t + 3) * 256 + d]; }
    __syncthreads();
    const int n = d >> 6, dl = d & 63;
    if (ck == 63) for (int i = tid; i < 768; i += 512) P.out[O_CVP + (size_t)(l * 8 + b) * 768 + i] = xs[32 * 256 + i];
    __syncthreads();
    {
        const int wave = tid >> 6, lane = tid & 63, wn = wave & 3, gate = wave >> 2, lr = lane & 15, lq = lane >> 4;
        float* gp = gate ? (sm + 67 * 256) : xs;
        const bf16_t* WL = (const bf16_t*)(P.ws + OFF_WLT) + (size_t)((l * 2 + gate) * 4 + wn) * 4096;
        bf16x8 bfr[4][2]; float bsv[4];
#pragma unroll
        for (int dt = 0; dt < 4; ++dt) { bsv[dt] = P.in[gate ? I_BX : I_BA][l * 256 + 64 * wn + 16 * dt + lr];
#pragma unroll
            for (int ks2 = 0; ks2 < 2; ++ks2) bfr[dt][ks2] = *(const bf16x8*)(WL + (16 * dt + lr) * 64 + 32 * ks2 + 8 * lq); }
#pragma unroll
        for (int tt = 0; tt < 2; ++tt) {
            bf16x8 afr[2];
#pragma unroll
            for (int ks2 = 0; ks2 < 2; ++ks2) { const float* xr = xc + (16 * tt + lr) * 256 + 64 * wn + 32 * ks2 + 8 * lq; const f32x4 x0 = *(const f32x4*)xr, x1 = *(const f32x4*)(xr + 4);
                u32x4 pk; pk.x = pk2(x0[0], x0[1]); pk.y = pk2(x0[2], x0[3]); pk.z = pk2(x1[0], x1[1]); pk.w = pk2(x1[2], x1[3]); afr[ks2] = __builtin_bit_cast(bf16x8, pk); }
#pragma unroll
            for (int dt = 0; dt < 4; ++dt) { f32x4 acc = {0.f, 0.f, 0.f, 0.f};
                acc = __builtin_amdgcn_mfma_f32_16x16x32_bf16(afr[0], bfr[dt][0], acc, 0, 0, 0); acc = __builtin_amdgcn_mfma_f32_16x16x32_bf16(afr[1], bfr[dt][1], acc, 0, 0, 0);
#pragma unroll
                for (int g = 0; g < 4; ++g) gp[(16 * tt + 4 * lq + g) * 256 + 64 * wn + 16 * dt + lr] = acc[g] + bsv[dt]; }
        }
    }
    __syncthreads();
    const float lsl = 8.f * logsig_acc(P.in[I_LAM][l * 256 + d]);
    float* LH = P.out + SO_LH; float* LP = P.out + SO_LP; float* LA = P.out + SO_LA; float* LB = P.out + SO_LB;
    const float* gr = xs; const float* gi = sm + 67 * 256;
    float hh = 0.f, pp = 1.f;
#pragma nounroll
    for (int tt = 0; tt < 16; ++tt) {
        const int t = half * 16 + tt;
        const float la = lsl * sigm(gr[t * 256 + d]), a = __expf(la), bt = __builtin_amdgcn_sqrtf(fmaxf(1.f - a * a, 0.f)) * sigm(gi[t * 256 + d]) * xc[t * 256 + d];
        hh = a * hh + bt; pp *= a;
        const size_t row = (size_t)b * 2048 + t0 + t; LH[row * 256 + d] = hh; LP[row * 256 + d] = pp;
    }
    const int sub = ck * 2 + half; LA[(size_t)(b * 128 + sub) * 256 + d] = pp; LB[(size_t)(b * 128 + sub) * 256 + d] = hh;
}
DEVI void gla_load_cum(const Params& P, int l, int h, int row0, float* gs, float* gl, float* seg) {
    const int tid = tidx(); const bf16_t* PA = (const bf16_t*)(P.ws + OFF_PA);
    { bf16_t t0 = PA[(size_t)(row0 + (tid >> 4)) * PALD + CB + 512 + (tid & 15)], t1 = PA[(size_t)(row0 + 32 + (tid >> 4)) * PALD + CB + 512 + (tid & 15)]; gl[tid] = bf2f(t0); gl[tid + 512] = bf2f(t1); }
    __syncthreads();
    const int d = tid & 31, sg = tid >> 5;
    float upc[16];
#pragma unroll
    for (int j = 0; j < 16; ++j) upc[j] = P.in[I_GUP][(l * 16 + j) * 128 + h * 32 + d];
    const float bias = P.in[I_GB][l * 128 + h * 32 + d];
    float run = 0.f, gv[4];
#pragma unroll
    for (int tt = 0; tt < 4; ++tt) { const int t = sg * 4 + tt; float x = bias;
#pragma unroll
        for (int j = 0; j < 16; ++j) x += gl[t * 16 + j] * upc[j];
        run += logsig(x) * (1.f / 16.f); gv[tt] = run; }
    seg[sg * 32 + d] = run;
    __syncthreads();
    float pre = 0.f; for (int s2 = 0; s2 < sg; ++s2) pre += seg[s2 * 32 + d];
#pragma unroll
    for (int tt = 0; tt < 4; ++tt) gs[(sg * 4 + tt) * 32 + d] = gv[tt] + pre;
    __syncthreads();
}
DEVI void gla_prep(const Params& P, int l, int item, float* sm) {
    const int tid = tidx(), c = item & 31, h = (item >> 5) & 3, b = item >> 7, row0 = b * 2048 + c * 64;
    const bf16_t* PA = (const bf16_t*)(P.ws + OFF_PA);
    float* gs = sm; float* ks = sm + 2048; float* vs = sm + 4096; float* gl = sm + 8192; float* seg = sm + 9216;
    __syncthreads();
    { bf16_t tk[4], tv[8];
#pragma unroll
      for (int k = 0; k < 4; ++k) { const int i = tid + 512 * k, t = i >> 5, d = i & 31; tk[k] = PA[(size_t)(row0 + t) * PALD + CB + 128 + h * 32 + d]; }
#pragma unroll
      for (int k = 0; k < 8; ++k) { const int i = tid + 512 * k, t = i >> 6, e = i & 63; tv[k] = PA[(size_t)(row0 + t) * PALD + CB + 256 + h * 64 + e]; }
#pragma unroll
      for (int k = 0; k < 4; ++k) ks[tid + 512 * k] = bf2f(tk[k]);
#pragma unroll
      for (int k = 0; k < 8; ++k) vs[tid + 512 * k] = bf2f(tv[k]); }
    gla_load_cum(P, l, h, row0, gs, gl, seg);
    for (int i = tid; i < 2048; i += 512) { const int d = i & 31; ks[i] *= __expf(gs[63 * 32 + d] - gs[i]); }
    __syncthreads();
    { const int d = tid >> 4, e4 = (tid & 15) * 4; f32x4 u = {0.f, 0.f, 0.f, 0.f};
        for (int t = 0; t < 64; ++t) { const float kd = ks[t * 32 + d]; const f32x4 v4 = *(const f32x4*)(vs + t * 64 + e4); u += v4 * kd; }
        *(f32x4*)(P.out + SO_GU + (size_t)item * 2048 + d * 64 + e4) = u; }
    if (tid < 32) P.out[SO_GD + (size_t)item * 32 + tid] = __expf(gs[63 * 32 + tid]);
}

DEVI void rwkv_scan_prompt(const Params& P, int l, int item, float* sm) {
    const int b = item >> 4, h = (item >> 2) & 3, q = item & 3;
    const int tid = tidx(), wave = tid >> 6, lane = tid & 63;
    const bf16_t* RWP = (const bf16_t*)(P.ws + OFF_RWP); const float* RWC = (const float*)(P.ws + OFF_RWC); float* RWO = P.out + SO_RWO;
    constexpr int T = 32, BUF = 5 * T * 64 + T * 16 + T * 2;
    const size_t rbase = (size_t)b * 2048;
    float* buf0 = sm; float* buf1 = sm + BUF;
    auto load_chunk = [&](int c, float* buf) {
        const int lt = tid - 256, ch = lt & 63, tq = lt >> 6;
        bf16_t raw[8][5], rv[2]; float rc = 0.f;
#pragma unroll
        for (int i = 0; i < 8; ++i) { const int t = tq + 4 * i; const bf16_t* rp = RWP + (rbase + c * T + t) * 1536 + h * 64 + ch;
            raw[i][0] = rp[0]; raw[i][1] = rp[256]; raw[i][2] = rp[512]; raw[i][3] = rp[768]; raw[i][4] = rp[1024]; }
#pragma unroll
        for (int i = 0; i < 2; ++i) { const int t = (lt >> 4) + 16 * i, rr = lt & 15; rv[i] = RWP[(rbase + c * T + t) * 1536 + 1280 + h * 64 + 16 * q + rr]; }
        if (lt < 64) { const int t = lt >> 1, j = lt & 1; rc = RWC[(rbase + c * T + t) * 16 + h * 4 + j]; }
#pragma unroll
        for (int i = 0; i < 8; ++i) { const int t = tq + 4 * i;
            const float lw = bf2f(raw[i][0]), kk = bf2f(raw[i][1]), ka = bf2f(raw[i][2]), kp = bf2f(raw[i][3]), r = bf2f(raw[i][4]); const float dd = __expf(-lw);
            buf[t * 64 + ch] = dd; buf[T * 64 + t * 64 + ch] = dd * r; buf[2 * T * 64 + t * 64 + ch] = kk; buf[3 * T * 64 + t * 64 + ch] = ka; buf[4 * T * 64 + t * 64 + ch] = kp; }
#pragma unroll
        for (int i = 0; i < 2; ++i) { const int t = (lt >> 4) + 16 * i, rr = lt & 15; buf[5 * T * 64 + t * 16 + rr] = bf2f(rv[i]); }
        if (lt < 64) { const int t = lt >> 1, j = lt & 1; buf[5 * T * 64 + T * 16 + t * 2 + j] = rc; }
    };
    __syncthreads();
    if (tid >= 256) load_chunk(0, buf0);
    __syncthreads();
    const int rowgrp = lane >> 4, ks = lane & 15, vloc = 4 * wave + rowgrp, vrow = 16 * q + vloc;
    f32x4 S = {0.f, 0.f, 0.f, 0.f};
    for (int c = 0; c < SEQ / T; ++c) {
        float* cur = (c & 1) ? buf1 : buf0; float* nxt = (c & 1) ? buf0 : buf1;
        if (tid >= 256) { if (c + 1 < SEQ / T) load_chunk(c + 1, nxt); }
        else {
            const float* cb = cur + 4 * ks;
            f32x4 d4 = *(const f32x4*)(cb), dr4 = *(const f32x4*)(cb + T * 64), kk4 = *(const f32x4*)(cb + 2 * T * 64), ka4 = *(const f32x4*)(cb + 3 * T * 64), kp4 = *(const f32x4*)(cb + 4 * T * 64);
            float vv = cur[5 * T * 64 + vloc]; f32x2 cc = *(const f32x2*)(cur + 5 * T * 64 + T * 16);
            float* op = RWO + (rbase + (size_t)c * T) * 256 + h * 64 + vrow;
#pragma unroll 16
            for (int t = 0; t < T; ++t) {
                const float* nb = cb + (t + 1) * 64;
                const f32x4 nd4 = *(const f32x4*)(nb), ndr4 = *(const f32x4*)(nb + T * 64), nkk4 = *(const f32x4*)(nb + 2 * T * 64), nka4 = *(const f32x4*)(nb + 3 * T * 64), nkp4 = *(const f32x4*)(nb + 4 * T * 64);
                const float nvv = cur[5 * T * 64 + (t + 1) * 16 + vloc]; const f32x2 ncc = *(const f32x2*)(cur + 5 * T * 64 + T * 16 + (t + 1) * 2);
                const f32x2 t1 = S.lo * kk4.lo + S.hi * kk4.hi, t2 = S.lo * dr4.lo + S.hi * dr4.hi;
                float p1 = t1.x + t1.y, p2 = t2.x + t2.y;
                p1 = reduce16(p1); p2 = reduce16(p2);
                const float sa = -p1;
                S = S * d4 + ka4 * sa + kp4 * vv;
                op[t * 256] = p2 + sa * cc[0] + vv * cc[1];
                d4 = nd4; dr4 = ndr4; kk4 = nkk4; ka4 = nka4; kp4 = nkp4; vv = nvv; cc = ncc;
            }
        }
        __syncthreads();
    }
    if (tid < 256) *(f32x4*)(P.out + O_WKVP + ((size_t)((l * 8 + b) * 4 + h) * 64 + vrow) * 64 + 4 * ks) = S;
}
DEVI void rwkv_scan_sample(const Params& P, int l, int item) {
    const int tid = tidx(), wave = tid >> 6, lane = tid & 63, pair = item * 8 + wave, b = pair >> 2, h = pair & 3;
    const bf16_t* RWP = (const bf16_t*)(P.ws + OFF_RWP); const float* RWC = (const float*)(P.ws + OFF_RWC); float* RWO = P.out + SO_RWO;
    const size_t row = NTOK + b; const int rowgrp = lane >> 4, ks = lane & 15;
    const bf16_t* rp = RWP + row * 1536 + h * 64 + 4 * ks;
    f32x4 d4, dr4, kk4, ka4, kp4;
#pragma unroll
    for (int j = 0; j < 4; ++j) { const float lw = bf2f(rp[j]), r = bf2f(rp[1024 + j]); d4[j] = __expf(-lw); dr4[j] = d4[j] * r; kk4[j] = bf2f(rp[256 + j]); ka4[j] = bf2f(rp[512 + j]); kp4[j] = bf2f(rp[768 + j]); }
    const float c1 = RWC[row * 16 + h * 4], c2 = RWC[row * 16 + h * 4 + 1];
    const float* S0 = P.in[I_SWKV] + (size_t)((l * 128 + b) * 4 + h) * 4096; float* S1 = P.out + O_WKVS + (size_t)((l * 128 + b) * 4 + h) * 4096;
    f32x4 Sv[16]; bf16_t vr[16];
#pragma unroll
    for (int it = 0; it < 16; ++it) { const int vrow = 4 * it + rowgrp; Sv[it] = *(const f32x4*)(S0 + vrow * 64 + 4 * ks); vr[it] = RWP[row * 1536 + 1280 + h * 64 + vrow]; }
#pragma unroll
    for (int it = 0; it < 16; ++it) {
        const int vrow = 4 * it + rowgrp;
        f32x4 S = Sv[it];
        const float vv = bf2f(vr[it]);
        float p1 = (S[0] * kk4[0] + S[1] * kk4[1]) + (S[2] * kk4[2] + S[3] * kk4[3]);
        float p2 = (S[0] * dr4[0] + S[1] * dr4[1]) + (S[2] * dr4[2] + S[3] * dr4[3]);
        p1 = reduce16(p1); p2 = reduce16(p2);
        const float sa = -p1;
        S = S * d4 + ka4 * sa + kp4 * vv;
        *(f32x4*)(S1 + vrow * 64 + 4 * ks) = S;
        RWO[row * 256 + h * 64 + vrow] = p2 + sa * c1 + vv * c2;
    }
}
DEVI void gla_prefix(const Params& P, int l, int bh) {
    const int idx = tidx() * 4, d = idx >> 6;
    float* GU = P.out + SO_GU; const float* GD = P.out + SO_GD;
    f32x4 S = {0.f, 0.f, 0.f, 0.f};
#pragma nounroll
    for (int c0 = 0; c0 < 32; c0 += 8) {
        f32x4 U[8]; float dd[8];
#pragma unroll
        for (int c = 0; c < 8; ++c) { const size_t it = (size_t)bh * 32 + c0 + c; U[c] = *(const f32x4*)(GU + it * 2048 + idx); dd[c] = GD[it * 32 + d]; }
#pragma unroll
        for (int c = 0; c < 8; ++c) { const size_t it = (size_t)bh * 32 + c0 + c; *(f32x4*)(GU + it * 2048 + idx) = S; S = S * dd[c] + U[c]; }
    }
    *(f32x4*)(P.out + O_GLP + (size_t)(l * 32 + bh) * 2048 + idx) = S;
}
DEVI void lru_carry(const Params& P, int l, int b) {
    if (tidx() >= 256) return;
    const int d = tidx(); const float* LA = P.out + SO_LA; float* LB = P.out + SO_LB;
    float carry = 0.f;
#pragma nounroll
    for (int s0 = 0; s0 < 128; s0 += 32) {
        float A[32], Bv[32];
#pragma unroll
        for (int s = 0; s < 32; ++s) { const size_t o = (size_t)(b * 128 + s0 + s) * 256 + d; A[s] = LA[o]; Bv[s] = LB[o]; }
#pragma unroll
        for (int s = 0; s < 32; ++s) { const size_t o = (size_t)(b * 128 + s0 + s) * 256 + d; LB[o] = carry; carry = A[s] * carry + Bv[s]; }
    }
    P.out[O_HP + (size_t)(l * 8 + b) * 256 + d] = carry;
}
template <bool DRY = false> DEVI void swa_prompt(const Params& P, int l, int item, float* sm) {
    const bool dost = !DRY || (P.ws == nullptr);
    const int tid = tidx(), b = item >> 6, kv = (item >> 5) & 1, qb = item & 31, t0 = qb * 64;
    const bf16_t* PA = (const bf16_t*)(P.ws + OFF_PA); bf16_t* ZY = (bf16_t*)(P.ws + OFF_ZY);
    float* Ks = sm; float* Vs = sm + 192 * 68;
    __syncthreads();
    u32x4 kwa[3], vwa[3];
#pragma unroll
    for (int k = 0; k < 3; ++k) { const int i = tid + 512 * k, ls = i >> 3, c8 = (i & 7) * 8, s = t0 - 128 + ls; kwa[k] = (u32x4){0u, 0u, 0u, 0u}; vwa[k] = (u32x4){0u, 0u, 0u, 0u};
        if (s >= 0) { const bf16_t* rp = PA + (size_t)(b * 2048 + s) * PALD + CC + 256 + kv * 64 + c8; kwa[k] = *(const u32x4*)rp; vwa[k] = *(const u32x4*)(rp + 128); } }
#pragma unroll
    for (int k = 0; k < 3; ++k) { const int i = tid + 512 * k, ls = i >> 3, c8 = (i & 7) * 8; const u32x4 kw = kwa[k], vw = vwa[k];
        *(f32x4*)(Ks + ls * 68 + c8) = (f32x4){bflo(kw.x), bfhi(kw.x), bflo(kw.y), bfhi(kw.y)}; *(f32x4*)(Ks + ls * 68 + c8 + 4) = (f32x4){bflo(kw.z), bfhi(kw.z), bflo(kw.w), bfhi(kw.w)};
        *(f32x4*)(Vs + ls * 68 + c8) = (f32x4){bflo(vw.x), bfhi(vw.x), bflo(vw.y), bfhi(vw.y)}; *(f32x4*)(Vs + ls * 68 + c8 + 4) = (f32x4){bflo(vw.z), bfhi(vw.z), bflo(vw.w), bfhi(vw.w)}; }
    __syncthreads();
    const int rowid = tid >> 2, part = tid & 3, g = rowid & 1, qi = rowid >> 1, hh = kv * 2 + g, t = t0 + qi;
    const size_t row = (size_t)b * 2048 + t;
    f32x2 q2[8];
    { const u32x4* qp = (const u32x4*)(PA + row * PALD + CC + hh * 64 + 16 * part);
#pragma unroll
        for (int i = 0; i < 2; ++i) { const u32x4 w = qp[i]; q2[4 * i] = (f32x2){bflo(w.x), bfhi(w.x)} * 0.125f; q2[4 * i + 1] = (f32x2){bflo(w.y), bfhi(w.y)} * 0.125f;
            q2[4 * i + 2] = (f32x2){bflo(w.z), bfhi(w.z)} * 0.125f; q2[4 * i + 3] = (f32x2){bflo(w.w), bfhi(w.w)} * 0.125f; } }
    const float slope = exp2f(-2.f * (float)(hh + 1));
    float m = -1e30f, lsum = 0.f; f32x2 acc2[8];
#pragma unroll
    for (int i = 0; i < 8; ++i) acc2[i] = (f32x2){0.f, 0.f};
    const int j0 = (t < 128) ? (128 - t) : 0;
    for (int j = j0; j <= 128; j += 2) {
        const bool vb = (j + 1) <= 128; const int rb = vb ? (qi + j + 1) : (qi + j);
        const float* kra = Ks + (qi + j) * 68 + 16 * part; const float* krb = Ks + rb * 68 + 16 * part;
        f32x2 sa2 = {0.f, 0.f}, sb2 = {0.f, 0.f};
#pragma unroll
        for (int i = 0; i < 4; ++i) { const f32x4 ka = *(const f32x4*)(kra + 4 * i), kb = *(const f32x4*)(krb + 4 * i);
            sa2 += q2[2 * i] * ka.lo; sa2 += q2[2 * i + 1] * ka.hi; sb2 += q2[2 * i] * kb.lo; sb2 += q2[2 * i + 1] * kb.hi; }
        const float sca = quad_sum(sa2.x + sa2.y) - slope * (float)(128 - j);
        const float scb = vb ? (quad_sum(sb2.x + sb2.y) - slope * (float)(127 - j)) : -1e30f;
        const float mn = fmaxf(sca, scb);
        if (mn > m) { const float corr = __expf(m - mn); lsum *= corr;
#pragma unroll
            for (int i = 0; i < 8; ++i) acc2[i] *= corr;
            m = mn; }
        const float pa = __expf(sca - m), pb = vb ? __expf(scb - m) : 0.f; lsum += pa + pb;
        const float* vra = Vs + (qi + j) * 68 + 16 * part; const float* vrb = Vs + rb * 68 + 16 * part;
#pragma unroll
        for (int i = 0; i < 4; ++i) { const f32x4 va = *(const f32x4*)(vra + 4 * i), vbv = *(const f32x4*)(vrb + 4 * i);
            acc2[2 * i] += va.lo * pa; acc2[2 * i + 1] += va.hi * pa; acc2[2 * i] += vbv.lo * pb; acc2[2 * i + 1] += vbv.hi * pb; }
    }
    float acc[16];
#pragma unroll
    for (int i = 0; i < 8; ++i) { acc[2 * i] = acc2[i].x; acc[2 * i + 1] = acc2[i].y; }
    const float sk = P.in[I_SINK][l * 4 + hh], mf = fmaxf(m, sk), e = __expf(m - mf), inv = e * frcp(lsum * e + __expf(sk - mf));
    bf16_t* zp = ZY + row * 1024 + 512 + hh * 64 + 16 * part;
    const u32x4 z0 = *(const u32x4*)zp, z1 = *(const u32x4*)(zp + 8);
    float o[16];
#pragma unroll
    for (int i = 0; i < 16; ++i) o[i] = acc[i] * inv;
    u32x4 w0, w1;
    w0.x = pk2(o[0] * silu(bflo(z0.x)), o[1] * silu(bfhi(z0.x))); w0.y = pk2(o[2] * silu(bflo(z0.y)), o[3] * silu(bfhi(z0.y)));
    w0.z = pk2(o[4] * silu(bflo(z0.z)), o[5] * silu(bfhi(z0.z))); w0.w = pk2(o[6] * silu(bflo(z0.w)), o[7] * silu(bfhi(z0.w)));
    w1.x = pk2(o[8] * silu(bflo(z1.x)), o[9] * silu(bfhi(z1.x))); w1.y = pk2(o[10] * silu(bflo(z1.y)), o[11] * silu(bfhi(z1.y)));
    w1.z = pk2(o[12] * silu(bflo(z1.z)), o[13] * silu(bfhi(z1.z))); w1.w = pk2(o[14] * silu(bflo(z1.w)), o[15] * silu(bfhi(z1.w)));
    if (dost) { *(u32x4*)zp = w0; *(u32x4*)(zp + 8) = w1; }
}
DEVI void swa_sample(const Params& P, int l, int b, float* sm) {
    const int tid = tidx(), wave = tid >> 6, lane = tid & 63; const size_t row = NTOK + b;
    const bf16_t* PA = (const bf16_t*)(P.ws + OFF_PA); bf16_t* ZY = (bf16_t*)(P.ws + OFF_ZY);
    float* qs = sm; float* kn = sm + 256; float* vn = sm + 384; float* sc = sm + 512;
    const float* CK = P.in[I_CK] + (size_t)(l * 128 + b) * 16384; const float* CV = P.in[I_CV] + (size_t)(l * 128 + b) * 16384;
    __syncthreads();
    { const float v = bf2f(PA[row * PALD + CC + tid]); if (tid < 256) qs[tid] = v * 0.125f; else if (tid < 384) kn[tid - 256] = v; else vn[tid - 384] = v; }
    __syncthreads();
    { const int hh = tid >> 7, s = tid & 127, kv = hh >> 1; const f32x4* kp = (const f32x4*)(CK + s * 128 + kv * 64); const float* qh = qs + hh * 64; float d = 0.f;
#pragma unroll
        for (int i = 0; i < 16; ++i) { const f32x4 k4 = kp[i]; d += qh[4 * i] * k4[0] + qh[4 * i + 1] * k4[1] + qh[4 * i + 2] * k4[2] + qh[4 * i + 3] * k4[3]; }
        sc[hh * 132 + s] = d - exp2f(-2.f * (float)(hh + 1)) * (float)(128 - s); }
    if (wave < 4) { const int hh = wave; const float d = wave_sum(qs[hh * 64 + lane] * kn[(hh >> 1) * 64 + lane]); if (lane == 0) sc[hh * 132 + 128] = d; }
    __syncthreads();
    if (wave < 4) { const int hh = wave; const float a0 = sc[hh * 132 + lane], a1 = sc[hh * 132 + 64 + lane], a2 = lane == 0 ? sc[hh * 132 + 128] : -1e30f, sk = P.in[I_SINK][l * 4 + hh];
        const float mx = fmaxf(wave_max(fmaxf(fmaxf(a0, a1), a2)), sk); const float e0 = __expf(a0 - mx), e1 = __expf(a1 - mx), e2 = lane == 0 ? __expf(a2 - mx) : 0.f;
        const float inv = frcp(wave_sum(e0 + e1 + e2) + __expf(sk - mx));
        sc[hh * 132 + lane] = e0 * inv; sc[hh * 132 + 64 + lane] = e1 * inv; if (lane == 0) sc[hh * 132 + 128] = e2 * inv; }
    __syncthreads();
    if (tid < 256) { const int hh = tid >> 6, dd = tid & 63, kv = hh >> 1; const float* pp = sc + hh * 132; float o = pp[128] * vn[kv * 64 + dd];
#pragma nounroll
        for (int s0 = 0; s0 < 128; s0 += 32) { float cvv[32];
#pragma unroll
            for (int s = 0; s < 32; ++s) cvv[s] = CV[(s0 + s) * 128 + kv * 64 + dd];
#pragma unroll
            for (int s = 0; s < 32; ++s) o += pp[s0 + s] * cvv[s]; }
        bf16_t* zp = ZY + row * 1024 + 512 + tid; *zp = f2bf(o * silu(bf2f(*zp))); }
    float* KO = P.out + O_KS + (size_t)(l * 128 + b) * 16384; float* VO = P.out + O_VS + (size_t)(l * 128 + b) * 16384;
    { f32x4 tk[8], tv[8];
#pragma unroll
      for (int k = 0; k < 8; ++k) { const int e = (tid + 512 * k) * 4;
        if (e < 127 * 128) { tk[k] = *(const f32x4*)(CK + 128 + e); tv[k] = *(const f32x4*)(CV + 128 + e); }
        else { tk[k] = *(const f32x4*)(kn + (e - 127 * 128)); tv[k] = *(const f32x4*)(vn + (e - 127 * 128)); } }
#pragma unroll
      for (int k = 0; k < 8; ++k) { const int e = (tid + 512 * k) * 4; *(f32x4*)(KO + e) = tk[k]; *(f32x4*)(VO + e) = tv[k]; } }
}
DEVI void gla_sample(const Params& P, int l, int b, float* sm) {
    const int tid = tidx(); const size_t row = NTOK + b;
    const bf16_t* PA = (const bf16_t*)(P.ws + OFF_PA); bf16_t* ZY = (bf16_t*)(P.ws + OFF_ZY);
    float* qs = sm; float* ks = sm + 128; float* eg = sm + 256; float* gl = sm + 384;
    __syncthreads();
    if (tid < 128) { qs[tid] = bf2f(PA[row * PALD + CB + tid]) * 0.17677669529663687f; ks[tid] = bf2f(PA[row * PALD + CB + 128 + tid]); }
    if (tid >= 128 && tid < 144) gl[tid - 128] = bf2f(PA[row * PALD + CB + 512 + tid - 128]);
    __syncthreads();
    if (tid < 128) { float x = P.in[I_GB][l * 128 + tid];
#pragma unroll
        for (int j = 0; j < 16; ++j) x += gl[j] * P.in[I_GUP][(l * 16 + j) * 128 + tid];
        eg[tid] = __expf(logsig(x) * (1.f / 16.f)); }
    __syncthreads();
    if (tid < 256) { const int h = tid >> 6, e = tid & 63; const float v = bf2f(PA[row * PALD + CB + 256 + tid]);
        const float* S0 = P.in[I_SGLA] + (size_t)((l * 128 + b) * 4 + h) * 2048; float* S1 = P.out + O_GLS + (size_t)((l * 128 + b) * 4 + h) * 2048;
        float o = 0.f, s0v[32];
#pragma unroll
        for (int d = 0; d < 32; ++d) s0v[d] = S0[d * 64 + e];
#pragma unroll
        for (int d = 0; d < 32; ++d) { const float sn = eg[h * 32 + d] * s0v[d] + ks[h * 32 + d] * v; S1[d * 64 + e] = sn; o += qs[h * 32 + d] * sn; }
        const float rr = rsqrtf(wave_sum(o * o) * (1.f / 64.f) + 1e-6f);
        bf16_t* zp = ZY + row * 1024 + 256 + tid; *zp = f2bf(o * rr * P.in[I_GNG][l * 64 + e] * silu(bf2f(*zp))); }
}
DEVI void lru_sample(const Params& P, int l, int item, float* sm) {
    const int tid = tidx(), s = tid >> 8, d = tid & 255, b = item * 2 + s; const size_t row = NTOK + b;
    const bf16_t* PA = (const bf16_t*)(P.ws + OFF_PA); bf16_t* ZY = (bf16_t*)(P.ws + OFF_ZY);
    float* xcs = sm;
    __syncthreads();
    const float x = bf2f(PA[row * PALD + CD + d]); const float* cv = P.in[I_SCONV] + (size_t)(l * 128 + b) * 768;
    const float c0 = cv[d], c1 = cv[256 + d], c2 = cv[512 + d];
    const float xc = P.in[I_CBI][l * 256 + d] + P.in[I_CW][(l * 4 + 0) * 256 + d] * c0 + P.in[I_CW][(l * 4 + 1) * 256 + d] * c1 + P.in[I_CW][(l * 4 + 2) * 256 + d] * c2 + P.in[I_CW][(l * 4 + 3) * 256 + d] * x;
    xcs[s * 256 + d] = xc;
    __syncthreads();
    const int n = d >> 6, dl = d & 63; float rp = P.in[I_BA][l * 256 + d], ip = P.in[I_BX][l * 256 + d];
#pragma unroll 8
    for (int c = 0; c < 64; ++c) { const float xv = xcs[s * 256 + n * 64 + c]; rp += xv * P.in[I_WA][((l * 4 + n) * 64 + c) * 64 + dl]; ip += xv * P.in[I_WX][((l * 4 + n) * 64 + c) * 64 + dl]; }
    const float la = 8.f * logsig_acc(P.in[I_LAM][l * 256 + d]) * sigm(rp), a = __expf(la), bt = __builtin_amdgcn_sqrtf(fmaxf(-expm1f(2.f * la), 0.f)) * sigm(ip) * xc;
    const float hn = a * P.in[I_SH][(size_t)(l * 128 + b) * 256 + d] + bt;
    float* co = P.out + O_CVS + (size_t)(l * 128 + b) * 768; co[d] = c1; co[256 + d] = c2; co[512 + d] = x;
    P.out[O_HS + (size_t)(l * 128 + b) * 256 + d] = hn;
    bf16_t* zp = ZY + row * 1024 + 768 + d; *zp = f2bf(hn * silu(bf2f(*zp)));
}

template <bool DRY = false> DEVI void rwkv_post(const Params& P, int l, int item) {
    const bool dost = !DRY || (P.ws == nullptr);
    const int tid = tidx(), wave = tid >> 6, lane = tid & 63;
    const bf16_t* RWP = (const bf16_t*)(P.ws + OFF_RWP); const float* RWC = (const float*)(P.ws + OFF_RWC); const float* RWO = P.out + SO_RWO; bf16_t* ZY = (bf16_t*)(P.ws + OFF_ZY);
    float o[8], v[8], z[8], c3[8];
#pragma unroll
    for (int k = 0; k < 8; ++k) { const int task = wave * 8 + k, h = task & 3; const size_t row = (size_t)item * 16 + (task >> 2);
        o[k] = RWO[row * 256 + h * 64 + lane]; v[k] = bf2f(RWP[row * 1536 + 1280 + h * 64 + lane]); z[k] = bf2f(ZY[row * 1024 + h * 64 + lane]); c3[k] = RWC[row * 16 + h * 4 + 2]; }
#pragma unroll
    for (int k = 0; k < 8; ++k) { const int task = wave * 8 + k, h = task & 3; const size_t row = (size_t)item * 16 + (task >> 2);
        const float mean = wave_sum(o[k]) * (1.f / 64.f); const float dv = o[k] - mean; const float var = wave_sum(dv * dv) * (1.f / 64.f);
        const float y = dv * rsqrtf(var + 64e-5f) * P.in[I_LNG][l * 256 + h * 64 + lane] + P.in[I_LNB][l * 256 + h * 64 + lane] + c3[k] * v[k];
        if (dost) ZY[row * 1024 + h * 64 + lane] = f2bf(y * silu(z[k])); }
}
template <bool DRY = false> DEVI void lru_final(const Params& P, int l, int item) {
    const bool dost = !DRY || (P.ws == nullptr);
    const int tid = tidx(), b = item >> 6, ck = item & 63, d = tid & 255, half = tid >> 8, sub = ck * 2 + half;
    const float* LH = P.out + SO_LH; const float* LP = P.out + SO_LP; const float* LB = P.out + SO_LB; bf16_t* ZY = (bf16_t*)(P.ws + OFF_ZY);
    const float carry = LB[(size_t)(b * 128 + sub) * 256 + d];
    const size_t r0 = (size_t)b * 2048 + ck * 32 + half * 16;
    float hv[16], z[16];
#pragma unroll
    for (int tt = 0; tt < 16; ++tt) { hv[tt] = LH[(r0 + tt) * 256 + d] + LP[(r0 + tt) * 256 + d] * carry; z[tt] = bf2f(ZY[(r0 + tt) * 1024 + 768 + d]); }
#pragma unroll
    for (int tt = 0; tt < 16; ++tt) if (dost) ZY[(r0 + tt) * 1024 + 768 + d] = f2bf(hv[tt] * silu(z[tt]));
}
template <bool DRY = false> DEVI void gla_out(const Params& P, int l, int item, float* sm) {
    const bool dost = !DRY || (P.ws == nullptr);
    const int tid = tidx(), c = item & 31, h = (item >> 5) & 3, b = item >> 7, row0 = b * 2048 + c * 64;
    const bf16_t* PA = (const bf16_t*)(P.ws + OFF_PA); bf16_t* ZY = (bf16_t*)(P.ws + OFF_ZY);
    float* gs = sm; float* gl = sm + 2048; float* seg = sm + 3072; float* qs = sm + 3584; float* ks = qs + 64 * 36; float* vs = ks + 64 * 36; float* att = vs + 4096; float* Ss = att + 64 * 65;
    __syncthreads();
    { bf16_t tq[4], tk[4], tv[8]; float ts[4];
#pragma unroll
      for (int k = 0; k < 4; ++k) { const int i = tid + 512 * k, t = i >> 5, d = i & 31; const bf16_t* rp = PA + (size_t)(row0 + t) * PALD + CB + h * 32 + d; tq[k] = rp[0]; tk[k] = rp[128]; ts[k] = P.out[SO_GU + (size_t)item * 2048 + i]; }
#pragma unroll
      for (int k = 0; k < 8; ++k) { const int i = tid + 512 * k, t = i >> 6, e = i & 63; tv[k] = PA[(size_t)(row0 + t) * PALD + CB + 256 + h * 64 + e]; }
#pragma unroll
      for (int k = 0; k < 4; ++k) { const int i = tid + 512 * k, t = i >> 5, d = i & 31; qs[t * 36 + d] = bf2f(tq[k]) * 0.17677669529663687f; ks[t * 36 + d] = bf2f(tk[k]); Ss[i] = ts[k]; }
#pragma unroll
      for (int k = 0; k < 8; ++k) vs[tid + 512 * k] = bf2f(tv[k]); }
    gla_load_cum(P, l, h, row0, gs, gl, seg);
    for (int i = tid; i < 2048; i += 512) { const int t = i >> 5, d = i & 31; const float bc = gs[i]; qs[t * 36 + d] *= __expf(bc); ks[t * 36 + d] *= __expf(-bc); }
    __syncthreads();
    const int t = tid >> 3, s8 = (tid & 7) * 8;
    {
        f32x4 qv[8];
#pragma unroll
        for (int d4 = 0; d4 < 8; ++d4) qv[d4] = *(const f32x4*)(qs + t * 36 + 4 * d4);
#pragma unroll
        for (int i = 0; i < 8; ++i) { const int s = 8 * i + (tid & 7); float a = 0.f;
            if (s <= t) { f32x2 a2 = {0.f, 0.f};
#pragma unroll
                for (int d4 = 0; d4 < 8; ++d4) { const f32x4 kv = *(const f32x4*)(ks + s * 36 + 4 * d4); a2 += qv[d4].lo * kv.lo; a2 += qv[d4].hi * kv.hi; }
                a = a2.x + a2.y; }
            att[t * 65 + s] = a; }
    }
    __syncthreads();
    const int e8 = s8; float o[8]; f32x2 o2[4];
#pragma unroll
    for (int i = 0; i < 4; ++i) o2[i] = (f32x2){0.f, 0.f};
#pragma unroll 2
    for (int s = 0; s <= t; ++s) { const float a = att[t * 65 + s]; const f32x4 v0 = *(const f32x4*)(vs + s * 64 + e8), v1 = *(const f32x4*)(vs + s * 64 + e8 + 4);
        o2[0] += v0.lo * a; o2[1] += v0.hi * a; o2[2] += v1.lo * a; o2[3] += v1.hi * a; }
#pragma unroll 8
    for (int d = 0; d < 32; ++d) { const float a = qs[t * 36 + d]; const f32x4 v0 = *(const f32x4*)(Ss + d * 64 + e8), v1 = *(const f32x4*)(Ss + d * 64 + e8 + 4);
        o2[0] += v0.lo * a; o2[1] += v0.hi * a; o2[2] += v1.lo * a; o2[3] += v1.hi * a; }
#pragma unroll
    for (int i = 0; i < 4; ++i) { o[2 * i] = o2[i].x; o[2 * i + 1] = o2[i].y; }
    float ss = 0.f;
#pragma unroll
    for (int i = 0; i < 8; ++i) ss += o[i] * o[i];
    ss = reduce8(ss);
    const float rr = rsqrtf(ss * (1.f / 64.f) + 1e-6f);
    bf16_t* zp = ZY + (size_t)(row0 + t) * 1024 + 256 + h * 64 + e8; const u32x4 z = *(const u32x4*)zp; const float* ng = P.in[I_GNG] + l * 64 + e8;
    u32x4 w; w.x = pk2(o[0] * rr * ng[0] * silu(bflo(z.x)), o[1] * rr * ng[1] * silu(bfhi(z.x))); w.y = pk2(o[2] * rr * ng[2] * silu(bflo(z.y)), o[3] * rr * ng[3] * silu(bfhi(z.y)));
    w.z = pk2(o[4] * rr * ng[4] * silu(bflo(z.z)), o[5] * rr * ng[5] * silu(bfhi(z.z))); w.w = pk2(o[6] * rr * ng[6] * silu(bflo(z.w)), o[7] * rr * ng[7] * silu(bfhi(z.w)));
    if (dost) *(u32x4*)zp = w;
}


DEVI void grid_bar(unsigned* w, unsigned k) {
    asm volatile("s_waitcnt vmcnt(0)" ::: "memory");
    __syncthreads();
    if (tidx() == 0) {
        const unsigned G = gridDim.x;
        __builtin_amdgcn_fence(__ATOMIC_RELEASE, "agent");
        asm volatile("s_waitcnt vmcnt(0)" ::: "memory");
        const unsigned old = __hip_atomic_fetch_add(&w[0], 1u, __ATOMIC_RELAXED, __HIP_MEMORY_SCOPE_AGENT);
        if (old + 1u == k * G) __hip_atomic_store(&w[64], k, __ATOMIC_RELAXED, __HIP_MEMORY_SCOPE_AGENT);
        while (__hip_atomic_load(&w[64], __ATOMIC_RELAXED, __HIP_MEMORY_SCOPE_AGENT) < k) __builtin_amdgcn_s_sleep(1);
        __builtin_amdgcn_fence(__ATOMIC_ACQUIRE, "agent");
        asm volatile("s_waitcnt vmcnt(0)" ::: "memory");
    }
    __syncthreads();
}

template <int NT, class Epi>
DEVI void small_gemm(const bf16_t* A, int lda, const bf16_t* const (&bp)[NT], int ldb, int K, const Epi& E, float* sm) {
    const int tid = tidx(), wave = tid >> 6, lane = tid & 63, lr = lane & 15, lq = lane >> 4;
    const int kw = K >> 3, kbeg = wave * kw;
    const bf16_t* ap = A + (size_t)lr * lda + 8 * lq + kbeg;
    f32x4 acc[NT];
#pragma unroll
    for (int t = 0; t < NT; ++t) acc[t] = (f32x4){0.f, 0.f, 0.f, 0.f};
    if (kw == 128) {
        bf16x8 a[4], b[4][NT];
#pragma unroll
        for (int s2 = 0; s2 < 4; ++s2) { a[s2] = *(const bf16x8*)(ap + 32 * s2);
#pragma unroll
            for (int t = 0; t < NT; ++t) b[s2][t] = *(const bf16x8*)(bp[t] + (size_t)lr * ldb + 8 * lq + kbeg + 32 * s2); }
#pragma unroll
        for (int s2 = 0; s2 < 4; ++s2)
#pragma unroll
            for (int t = 0; t < NT; ++t) acc[t] = __builtin_amdgcn_mfma_f32_16x16x32_bf16(a[s2], b[s2][t], acc[t], 0, 0, 0);
    } else {
        const bf16x8 a = *(const bf16x8*)ap; bf16x8 b[NT];
#pragma unroll
        for (int t = 0; t < NT; ++t) b[t] = *(const bf16x8*)(bp[t] + (size_t)lr * ldb + 8 * lq + kbeg);
#pragma unroll
        for (int t = 0; t < NT; ++t) acc[t] = __builtin_amdgcn_mfma_f32_16x16x32_bf16(a, b[t], acc[t], 0, 0, 0);
    }
    __syncthreads();
    f32x4* red = (f32x4*)sm;
#pragma unroll
    for (int t = 0; t < NT; ++t) red[(wave * NT + t) * 64 + lane] = acc[t];
    __syncthreads();
    if (wave == 0) {
#pragma unroll
        for (int t = 0; t < NT; ++t) { f32x4 v = red[t * 64 + lane];
#pragma unroll
            for (int w = 1; w < 8; ++w) v += red[(w * NT + t) * 64 + lane];
            acc[t] = v; }
        E(acc, lane);
    }
}
DEVI void small_br(const Params& P, int l, int item, float* sm) {
    const int rg = item >> 6, it = item & 63, b = it >> 4, s4 = it & 15;
    const bf16_t* ZY = (const bf16_t*)(P.ws + OFF_ZY) + (size_t)(NTOK + 16 * rg) * 1024 + b * 256;
    const bf16_t* W = (const bf16_t*)(P.ws + OFF_WBR) + (size_t)(l * 4 + b) * 1024 * 256;
    const bf16_t* bp[4] = {W + (size_t)(64 * s4) * 256, W + (size_t)(64 * s4 + 16) * 256, W + (size_t)(64 * s4 + 32) * 256, W + (size_t)(64 * s4 + 48) * 256};
    bf16_t* BR = (bf16_t*)(P.ws + OFF_BR) + (size_t)(NTOK + 16 * rg) * 4096 + b * 1024;
    auto E = [&](const f32x4 (&acc)[4], int lane) {
#pragma unroll
        for (int t = 0; t < 4; ++t) { const int n = 64 * s4 + 16 * t + (lane & 15), col = (n & ~255) + natcol(n & 255);
#pragma unroll
            for (int g = 0; g < 4; ++g) BR[(size_t)((lane >> 4) * 4 + g) * 4096 + col] = f2bf(acc[t][g]); } };
    small_gemm<4>(ZY, 1024, bp, 256, 256, E, sm);
}
DEVI void small_gate(const Params& P, int l, int item, float* sm) {
    const int rg = item >> 6, it = item & 63, q = it >> 2, wc = it & 3;
    const bf16_t* XB = (const bf16_t*)(P.ws + OFF_XB) + (size_t)(NTOK + 16 * rg) * 1024;
    const bf16_t* W = (const bf16_t*)(P.ws + OFF_W1T) + (size_t)l * 7424 * 1024 + (size_t)(3328 + 256 * q + 32 * wc) * 1024;
    const bf16_t* bp[4] = {W, W + (size_t)16 * 1024, W + (size_t)128 * 1024, W + (size_t)144 * 1024};
    const bf16_t* BR = (const bf16_t*)(P.ws + OFF_BR) + (size_t)(NTOK + 16 * rg) * 4096;
    const float* ssq = (const float*)(P.ws + OFF_SSQ) + l * MPAD + NTOK + 16 * rg;
    bf16_t* ZY = (bf16_t*)(P.ws + OFF_ZY) + (size_t)(NTOK + 16 * rg) * 1024;
    auto E = [&](const f32x4 (&acc)[4], int lane) {
        const int col = 64 * q + 16 * wc + (lane & 15);
#pragma unroll
        for (int g = 0; g < 4; ++g) { const int rl = (lane >> 4) * 4 + g; const float rs = rsqrtf(ssq[rl] * (1.f / 1024.f) + 1e-6f); float o = 0.f;
#pragma unroll
            for (int b = 0; b < 4; ++b) o += sigm(acc[b][g] * rs) * bf2f(BR[(size_t)rl * 4096 + b * 1024 + col]);
            ZY[(size_t)rl * 1024 + col] = f2bf(o); } };
    small_gemm<4>(XB, 1024, bp, 1024, 1024, E, sm);
}
template <int LAYER> DEVI void small_out(const Params& P, int l, int item, float* sm) {
    const int rg = item >> 5, it = item & 31;
    const bf16_t* ZY = (const bf16_t*)(P.ws + OFF_ZY) + (size_t)(NTOK + 16 * rg) * 1024;
    const bf16_t* W = (const bf16_t*)(P.ws + OFF_WOUT) + (size_t)l * 1024 * 1024 + (size_t)(32 * it) * 1024;
    const bf16_t* bp[2] = {W, W + (size_t)16 * 1024};
    bf16_t* XB = (bf16_t*)(P.ws + OFF_XB) + (size_t)(NTOK + 16 * rg) * 1024; float* yout = P.out + (size_t)(NTOK + 16 * rg) * 1024; const float* xs = P.in[I_XS] + (size_t)(16 * rg) * 1024;
    float* ssq = (float*)(P.ws + OFF_SSQ) + (LAYER == 0 ? 1 : 2) * MPAD + NTOK + 16 * rg;
    auto E = [&](const f32x4 (&acc)[2], int lane) {
        const int i = lane & 15;
#pragma unroll
        for (int g = 0; g < 4; ++g) { const int rl = (lane >> 4) * 4 + g; float ps = 0.f;
#pragma unroll
            for (int t = 0; t < 2; ++t) { const int col = 32 * it + 8 * (i >> 2) + 4 * t + (i & 3); float v = acc[t][g];
                if (LAYER == 0) { v += xs[(size_t)rl * 1024 + col]; XB[(size_t)rl * 1024 + col] = f2bf(v); }
                else { v += bf2f(XB[(size_t)rl * 1024 + col]); yout[(size_t)rl * 1024 + col] = v; }
                ps += v * v; }
            ps = reduce16(ps);
            if (i == 0) atomicAdd(ssq + rl, ps); } };
    small_gemm<2>(ZY, 1024, bp, 1024, 1024, E, sm);
}

#ifndef PHMASK
#define PHMASK 0xFFFF
#endif
#define PHON(b) ((PHMASK >> (b)) & 1)
DEVI void run_phase(const Params& P, int ph, unsigned char* smem) {
    float* sm = (float*)smem;
    const int G = gridDim.x, c = blockIdx.x;
    if (ph == 0) { if (PHON(0)) phase_p0(P, smem); return; }
    if (ph == NPH - 1) { if (!PHON(8)) return;
        const int wave = tidx() >> 6, lane = tidx() & 63; const float* ssq = (const float*)(P.ws + OFF_SSQ) + 2 * MPAD;
        for (int row = c * 8 + wave; row < ROWS; row += G * 8) { const float rs = rsqrtf(ssq[row] * (1.f / 1024.f) + 1e-6f); f32x4* yp = (f32x4*)(P.out + (size_t)row * 1024) + lane; const f32x4* gp = (const f32x4*)P.in[I_FNG] + lane;
#pragma unroll
            for (int j = 0; j < 4; ++j) yp[64 * j] = yp[64 * j] * rs * gp[64 * j]; }
        return;
    }
    const int l = (ph - 1) / 7, sp = (ph - 1) % 7;
    const char* XB = (const char*)(P.ws + OFF_XB); const char* ZYc = (const char*)(P.ws + OFF_ZY);
    float* ssq = (float*)(P.ws + OFF_SSQ);
    if (sp == 0) { if (!PHON(1)) return; SchedG1 S{XB, (const char*)(P.ws + OFF_W1T) + (size_t)l * 7424 * 2048, G, c}; EpiG1 E{(bf16_t*)(P.ws + OFF_PA), (bf16_t*)(P.ws + OFF_ZY), ssq + l * MPAD};
        g8::gemm_phase((LAS unsigned char*)smem, 2048, 2048, 1024, S, E);
        if (l == 0) { const int nfull = 65 * 13 - 3 * G;
            if (false && c >= nfull) { __syncthreads(); weight_items(P, smem, WI_EARLY, WI_ALL, (c - nfull) * 8 + (tidx() >> 6), (G - nfull) * 8); } }
        return; }
    if (sp == 1) { if (!PHON(2)) return;
        constexpr int NA = 1024, NL = 512, NG = 1024, NAS = 32, NC = 8;
        for (int it = c; it < NA + NL + NG + NAS + NC; it += G) { int r = it;
            if (r < NA) { rwkv_prep(P, l, r); continue; } r -= NA;
            if (r < NL) { lru_prep(P, l, r, sm); continue; } r -= NL;
            if (r < NG) { gla_prep(P, l, r, sm); continue; } r -= NG;
            if (r < NAS) { rwkv_prep(P, l, 1024 + r); continue; } r -= NAS;
            cache_copy(P, l, r); }
        return; }
    if (sp == 2) { if (!PHON(3)) return;
        const int nR = G >= 256 ? 128 : (G > 1 ? G / 2 : 0);
        if (c < nR) { if (PROBE_SP != 13) for (int it = c; it < 128; it += nR) { const int slot = it >> 3; rwkv_scan_prompt(P, l, (((it & 7) * 4 + (slot >> 2)) * 4) + (slot & 3), sm); } return; }
        constexpr int NSW = 512, NGP = 32, NLC = 8, NRS = 64, NSS = 128, NGS = 128, NLS = 64;
        if (nR == 0) for (int it = 0; it < 128; ++it) rwkv_scan_prompt(P, l, it, sm);
        for (int it = c - nR; it < NSW + NGP + NLC + NRS + NSS + NGS + NLS; it += G - nR) { int r = it;
            if (r < NGP) { gla_prefix(P, l, r); continue; } r -= NGP;
            if (r < NLC) { lru_carry(P, l, r); continue; } r -= NLC;
            if (r < NSW) { swa_prompt(P, l, r, sm); continue; } r -= NSW;
            if (r < NRS) { rwkv_scan_sample(P, l, r); continue; } r -= NRS;
            if (r < NSS) { swa_sample(P, l, r, sm); continue; } r -= NSS;
            if (r < NGS) { gla_sample(P, l, r, sm); continue; } r -= NGS;
            lru_sample(P, l, r, sm); }
        return; }
    if (sp == 3) { if (!PHON(4)) return;
        constexpr int NG = 1024, NL = 512, NR = 1032;
        for (int it = c; it < NG + NL + NR; it += G) { int r = it;
            if (r < NG) { gla_out(P, l, r, sm); continue; } r -= NG;
            if (r < NL) { lru_final(P, l, r); continue; } r -= NL;
            rwkv_post(P, l, r); }
        return; }
    if (sp == 4) { if (!PHON(5)) return; SchedBr S{ZYc, (const char*)(P.ws + OFF_WBR) + (size_t)l * 4 * 1024 * 512, G, c}; EpiBr E{(bf16_t*)(P.ws + OFF_BR)};
        g8::gemm_phase((LAS unsigned char*)smem, 2048, 512, 256, S, E);
        for (int it = G - 1 - c; it < 512; it += G) small_br(P, l, it, sm);
        return; }
    if (sp == 5) { if (!PHON(6)) return; SchedGate S{XB, (const char*)(P.ws + OFF_W1T) + (size_t)l * 7424 * 2048, G, c}; EpiGate E{(const bf16_t*)(P.ws + OFF_BR), ssq + l * MPAD, (bf16_t*)(P.ws + OFF_ZY)};
        g8::gemm_phase((LAS unsigned char*)smem, 2048, 2048, 1024, S, E);
        for (int it = G - 1 - c; it < 512; it += G) small_gate(P, l, it, sm);
        return; }
    if (PHON(7)) { SchedOut S{ZYc, (const char*)(P.ws + OFF_WOUT) + (size_t)l * 1024 * 2048, G, c};
        if (l == 0) { EpiOut<0> E{P.in[I_XP], P.in[I_XS], (bf16_t*)(P.ws + OFF_XB), P.out, ssq + MPAD}; g8::gemm_phase((LAS unsigned char*)smem, 2048, 2048, 1024, S, E); for (int it = G - 1 - c; it < 256; it += G) small_out<0>(P, l, it, sm); }
        else { EpiOut<1> E{P.in[I_XP], P.in[I_XS], (bf16_t*)(P.ws + OFF_XB), P.out, ssq + 2 * MPAD}; g8::gemm_phase((LAS unsigned char*)smem, 2048, 2048, 1024, S, E); for (int it = G - 1 - c; it < 256; it += G) small_out<1>(P, l, it, sm); }
    }
}

__global__ void __launch_bounds__(512) mega_fwd(Params P, int ph_lo, int ph_hi, int cg_mode) {
    extern __shared__ __attribute__((aligned(16))) unsigned char smem[];
    cg::grid_group grid = cg::this_grid();
    unsigned nbar = 0;
    unsigned* barw = (unsigned*)(P.ws + OFF_BAR);
#define GSYNC() do { if (USE_CG_SYNC || cg_mode) grid.sync(); else grid_bar(barw, ++nbar); } while (0)
    for (int ph = ph_lo; ph < ph_hi; ++ph) {
        if (ph > ph_lo) GSYNC();
        __syncthreads();
        unsigned z; asm volatile("s_mov_b32 %0, 0" : "=s"(z));
        const Params* pp = (const Params*)((const char*)(const __attribute__((address_space(4))) char*)__builtin_amdgcn_kernarg_segment_ptr() + z);
        if (PROBE_SP == 13 && ph >= 1 && ph < NPH - 1 && (ph - 1) % 7 == 2) { if (blockIdx.x < 128) rwkv_scan_prompt(*pp, (ph - 1) / 7, blockIdx.x, (float*)smem); GSYNC(); __syncthreads(); }
        run_phase(*pp, ph, smem);
        if (PROBE_SP >= 0) {
            const int spx = (ph >= 1 && ph < NPH - 1) ? (ph - 1) % 7 : -1;
            if ((PROBE_SP < 7 && spx == PROBE_SP) || (PROBE_SP == 7 && ph == 0)) { GSYNC(); __syncthreads(); run_phase(*pp, ph, smem); }
            if (PROBE_SP == 8 && spx == 2) { GSYNC(); __syncthreads(); if (blockIdx.x < 128) rwkv_scan_prompt(*pp, (ph - 1) / 7, blockIdx.x, (float*)smem); }
            if (PROBE_SP == 9) GSYNC();
            if (PROBE_SP == 14 && spx == 2) { GSYNC(); __syncthreads(); if (blockIdx.x >= 128) for (int it = blockIdx.x - 128; it < 512; it += gridDim.x - 128) swa_prompt<true>(*pp, (ph - 1) / 7, it, (float*)smem); }
            if (PROBE_SP >= 15 && PROBE_SP <= 17 && spx == 2) { GSYNC(); __syncthreads(); const int l_ = (ph - 1) / 7;
                if (PROBE_SP == 15) for (int it = blockIdx.x; it < 1024; it += gridDim.x) gla_out<true>(*pp, l_, it, (float*)smem);
                if (PROBE_SP == 16) for (int it = blockIdx.x; it < 512; it += gridDim.x) lru_final<true>(*pp, l_, it);
                if (PROBE_SP == 17) for (int it = blockIdx.x; it < 1032; it += gridDim.x) rwkv_post<true>(*pp, l_, it); }
            if (PROBE_SP == 18 && spx == 5) { GSYNC(); __syncthreads(); const int l_ = (ph - 1) / 7; const int G = gridDim.x, c = blockIdx.x;
                SchedOut S{(const char*)(pp->ws + OFF_ZY), (const char*)(pp->ws + OFF_WOUT) + (size_t)l_ * 1024 * 2048, G, c}; float* ssq = (float*)(pp->ws + OFF_SSQ);
                if (l_ == 0) { EpiOut<0, false> E{pp->in[I_XP], pp->in[I_XS], (bf16_t*)(pp->ws + OFF_XB), pp->out, ssq + MPAD}; g8::gemm_phase((LAS unsigned char*)smem, 2048, 2048, 1024, S, E); }
                else { EpiOut<1, false> E{pp->in[I_XP], pp->in[I_XS], (bf16_t*)(pp->ws + OFF_XB), pp->out, ssq + 2 * MPAD}; g8::gemm_phase((LAS unsigned char*)smem, 2048, 2048, 1024, S, E); } }
            if (PROBE_SP >= 10 && PROBE_SP <= 12 && spx == 1) { GSYNC(); __syncthreads(); const int l_ = (ph - 1) / 7;
                if (PROBE_SP == 10) for (int it = blockIdx.x; it < 1024; it += gridDim.x) gla_prep(*pp, l_, it, (float*)smem);
                if (PROBE_SP == 11) for (int it = blockIdx.x; it < 512; it += gridDim.x) lru_prep(*pp, l_, it, (float*)smem);
                if (PROBE_SP == 12) for (int it = blockIdx.x; it < 1056; it += gridDim.x) rwkv_prep(*pp, l_, it); }
        }
    }
}

extern "C" void kernel_launch(void* const* d_in, const int* in_sizes, int n_in, void* d_out, int out_size, void* d_ws, size_t ws_size, hipStream_t stream) {
    static int grid = 0;
    if (grid == 0) {
        if (n_in != 35 || (size_t)out_size != O_END || ws_size < WS_END) { fprintf(stderr, "kernel_launch: unexpected shapes n_in %d out %d ws %zu (need %zu)\n", n_in, out_size, ws_size, (size_t)WS_END); grid = -1; return; }
        int dev = 0, cus = 0, per_cu = 0;
        hipGetDevice(&dev); hipDeviceGetAttribute(&cus, hipDeviceAttributeMultiprocessorCount, dev);
        if (hipFuncSetAttribute((const void*)mega_fwd, hipFuncAttributeMaxDynamicSharedMemorySize, LDS_BYTES) != hipSuccess) { fprintf(stderr, "kernel_launch: hipFuncSetAttribute failed\n"); grid = -1; return; }
        if (hipOccupancyMaxActiveBlocksPerMultiprocessor(&per_cu, (const void*)mega_fwd, 512, LDS_BYTES) != hipSuccess || per_cu < 1) { fprintf(stderr, "kernel_launch: occupancy query says %d\n", per_cu); per_cu = 1; }
        (void)hipGetLastError();
        grid = cus;
    }
    if (grid < 0) return;
    Params p{};
    for (int i = 0; i < 35; ++i) p.in[i] = (const float*)d_in[i];
    p.out = (float*)d_out; p.ws = (unsigned char*)d_ws;
#if ONE_LAUNCH
    (void)hipMemsetAsync((char*)d_ws + OFF_BAR, 0, 4096, stream);
    int lo = 0, hi = NPH, cgm = 0;
    void* args[] = {&p, &lo, &hi, &cgm};
    hipError_t e = hipLaunchCooperativeKernel((const void*)mega_fwd, dim3(grid), dim3(512), args, LDS_BYTES, stream);
    if (e != hipSuccess) fprintf(stderr, "cooperative launch failed: %s (grid %d)\n", hipGetErrorString(e), grid);
#else
    for (int ph = 0; ph < NPH; ++ph) hipLaunchKernelGGL(mega_fwd, dim3(grid), dim3(512), LDS_BYTES, stream, p, ph, ph + 1, 0);
#endif
}
```

```cpp
#include <hip/hip_runtime.h>
#include <hip/hip_cooperative_groups.h>
#include <cstdio>
#include <cstdint>
namespace cg = cooperative_groups;

typedef unsigned short bf16_t;
typedef short bf16x8 __attribute__((ext_vector_type(8)));
typedef float f32x4 __attribute__((ext_vector_type(4)));
typedef unsigned u32x4 __attribute__((ext_vector_type(4)));
typedef unsigned u32x2 __attribute__((ext_vector_type(2)));
typedef float f32x2 __attribute__((ext_vector_type(2)));
#define LAS __attribute__((address_space(3)))
#define DEVI __device__ __forceinline__

#ifndef PROBE_SP
#define PROBE_SP -1
#endif
#ifndef USE_CG_SYNC
#define USE_CG_SYNC 0
#endif
#ifndef ONE_LAUNCH
#define ONE_LAUNCH 1
#endif

constexpr int NTOK = 16384, NSAMP = 128, ROWS = 16512, MPAD = 16640, SEQ = 2048;
constexpr int INC = 7248;
constexpr int CA = 0, CB = 832, CC = 1360, CD = 1872, CZ = 2128, CG = 3152;
constexpr int PALD = 2304;
constexpr int NPH = 16;
constexpr int LDS_BYTES = 131072;

constexpr size_t OFF_W1T = 0, SZ_W1T = (size_t)2 * 7424 * 1024 * 2;
constexpr size_t OFF_WBR = OFF_W1T + SZ_W1T, SZ_WBR = (size_t)2 * 4 * 1024 * 256 * 2;
constexpr size_t OFF_WOUT = OFF_WBR + SZ_WBR, SZ_WOUT = (size_t)2 * 1024 * 1024 * 2;
constexpr size_t OFF_XB = OFF_WOUT + SZ_WOUT, SZ_XB = (size_t)MPAD * 1024 * 2;
constexpr size_t OFF_ZY = OFF_XB + SZ_XB;
constexpr size_t OFF_SSQ = OFF_ZY + SZ_XB, SZ_SSQ = (size_t)3 * MPAD * 4;
constexpr size_t OFF_BR = OFF_SSQ + SZ_SSQ, SZ_BR = (size_t)MPAD * 4096 * 2;
constexpr size_t OFF_PA = OFF_BR, SZ_PA = (size_t)MPAD * PALD * 2;
constexpr size_t OFF_RWP = OFF_BR + SZ_PA, SZ_RWP = (size_t)ROWS * 1536 * 2;
constexpr size_t OFF_RWC = OFF_RWP + SZ_RWP, SZ_RWC = (size_t)ROWS * 16 * 4;
constexpr size_t OFF_BAR = OFF_BR + SZ_BR;
constexpr size_t OFF_WLT = OFF_BAR + 4096, SZ_WLT = (size_t)2 * 2 * 4 * 4096 * 2;
constexpr size_t WS_END = OFF_WLT + SZ_WLT;
static_assert(OFF_RWC + SZ_RWC <= WS_END, "ws overlay");

constexpr size_t SO_RWO = 0;
constexpr size_t SO_LH = SO_RWO + (size_t)ROWS * 256;
constexpr size_t SO_LP = SO_LH + (size_t)NTOK * 256;
constexpr size_t SO_GU = SO_LP + (size_t)NTOK * 256;
constexpr size_t SO_GD = SO_GU + (size_t)1024 * 2048;
constexpr size_t SO_LA = SO_GD + (size_t)1024 * 32;
constexpr size_t SO_LB = SO_LA + (size_t)8 * 128 * 256;
static_assert(SO_LB + 8 * 128 * 256 <= (size_t)ROWS * 1024, "out scratch");

constexpr size_t O_Y = 0;
constexpr size_t O_WKVP = (size_t)ROWS * 1024;
constexpr size_t O_WKVS = O_WKVP + 2 * 8 * 4 * 64 * 64;
constexpr size_t O_SHP = O_WKVS + (size_t)2 * 128 * 4 * 64 * 64;
constexpr size_t O_SHS = O_SHP + 2 * 8 * 832;
constexpr size_t O_GLP = O_SHS + 2 * 128 * 832;
constexpr size_t O_GLS = O_GLP + 2 * 8 * 4 * 32 * 64;
constexpr size_t O_KP = O_GLS + 2 * 128 * 4 * 32 * 64;
constexpr size_t O_KS = O_KP + 2 * 8 * 128 * 128;
constexpr size_t O_VP = O_KS + (size_t)2 * 128 * 128 * 128;
constexpr size_t O_VS = O_VP + 2 * 8 * 128 * 128;
constexpr size_t O_CVP = O_VS + (size_t)2 * 128 * 128 * 128;
constexpr size_t O_CVS = O_CVP + 2 * 8 * 3 * 256;
constexpr size_t O_HP = O_CVS + 2 * 128 * 3 * 256;
constexpr size_t O_HS = O_HP + 2 * 8 * 256;
constexpr size_t O_END = O_HS + 2 * 128 * 256;

struct Params {
    const float* in[35];
    float* out;
    unsigned char* ws;
};
enum { I_XP = 0, I_XS, I_SWKV, I_SSHIFT, I_SGLA, I_CK, I_CV, I_SCONV, I_SH, I_NG, I_WIN, I_MU, I_W0, I_WUP, I_A0, I_AUP, I_KK, I_KA, I_RK, I_LNG, I_LNB,
       I_GUP, I_GB, I_GNG, I_SINK, I_CW, I_CBI, I_WA, I_BA, I_WX, I_BX, I_LAM, I_WBR, I_WOUT, I_FNG };

DEVI int tidx() { int t = (int)threadIdx.x; asm volatile("" : "+v"(t)); return t; }
DEVI float bf2f(bf16_t h) { return __uint_as_float(((unsigned)h) << 16); }
DEVI float bflo(unsigned w) { return __uint_as_float(w << 16); }
DEVI float bfhi(unsigned w) { return __uint_as_float(w & 0xffff0000u); }
DEVI unsigned f2bfu(float f) { unsigned u = __float_as_uint(f); return (u + 0x7fffu + ((u >> 16) & 1u)) >> 16; }
DEVI bf16_t f2bf(float f) { return (bf16_t)f2bfu(f); }
DEVI unsigned pk2(float lo, float hi) { return f2bfu(lo) | (f2bfu(hi) << 16); }
template <int CTRL> DEVI float dpp_mov(float v) { return __builtin_bit_cast(float, __builtin_amdgcn_update_dpp(0, __builtin_bit_cast(int, v), CTRL, 0xF, 0xF, true)); }
DEVI float rdlane(float v, int l) { return __builtin_bit_cast(float, __builtin_amdgcn_readlane(__builtin_bit_cast(int, v), l)); }
DEVI float reduce16(float v) { v += dpp_mov<0xB1>(v); v += dpp_mov<0x4E>(v); v += dpp_mov<0x141>(v); v += dpp_mov<0x140>(v); return v; }
DEVI float reduce8(float v) { v += dpp_mov<0xB1>(v); v += dpp_mov<0x4E>(v); v += dpp_mov<0x141>(v); return v; }
DEVI float wave_sum(float v) { v = reduce16(v); return (rdlane(v, 0) + rdlane(v, 16)) + (rdlane(v, 32) + rdlane(v, 48)); }
DEVI float wave_max(float v) { v = fmaxf(v, dpp_mov<0xB1>(v)); v = fmaxf(v, dpp_mov<0x4E>(v)); v = fmaxf(v, dpp_mov<0x141>(v)); v = fmaxf(v, dpp_mov<0x140>(v));
    return fmaxf(fmaxf(rdlane(v, 0), rdlane(v, 16)), fmaxf(rdlane(v, 32), rdlane(v, 48))); }
DEVI float quad_sum(float v) { v += dpp_mov<0xB1>(v); v += dpp_mov<0x4E>(v); return v; }
DEVI float quad_max(float v) { v = fmaxf(v, dpp_mov<0xB1>(v)); v = fmaxf(v, dpp_mov<0x4E>(v)); return v; }
DEVI float frcp(float x) { return __builtin_amdgcn_rcpf(x); }
DEVI float sigm(float x) { return frcp(1.f + __expf(-x)); }
DEVI float silu(float x) { return x * sigm(x); }
DEVI float flog(float x) { return __builtin_amdgcn_logf(x) * 0.6931471806f; }
DEVI float logsig(float x) { return fminf(x, 0.f) - flog(1.f + __expf(-fabsf(x))); }
DEVI float softplus(float x) { return fmaxf(x, 0.f) + flog(1.f + __expf(-fabsf(x))); }
DEVI float logsig_acc(float x) { return fminf(x, 0.f) - log1pf(expf(-fabsf(x))); }
DEVI float ftanh(float x) { const float e = __expf(-2.f * fabsf(x)); const float t = (1.f - e) * frcp(1.f + e); return x < 0.f ? -t : t; }
#define LDS_WAIT() asm volatile("s_waitcnt lgkmcnt(0)" ::: "memory")

DEVI int natcol(int p) { return (p & ~31) | (((p >> 2) & 3) << 3) | (((p >> 4) & 1) << 2) | (p & 3); }
DEVI int w1_src(int n) {
    const int pn = n >> 8, p = n & 255;
    if (pn < 9) { const int c = 256 * pn + natcol(p); return c < CZ ? c : -1; }
    if (pn < 13) return CZ + 256 * (pn - 9) + natcol(p);
    const int q = pn - 13, bj = p >> 7, wc = (p >> 5) & 3, n_ = (p >> 4) & 1, r16 = p & 15;
    return CG + (2 * bj + n_) * 1024 + 64 * q + 16 * wc + r16;
}

namespace g8 {
constexpr int BM = 256, BK = 64, HALF = 128, HTB = HALF * BK * 2;
DEVI int lds_byte(int r, int c) { const int st = (r >> 4) * 2 + (c >> 5), rr = r & 15, cc = c & 31, ob = rr * 64 + cc * 2; return st * 1024 + (ob ^ (((ob >> 9) & 1) << 5)); }
DEVI void stage_rc(int b, int& R, int& C) { const int st = b / 1024, sb = b % 1024, swz = sb ^ (((sb >> 9) & 1) << 5); R = (st >> 1) * 16 + swz / 64; C = (st & 1) * 32 + (swz % 64) / 2; }
struct Unit { const char* a; const char* b; int pm, pn; };
DEVI void tile_of(int L, int nM, int nN, int& pm, int& pn) {
    const int nwg = nM * nN; int wgid = L;
    { const int q = nwg / 8, r = nwg % 8, xcd = wgid % 8, off = wgid / 8; wgid = (xcd < r ? xcd * (q + 1) : r * (q + 1) + (xcd - r) * q) + off; }
    const int nig = 8 * nN, gid = wgid / nig, fm = gid * 8, gsz = (nM - fm) < 8 ? (nM - fm) : 8;
    pm = fm + ((wgid % nig) % gsz); pn = (wgid % nig) / gsz;
}

template <class Sched, class Epi>
DEVI void gemm_phase(LAS unsigned char* lds, const int lda, const int ldb, const int K, const Sched& S, const Epi& E) {
    const int tid = tidx(), wid = __builtin_amdgcn_readfirstlane(tid >> 6), lane = tid & 63, wr = wid >> 2, wc = wid & 3, fr = lane & 15, fq = lane >> 4;
    const int nt = K / BK;
    unsigned voffA[2], voffB[2];
#pragma unroll
    for (int i = 0; i < 2; ++i) { int R, C; stage_rc(tid * 16 + i * 8192, R, C); voffA[i] = (unsigned)(R * lda + C * 2); voffB[i] = (unsigned)(R * ldb + C * 2); }
    const size_t kstep = (size_t)(BK * 2);
    const size_t hstepA = (size_t)HALF * lda, hstepB = (size_t)HALF * ldb;
    const unsigned ldsw = (unsigned)wid * 1024u;
    const int aoff = lds_byte(wr * 64 + fr, fq * 8), boff = lds_byte(wc * 32 + fr, fq * 8);
#define G8_SA(b, h) (((b) * 2 + (h)) * HTB)
#define G8_SB(b, h) ((4 + (b) * 2 + (h)) * HTB)
#define G8_STAGE(bufoff, gbase, voff) do { _Pragma("unroll") for (int _i = 0; _i < 2; ++_i) \
        __builtin_amdgcn_global_load_lds((const unsigned*)((const char*)(gbase) + (voff)[_i]), (LAS unsigned*)(lds + (bufoff) + ldsw + _i * 8192), 16, 0, 0); } while (0)
#define G8_LDA(dst, b, h) do { _Pragma("unroll") for (int m = 0; m < 4; ++m) _Pragma("unroll") for (int k = 0; k < 2; ++k) dst[m][k] = *(const LAS bf16x8*)(lds + G8_SA(b, h) + aoff + m * 2048 + k * 1024); } while (0)
#define G8_LDB(dst, b, h) do { _Pragma("unroll") for (int n = 0; n < 2; ++n) _Pragma("unroll") for (int k = 0; k < 2; ++k) dst[n][k] = *(const LAS bf16x8*)(lds + G8_SB(b, h) + boff + n * 2048 + k * 1024); } while (0)
#define G8_MMA(ai, bj, At, Bt) do { __builtin_amdgcn_s_setprio(1); _Pragma("unroll") for (int m = 0; m < 4; ++m) _Pragma("unroll") for (int n = 0; n < 2; ++n) _Pragma("unroll") for (int k = 0; k < 2; ++k) \
        acc[ai][bj][m][n] = __builtin_amdgcn_mfma_f32_16x16x32_bf16(Bt[n][k], At[m][k], acc[ai][bj][m][n], 0, 0, 0); __builtin_amdgcn_s_setprio(0); } while (0)
#define G8_WAIT_V(n) asm volatile("s_waitcnt vmcnt(" #n ")" ::: "memory")
#define G8_WAIT_L(n) asm volatile("s_waitcnt lgkmcnt(" #n ")" ::: "memory")
#define G8_BAR __builtin_amdgcn_s_barrier()
#define G8_SCHED __builtin_amdgcn_sched_barrier(0)
    Unit cur, nxt; int ui = 0;
    if (!S.next(0, cur)) return;
    f32x4 acc[2][2][4][2];
#pragma unroll
    for (int a = 0; a < 2; ++a)
#pragma unroll
        for (int b = 0; b < 2; ++b)
#pragma unroll
            for (int m = 0; m < 4; ++m)
#pragma unroll
                for (int n = 0; n < 2; ++n) acc[a][b][m][n] = (f32x4){0.f, 0.f, 0.f, 0.f};
    bf16x8 At[4][2], B0[2][2], B1[2][2];
    const char* cA = cur.a; const char* cB = cur.b;
    G8_STAGE(G8_SB(0, 0), cB, voffB); G8_STAGE(G8_SA(0, 0), cA, voffA); G8_STAGE(G8_SB(0, 1), cB + hstepB, voffB); G8_STAGE(G8_SA(0, 1), cA + hstepA, voffA);
    if (wr == 1) G8_BAR;
    G8_WAIT_V(4); G8_BAR;
    G8_STAGE(G8_SB(1, 0), cB + kstep, voffB); G8_STAGE(G8_SA(1, 0), cA + kstep, voffA); G8_STAGE(G8_SB(1, 1), cB + hstepB + kstep, voffB);
    G8_WAIT_V(6); G8_BAR;
    for (;;) {
        const bool has_next = S.next(ui + 1, nxt);
        const char* nA = has_next ? nxt.a : cA; const char* nB = has_next ? nxt.b : cB;
        const bool full = cur.pm != 64;
#pragma nounroll
        for (int t = 0; t < nt; t += 2) {
            const bool last = (t == nt - 2);
            const char* a1 = cA + (size_t)(t + 1) * kstep;
            const char* a2 = last ? nA : cA + (size_t)(t + 2) * kstep; const char* b2 = last ? nB : cB + (size_t)(t + 2) * kstep;
            const char* a3 = a2 + kstep; const char* b3 = b2 + kstep;
            G8_LDB(B0, 0, 0); G8_SCHED; G8_LDA(At, 0, 0); G8_STAGE(G8_SA(1, 1), a1 + hstepA, voffA);
            G8_WAIT_L(8); G8_BAR; G8_WAIT_L(0); G8_MMA(0, 0, At, B0); G8_BAR; G8_SCHED;
            G8_LDB(B1, 0, 1); G8_STAGE(G8_SB(0, 0), b2, voffB);
            G8_BAR; G8_WAIT_L(0); G8_MMA(0, 1, At, B1); G8_BAR;
            G8_LDA(At, 0, 1); G8_STAGE(G8_SA(0, 0), a2, voffA);
            G8_BAR; G8_WAIT_L(0); G8_MMA(1, 0, At, B0); G8_BAR; G8_SCHED;
            G8_STAGE(G8_SB(0, 1), b2 + hstepB, voffB);
            G8_WAIT_V(6); G8_BAR; G8_MMA(1, 1, At, B1); G8_BAR;
            G8_LDB(B0, 1, 0); G8_SCHED; G8_LDA(At, 1, 0); G8_STAGE(G8_SA(0, 1), a2 + hstepA, voffA);
            G8_WAIT_L(8); G8_BAR; G8_WAIT_L(0); G8_MMA(0, 0, At, B0); G8_BAR; G8_SCHED;
            G8_LDB(B1, 1, 1); G8_STAGE(G8_SB(1, 0), b3, voffB);
            G8_BAR; G8_WAIT_L(0); G8_MMA(0, 1, At, B1); G8_BAR;
            G8_LDA(At, 1, 1); G8_STAGE(G8_SA(1, 0), a3, voffA);
            G8_BAR; G8_WAIT_L(0); G8_MMA(1, 0, At, B0); G8_BAR; G8_SCHED;
            G8_STAGE(G8_SB(1, 1), b3 + hstepB, voffB);
            G8_WAIT_V(6); G8_BAR; G8_MMA(1, 1, At, B1); G8_BAR;
        }
        E(acc, cur, wr, wc, fr, fq);
        if (!has_next) break;
#pragma unroll
        for (int a = 0; a < 2; ++a)
#pragma unroll
            for (int b = 0; b < 2; ++b)
#pragma unroll
                for (int m = 0; m < 4; ++m)
#pragma unroll
                    for (int n = 0; n < 2; ++n) acc[a][b][m][n] = (f32x4){0.f, 0.f, 0.f, 0.f};
        cur = nxt; cA = nA; cB = nB; ++ui;
    }
    G8_WAIT_V(0);
    if (wr == 0) G8_BAR;
    G8_BAR;
}
}
using g8::Unit;
typedef f32x4 AccT[2][2][4][2];

struct SchedG1 { const char* A; const char* B; int G, c;
    DEVI bool next(int i, Unit& u) const { const int L = i * G + c; if (L >= 65 * 13) return false; g8::tile_of(L, 65, 13, u.pm, u.pn);
        u.a = A + (size_t)u.pm * 256 * 2048; u.b = B + (size_t)u.pn * 256 * 2048; return true; } };
struct SchedBr { const char* A; const char* B; int G, c;
    DEVI bool next(int i, Unit& u) const { const int L = i * G + c; if (L >= 64 * 16) return false; g8::tile_of(L, 64, 16, u.pm, u.pn);
        const int b = u.pn >> 2, p4 = u.pn & 3; u.a = A + (size_t)u.pm * 256 * 2048 + b * 512; u.b = B + (size_t)b * (1024 * 512) + (size_t)p4 * 256 * 512; return true; } };
struct SchedGate { const char* A; const char* B; int G, c;
    DEVI bool next(int i, Unit& u) const { const int L = i * G + c; if (L >= 64 * 16) return false; g8::tile_of(L, 64, 16, u.pm, u.pn);
        u.a = A + (size_t)u.pm * 256 * 2048; u.b = B + (size_t)(3328 + 256 * u.pn) * 2048; return true; } };
struct SchedOut { const char* A; const char* B; int G, c;
    DEVI bool next(int i, Unit& u) const { const int L = i * G + c; if (L >= 64 * 4) return false; g8::tile_of(L, 64, 4, u.pm, u.pn);
        u.a = A + (size_t)u.pm * 256 * 2048; u.b = B + (size_t)u.pn * 256 * 2048; return true; } };

struct EpiG1 { bf16_t* PA; bf16_t* ZY; const float* ssq;
    DEVI void operator()(const AccT& acc, const Unit& u, int wr, int wc, int fr, int fq) const {
        bf16_t* base; int ld, pnl; if (u.pn < 9) { base = PA; ld = PALD; pnl = u.pn; } else { base = ZY; ld = 1024; pnl = u.pn - 9; }
        float sq[2][4];
#pragma unroll
        for (int ai = 0; ai < 2; ++ai)
#pragma unroll
            for (int m = 0; m < 4; ++m) sq[ai][m] = ssq[256 * u.pm + 128 * ai + 64 * wr + 16 * m + fr];
#pragma unroll
        for (int ai = 0; ai < 2; ++ai)
#pragma unroll
            for (int m = 0; m < 4; ++m) {
                const int r = 256 * u.pm + 128 * ai + 64 * wr + 16 * m + fr;
                const float rs = rsqrtf(sq[ai][m] * (1.f / 1024.f) + 1e-6f);
                bf16_t* rowp = base + (size_t)r * ld + 256 * pnl + 32 * wc + 8 * fq;
#pragma unroll
                for (int bj = 0; bj < 2; ++bj) { const f32x4 v0 = acc[ai][bj][m][0] * rs, v1 = acc[ai][bj][m][1] * rs;
                    u32x4 w; w.x = pk2(v0[0], v0[1]); w.y = pk2(v0[2], v0[3]); w.z = pk2(v1[0], v1[1]); w.w = pk2(v1[2], v1[3]);
                    *(u32x4*)(rowp + 128 * bj) = w; }
            }
    } };
struct EpiBr { bf16_t* BR;
    DEVI void operator()(const AccT& acc, const Unit& u, int wr, int wc, int fr, int fq) const {
        const int b = u.pn >> 2, p4 = u.pn & 3;
#pragma unroll
        for (int ai = 0; ai < 2; ++ai)
#pragma unroll
            for (int m = 0; m < 4; ++m) {
                const int r = 256 * u.pm + 128 * ai + 64 * wr + 16 * m + fr;
                bf16_t* rowp = BR + (size_t)r * 4096 + b * 1024 + 256 * p4 + 32 * wc + 8 * fq;
#pragma unroll
                for (int bj = 0; bj < 2; ++bj) { const f32x4 v0 = acc[ai][bj][m][0], v1 = acc[ai][bj][m][1];
                    u32x4 w; w.x = pk2(v0[0], v0[1]); w.y = pk2(v0[2], v0[3]); w.z = pk2(v1[0], v1[1]); w.w = pk2(v1[2], v1[3]);
                    *(u32x4*)(rowp + 128 * bj) = w; }
            }
    } };
struct EpiGate { const bf16_t* BR; const float* ssq; bf16_t* ZY;
    DEVI void operator()(const AccT& acc, const Unit& u, int wr, int wc, int fr, int fq) const {
        const int c = 64 * u.pn + 16 * wc + 4 * fq;
#pragma unroll
        for (int ai = 0; ai < 2; ++ai) {
            float sq[4]; u32x2 w[4][4];
#pragma unroll
            for (int m = 0; m < 4; ++m) { const int r = 256 * u.pm + 128 * ai + 64 * wr + 16 * m + fr; sq[m] = ssq[r]; const bf16_t* brr = BR + (size_t)r * 4096 + c;
#pragma unroll
                for (int b = 0; b < 4; ++b) w[m][b] = *(const u32x2*)(brr + b * 1024); }
#pragma unroll
            for (int m = 0; m < 4; ++m) {
                const int r = 256 * u.pm + 128 * ai + 64 * wr + 16 * m + fr;
                const float rs = rsqrtf(sq[m] * (1.f / 1024.f) + 1e-6f);
                float o0 = 0.f, o1 = 0.f, o2 = 0.f, o3 = 0.f;
#pragma unroll
                for (int bj = 0; bj < 2; ++bj)
#pragma unroll
                    for (int n = 0; n < 2; ++n) { const u32x2 ww = w[m][2 * bj + n]; const f32x4 g = acc[ai][bj][m][n];
                        o0 += sigm(g[0] * rs) * bflo(ww.x); o1 += sigm(g[1] * rs) * bfhi(ww.x); o2 += sigm(g[2] * rs) * bflo(ww.y); o3 += sigm(g[3] * rs) * bfhi(ww.y); }
                u32x2 o; o.x = pk2(o0, o1); o.y = pk2(o2, o3);
                *(u32x2*)(ZY + (size_t)r * 1024 + c) = o;
            }
        }
    } };
template <int LAYER, bool ATOM = true> struct EpiOut { const float* xp; const float* xs; bf16_t* XB; float* yout; float* ssq;
    DEVI void operator()(const AccT& acc, const Unit& u, int wr, int wc, int fr, int fq) const {
        const int col0 = 256 * u.pn + 32 * wc + 8 * fq;
#pragma unroll
        for (int ai = 0; ai < 2; ++ai) {
            if (256 * u.pm + 128 * ai >= ROWS) continue;
            f32x4 rf[4][2][2]; u32x4 rb[4][2];
#pragma unroll
            for (int m = 0; m < 4; ++m) { const int r = 256 * u.pm + 128 * ai + 64 * wr + 16 * m + fr;
#pragma unroll
                for (int bj = 0; bj < 2; ++bj) { const int col = col0 + 128 * bj;
                    if (LAYER == 0) { const float* xr = (r < NTOK ? xp + (size_t)r * 1024 : xs + (size_t)(r - NTOK) * 1024) + col; rf[m][bj][0] = *(const f32x4*)xr; rf[m][bj][1] = *(const f32x4*)(xr + 4); }
                    else rb[m][bj] = *(const u32x4*)(XB + (size_t)r * 1024 + col); } }
            float part[4];
#pragma unroll
            for (int m = 0; m < 4; ++m) {
                const int r = 256 * u.pm + 128 * ai + 64 * wr + 16 * m + fr;
                float ps = 0.f;
#pragma unroll
                for (int bj = 0; bj < 2; ++bj) { const int col = col0 + 128 * bj; f32x4 v0 = acc[ai][bj][m][0], v1 = acc[ai][bj][m][1];
                    if (LAYER == 0) { v0 += rf[m][bj][0]; v1 += rf[m][bj][1];
                        u32x4 w; w.x = pk2(v0[0], v0[1]); w.y = pk2(v0[2], v0[3]); w.z = pk2(v1[0], v1[1]); w.w = pk2(v1[2], v1[3]);
                        *(u32x4*)(XB + (size_t)r * 1024 + col) = w;
                    } else { const u32x4 w = rb[m][bj];
                        v0[0] += bflo(w.x); v0[1] += bfhi(w.x); v0[2] += bflo(w.y); v0[3] += bfhi(w.y); v1[0] += bflo(w.z); v1[1] += bfhi(w.z); v1[2] += bflo(w.w); v1[3] += bfhi(w.w);
                        *(f32x4*)(yout + (size_t)r * 1024 + col) = v0; *(f32x4*)(yout + (size_t)r * 1024 + col + 4) = v1; }
                    ps += v0[0] * v0[0] + v0[1] * v0[1] + v0[2] * v0[2] + v0[3] * v0[3] + v1[0] * v1[0] + v1[1] * v1[1] + v1[2] * v1[2] + v1[3] * v1[3]; }
                part[m] = ps;
            }
#pragma unroll
            for (int m = 0; m < 4; ++m) { const int r = 256 * u.pm + 128 * ai + 64 * wr + 16 * m + fr; float p = part[m]; p += __shfl_xor(p, 16); p += __shfl_xor(p, 32); if (ATOM && fq == 0) atomicAdd(ssq + r, p); }
        }
    } };

DEVI void transpose_item(const float* W, int ldw, const float* gain, int kind, bf16_t* WT, int K, int n0, int k0, float* scr, int lane) {
    const int nl = lane & 31, n = n0 + nl;
    const int sc = (kind == 0) ? w1_src(n) : ((n & ~255) + natcol(n & 255));
    float tw[32], tg[32];
#pragma unroll
    for (int i = 0; i < 32; ++i) { const int kk = 2 * i + (lane >> 5); tw[i] = (sc >= 0) ? W[(size_t)(k0 + kk) * ldw + sc] : 0.f; tg[i] = gain ? gain[k0 + kk] : 1.f; }
#pragma unroll
    for (int i = 0; i < 32; ++i) { const int kk = 2 * i + (lane >> 5); scr[kk * 33 + nl] = tw[i] * tg[i]; }
    LDS_WAIT();
    const int c = lane & 7;
#pragma unroll
    for (int j = 0; j < 4; ++j) { const int nn = (lane >> 3) + 8 * j; const float* s = scr + (8 * c) * 33 + nn;
        u32x4 o; o.x = pk2(s[0], s[33]); o.y = pk2(s[66], s[99]); o.z = pk2(s[132], s[165]); o.w = pk2(s[198], s[231]);
        *(u32x4*)(WT + (size_t)(n0 + nn) * K + k0 + 8 * c) = o; }
    LDS_WAIT();
}
DEVI void weight_items(const Params& P, unsigned char* smem, int it0, int it1, int gw, int NGW) {
    const int tid = tidx(), wave = tid >> 6, lane = tid & 63;
    float* scr = (float*)(smem + wave * 16384);
    bf16_t* W1T = (bf16_t*)(P.ws + OFF_W1T); bf16_t* WBR = (bf16_t*)(P.ws + OFF_WBR); bf16_t* WOUT = (bf16_t*)(P.ws + OFF_WOUT);
    constexpr int I1 = 2 * 232 * 16, I2 = 8 * 32 * 4;
    for (int it = it0 + gw; it < it1; it += NGW) {
        int r = it;
        if (r < I1) { const int l = r / 3712, q = r % 3712, nb = q >> 4, kb = q & 15;
            transpose_item(P.in[I_WIN] + (size_t)l * 1024 * INC, INC, P.in[I_NG] + l * 1024, 0, W1T + (size_t)l * 7424 * 1024, 1024, nb * 32, kb * 64, scr, lane); continue; }
        r -= I1;
        if (r < I2) { const int lb = r >> 7, q = r & 127, nb = q >> 2, kb = q & 3;
            transpose_item(P.in[I_WBR] + (size_t)lb * 256 * 1024, 1024, nullptr, 1, WBR + (size_t)lb * 1024 * 256, 256, nb * 32, kb * 64, scr, lane); continue; }
        r -= I2;
        { const int l = r >> 9, q = r & 511, nb = q >> 4, kb = q & 15;
            transpose_item(P.in[I_WOUT] + (size_t)l * 1024 * 1024, 1024, nullptr, 2, WOUT + (size_t)l * 1024 * 1024, 1024, nb * 32, kb * 64, scr, lane); }
    }
}
constexpr int WI_EARLY = 104 * 16, WI_ALL = 2 * 232 * 16 + 8 * 32 * 4 + 2 * 32 * 16;
DEVI void phase_p0(const Params& P, unsigned char* smem) {
    const int tid = tidx(), wave = tid >> 6, lane = tid & 63;
    const int gw = blockIdx.x * 8 + wave, NGW = gridDim.x * 8;
    weight_items(P, smem, 0, WI_ALL, gw, NGW);
    { bf16_t* WLT = (bf16_t*)(P.ws + OFF_WLT);
      for (int i = blockIdx.x * 512 + tid; i < 65536; i += gridDim.x * 512) { const int l = i >> 15, g = (i >> 14) & 1, n = (i >> 12) & 3, dd = (i >> 6) & 63, cc = i & 63;
          WLT[i] = f2bf(P.in[g ? I_WX : I_WA][((l * 4 + n) * 64 + cc) * 64 + dd]); } }
    bf16_t* XB = (bf16_t*)(P.ws + OFF_XB); float* ssq = (float*)(P.ws + OFF_SSQ);
    for (int row = gw; row < MPAD; row += NGW) {
        f32x4 v[4]; float s = 0.f;
        if (row < ROWS) { const f32x4* xr = (const f32x4*)(row < NTOK ? P.in[I_XP] + (size_t)row * 1024 : P.in[I_XS] + (size_t)(row - NTOK) * 1024) + lane;
#pragma unroll
            for (int j = 0; j < 4; ++j) { v[j] = xr[64 * j]; s += v[j][0] * v[j][0] + v[j][1] * v[j][1] + v[j][2] * v[j][2] + v[j][3] * v[j][3]; }
        } else {
#pragma unroll
            for (int j = 0; j < 4; ++j) v[j] = (f32x4){0.f, 0.f, 0.f, 0.f};
        }
        s = wave_sum(s);
        u32x2* o = (u32x2*)(XB + (size_t)row * 1024) + lane;
#pragma unroll
        for (int j = 0; j < 4; ++j) { u32x2 w; w.x = pk2(v[j][0], v[j][1]); w.y = pk2(v[j][2], v[j][3]); o[64 * j] = w; }
        if (lane == 0) { ssq[row] = s; ssq[MPAD + row] = 0.f; ssq[2 * MPAD + row] = 0.f; }
    }
}

DEVI void rwkv_prep(const Params& P, int l, int item) {
    const int tid = tidx(), wave = tid >> 6, lane = tid & 63, slot = wave >> 2, h = wave & 3, c = h * 64 + lane;
    const bf16_t* PA = (const bf16_t*)(P.ws + OFF_PA); bf16_t* RWP = (bf16_t*)(P.ws + OFF_RWP); float* RWC = (float*)(P.ws + OFF_RWC);
    const bool samp = item >= 1024; const int row0 = samp ? NTOK + (item - 1024) * 4 : item * 16, nit = samp ? 2 : 8;
    const float* mu = P.in[I_MU] + l * 832;
    float wup[32], aup[32];
#pragma unroll
    for (int j = 0; j < 32; ++j) { wup[j] = P.in[I_WUP][(l * 32 + j) * 256 + c]; aup[j] = P.in[I_AUP][(l * 32 + j) * 256 + c]; }
    const float w0 = P.in[I_W0][l * 256 + c], a0 = P.in[I_A0][l * 256 + c], kkw = P.in[I_KK][l * 256 + c], kaw = P.in[I_KA][l * 256 + c], rkw = P.in[I_RK][l * 256 + c];
    const float mur = mu[c], muk = mu[256 + c], muv = mu[512 + c], mul = mu[768 + lane];
    float aur[8], auk[8], auv[8], aul[8], apr[8], apk[8], apv[8], apl[8];
#pragma unroll
    for (int it = 0; it < 8; ++it) { const int row = row0 + 2 * (it < nit ? it : 0) + slot; const bf16_t* up = PA + (size_t)row * PALD;
        if (samp) { const float* sp = P.in[I_SSHIFT] + (size_t)(l * 128 + (row - NTOK)) * 832; apr[it] = sp[c]; apk[it] = sp[256 + c]; apv[it] = sp[512 + c]; apl[it] = sp[768 + lane]; }
        else if ((row & 2047) == 0) { apr[it] = apk[it] = apv[it] = apl[it] = 0.f; }
        else { const bf16_t* pp = up - PALD; apr[it] = bf2f(pp[c]); apk[it] = bf2f(pp[256 + c]); apv[it] = bf2f(pp[512 + c]); apl[it] = bf2f(pp[768 + lane]); }
        aur[it] = bf2f(up[c]); auk[it] = bf2f(up[256 + c]); auv[it] = bf2f(up[512 + c]); aul[it] = bf2f(up[768 + lane]); }
#pragma unroll
    for (int it = 0; it < 8; ++it) {
        if (it >= nit) break;
        const int row = row0 + 2 * it + slot;
        const float ur = aur[it], uk = auk[it], uv = auv[it], ul = aul[it], pr = apr[it], pk = apk[it], pv = apv[it], pl = apl[it];
        const float r = ur + (pr - ur) * mur, k = uk + (pk - uk) * muk, v = uv + (pv - uv) * muv;
        float lo = ul + (pl - ul) * mul;
        const float lt = lane < 32 ? ftanh(lo) : lo;
        float wpre = w0, apre = a0;
#pragma unroll
        for (int j = 0; j < 32; ++j) { wpre += rdlane(lt, j) * wup[j]; apre += rdlane(lt, 32 + j) * aup[j]; }
        const float w = -softplus(-wpre) - 0.5f, lw = __expf(w);
        const float a = sigm(apre);
        const float kkr = k * kkw; const float kk = kkr * __builtin_amdgcn_rsqf(fmaxf(wave_sum(kkr * kkr), 1e-24f));
        const float kp = k * (1.f + (a - 1.f) * kaw), ka = kk * a;
        const float kaq = bf2f(f2bf(ka)), kpq = bf2f(f2bf(kp)), rq = bf2f(f2bf(r));
        const float c1 = wave_sum(kaq * rq), c2 = wave_sum(kpq * rq), c3 = wave_sum(r * kp * rkw);
        bf16_t* o = RWP + (size_t)row * 1536 + c;
        o[0] = f2bf(lw); o[256] = f2bf(kk); o[512] = f2bf(ka); o[768] = f2bf(kp); o[1024] = f2bf(r); o[1280] = f2bf(v);
        if (lane == 0) { float* cc = RWC + (size_t)row * 16 + h * 4; cc[0] = c1; cc[1] = c2; cc[2] = c3; }
    }
    if (samp) { for (int i = tid; i < 4 * 832; i += 512) { const int rr = i / 832, cc = i % 832; const int b = row0 - NTOK + rr; P.out[O_SHS + (size_t)(l * 128 + b) * 832 + cc] = bf2f(PA[(size_t)(row0 + rr) * PALD + cc]); } }
    else if (((row0 + 16) & 2047) == 0) { const int b = row0 >> 11; for (int i = tid; i < 832; i += 512) P.out[O_SHP + (size_t)(l * 8 + b) * 832 + i] = bf2f(PA[(size_t)(row0 + 15) * PALD + i]); }
}
DEVI void cache_copy(const Params& P, int l, int b) {
    const bf16_t* PA = (const bf16_t*)(P.ws + OFF_PA);
    for (int i = tidx(); i < 128 * 128; i += 512) { const int j = i >> 7, c = i & 127; const bf16_t* rp = PA + (size_t)(b * 2048 + 1920 + j) * PALD + CC + 256 + c;
        P.out[O_KP + (size_t)((l * 8 + b) * 128 + j) * 128 + c] = bf2f(rp[0]); P.out[O_VP + (size_t)((l * 8 + b) * 128 + j) * 128 + c] = bf2f(rp[128]); }
}
DEVI void lru_prep(const Params& P, int l, int item, float* sm) {
    const int tid = tidx(), b = item >> 6, ck = item & 63, t0 = ck * 32;
    const bf16_t* PA = (const bf16_t*)(P.ws + OFF_PA);
    float* xs = sm; float* xc = sm + 35 * 256;
    __syncthreads();
    { bf16_t tx[18];
#pragma unroll
      for (int k = 0; k < 18; ++k) { const int i = tid + 512 * k, tt = i >> 8, ch = i & 255, tk = t0 - 3 + tt; tx[k] = (i < 35 * 256 && tk >= 0) ? PA[(size_t)(b * 2048 + tk) * PALD + CD + ch] : (bf16_t)0; }
#pragma unroll
      for (int k = 0; k < 18; ++k) { const int i = tid + 512 * k; if (i < 35 * 256) xs[i] = bf2f(tx[k]); } }
    __syncthreads();
    const int d = tid & 255, half = tid >> 8;
    { const float cb = P.in[I_CBI][l * 256 + d], c0 = P.in[I_CW][(l * 4 + 0) * 256 + d], c1 = P.in[I_CW][(l * 4 + 1) * 256 + d], c2 = P.in[I_CW][(l * 4 + 2) * 256 + d], c3 = P.in[I_CW][(l * 4 + 3) * 256 + d];
        for (int t = half; t < 32; t += 2) xc[t * 256 + d] = cb + c0 * xs[t * 256 + d] + c1 * xs[(t + 1) * 256 + d] + c2 * xs[(t + 2) * 256 + d] + c3 * xs[(t + 3) * 256 + d]; }
    __syncthreads();
    const int n = d >> 6, dl = d & 63;
    if (ck == 63) for (int i = tid; i < 768; i += 512) P.out[O_CVP + (size_t)(l * 8 + b) * 768 + i] = xs[32 * 256 + i];
    __syncthreads();
    {
        const int wave = tid >> 6, lane = tid & 63, wn = wave & 3, gate = wave >> 2, lr = lane & 15, lq = lane >> 4;
        float* gp = gate ? (sm + 67 * 256) : xs;
        const bf16_t* WL = (const bf16_t*)(P.ws + OFF_WLT) + (size_t)((l * 2 + gate) * 4 + wn) * 4096;
        bf16x8 bfr[4][2]; float bsv[4];
#pragma unroll
        for (int dt = 0; dt < 4; ++dt) { bsv[dt] = P.in[gate ? I_BX : I_BA][l * 256 + 64 * wn + 16 * dt + lr];
#pragma unroll
            for (int ks2 = 0; ks2 < 2; ++ks2) bfr[dt][ks2] = *(const bf16x8*)(WL + (16 * dt + lr) * 64 + 32 * ks2 + 8 * lq); }
#pragma unroll
        for (int tt = 0; tt < 2; ++tt) {
            bf16x8 afr[2];
#pragma unroll
            for (int ks2 = 0; ks2 < 2; ++ks2) { const float* xr = xc + (16 * tt + lr) * 256 + 64 * wn + 32 * ks2 + 8 * lq; const f32x4 x0 = *(const f32x4*)xr, x1 = *(const f32x4*)(xr + 4);
                u32x4 pk; pk.x = pk2(x0[0], x0[1]); pk.y = pk2(x0[2], x0[3]); pk.z = pk2(x1[0], x1[1]); pk.w = pk2(x1[2], x1[3]); afr[ks2] = __builtin_bit_cast(bf16x8, pk); }
#pragma unroll
            for (int dt = 0; dt < 4; ++dt) { f32x4 acc = {0.f, 0.f, 0.f, 0.f};
                acc = __builtin_amdgcn_mfma_f32_16x16x32_bf16(afr[0], bfr[dt][0], acc, 0, 0, 0); acc = __builtin_amdgcn_mfma_f32_16x16x32_bf16(afr[1], bfr[dt][1], acc, 0, 0, 0);
#pragma unroll
                for (int g = 0; g < 4; ++g) gp[(16 * tt + 4 * lq + g) * 256 + 64 * wn + 16 * dt + lr] = acc[g] + bsv[dt]; }
        }
    }
    __syncthreads();
    const float lsl = 8.f * logsig_acc(P.in[I_LAM][l * 256 + d]);
    float* LH = P.out + SO_LH; float* LP = P.out + SO_LP; float* LA = P.out + SO_LA; float* LB = P.out + SO_LB;
    const float* gr = xs; const float* gi = sm + 67 * 256;
    float hh = 0.f, pp = 1.f;
#pragma nounroll
    for (int tt = 0; tt < 16; ++tt) {
        const int t = half * 16 + tt;
        const float la = lsl * sigm(gr[t * 256 + d]), a = __expf(la), bt = __builtin_amdgcn_sqrtf(fmaxf(1.f - a * a, 0.f)) * sigm(gi[t * 256 + d]) * xc[t * 256 + d];
        hh = a * hh + bt; pp *= a;
        const size_t row = (size_t)b * 2048 + t0 + t; LH[row * 256 + d] = hh; LP[row * 256 + d] = pp;
    }
    const int sub = ck * 2 + half; LA[(size_t)(b * 128 + sub) * 256 + d] = pp; LB[(size_t)(b * 128 + sub) * 256 + d] = hh;
}
DEVI void gla_load_cum(const Params& P, int l, int h, int row0, float* gs, float* gl, float* seg) {
    const int tid = tidx(); const bf16_t* PA = (const bf16_t*)(P.ws + OFF_PA);
    { bf16_t t0 = PA[(size_t)(row0 + (tid >> 4)) * PALD + CB + 512 + (tid & 15)], t1 = PA[(size_t)(row0 + 32 + (tid >> 4)) * PALD + CB + 512 + (tid & 15)]; gl[tid] = bf2f(t0); gl[tid + 512] = bf2f(t1); }
    __syncthreads();
    const int d = tid & 31, sg = tid >> 5;
    float upc[16];
#pragma unroll
    for (int j = 0; j < 16; ++j) upc[j] = P.in[I_GUP][(l * 16 + j) * 128 + h * 32 + d];
    const float bias = P.in[I_GB][l * 128 + h * 32 + d];
    float run = 0.f, gv[4];
#pragma unroll
    for (int tt = 0; tt < 4; ++tt) { const int t = sg * 4 + tt; float x = bias;
#pragma unroll
        for (int j = 0; j < 16; ++j) x += gl[t * 16 + j] * upc[j];
        run += logsig(x) * (1.f / 16.f); gv[tt] = run; }
    seg[sg * 32 + d] = run;
    __syncthreads();
    float pre = 0.f; for (int s2 = 0; s2 < sg; ++s2) pre += seg[s2 * 32 + d];
#pragma unroll
    for (int tt = 0; tt < 4; ++tt) gs[(sg * 4 + tt) * 32 + d] = gv[tt] + pre;
    __syncthreads();
}
DEVI void gla_prep(const Params& P, int l, int item, float* sm) {
    const int tid = tidx(), c = item & 31, h = (item >> 5) & 3, b = item >> 7, row0 = b * 2048 + c * 64;
    const bf16_t* PA = (const bf16_t*)(P.ws + OFF_PA);
    float* gs = sm; float* ks = sm + 2048; float* vs = sm + 4096; float* gl = sm + 8192; float* seg = sm + 9216;
    __syncthreads();
    { bf16_t tk[4], tv[8];
#pragma unroll
      for (int k = 0; k < 4; ++k) { const int i = tid + 512 * k, t = i >> 5, d = i & 31; tk[k] = PA[(size_t)(row0 + t) * PALD + CB + 128 + h * 32 + d]; }
#pragma unroll
      for (int k = 0; k < 8; ++k) { const int i = tid + 512 * k, t = i >> 6, e = i & 63; tv[k] = PA[(size_t)(row0 + t) * PALD + CB + 256 + h * 64 + e]; }
#pragma unroll
      for (int k = 0; k < 4; ++k) ks[tid + 512 * k] = bf2f(tk[k]);
#pragma unroll
      for (int k = 0; k < 8; ++k) vs[tid + 512 * k] = bf2f(tv[k]); }
    gla_load_cum(P, l, h, row0, gs, gl, seg);
    for (int i = tid; i < 2048; i += 512) { const int d = i & 31; ks[i] *= __expf(gs[63 * 32 + d] - gs[i]); }
    __syncthreads();
    { const int d = tid >> 4, e4 = (tid & 15) * 4; f32x4 u = {0.f, 0.f, 0.f, 0.f};
        for (int t = 0; t < 64; ++t) { const float kd = ks[t * 32 + d]; const f32x4 v4 = *(const f32x4*)(vs + t * 64 + e4); u += v4 * kd; }
        *(f32x4*)(P.out + SO_GU + (size_t)item * 2048 + d * 64 + e4) = u; }
    if (tid < 32) P.out[SO_GD + (size_t)item * 32 + tid] = __expf(gs[63 * 32 + tid]);
}

DEVI void rwkv_scan_prompt(const Params& P, int l, int item, float* sm) {
    const int b = item >> 4, h = (item >> 2) & 3, q = item & 3;
    const int tid = tidx(), wave = tid >> 6, lane = tid & 63;
    const bf16_t* RWP = (const bf16_t*)(P.ws + OFF_RWP); const float* RWC = (const float*)(P.ws + OFF_RWC); float* RWO = P.out + SO_RWO;
    constexpr int T = 32, BUF = 5 * T * 64 + T * 16 + T * 2;
    const size_t rbase = (size_t)b * 2048;
    float* buf0 = sm; float* buf1 = sm + BUF;
    auto load_chunk = [&](int c, float* buf) {
        const int lt = tid - 256, ch = lt & 63, tq = lt >> 6;
        bf16_t raw[8][5], rv[2]; float rc = 0.f;
#pragma unroll
        for (int i = 0; i < 8; ++i) { const int t = tq + 4 * i; const bf16_t* rp = RWP + (rbase + c * T + t) * 1536 + h * 64 + ch;
            raw[i][0] = rp[0]; raw[i][1] = rp[256]; raw[i][2] = rp[512]; raw[i][3] = rp[768]; raw[i][4] = rp[1024]; }
#pragma unroll
        for (int i = 0; i < 2; ++i) { const int t = (lt >> 4) + 16 * i, rr = lt & 15; rv[i] = RWP[(rbase + c * T + t) * 1536 + 1280 + h * 64 + 16 * q + rr]; }
        if (lt < 64) { const int t = lt >> 1, j = lt & 1; rc = RWC[(rbase + c * T + t) * 16 + h * 4 + j]; }
#pragma unroll
        for (int i = 0; i < 8; ++i) { const int t = tq + 4 * i;
            const float lw = bf2f(raw[i][0]), kk = bf2f(raw[i][1]), ka = bf2f(raw[i][2]), kp = bf2f(raw[i][3]), r = bf2f(raw[i][4]); const float dd = __expf(-lw);
            buf[t * 64 + ch] = dd; buf[T * 64 + t * 64 + ch] = dd * r; buf[2 * T * 64 + t * 64 + ch] = kk; buf[3 * T * 64 + t * 64 + ch] = ka; buf[4 * T * 64 + t * 64 + ch] = kp; }
#pragma unroll
        for (int i = 0; i < 2; ++i) { const int t = (lt >> 4) + 16 * i, rr = lt & 15; buf[5 * T * 64 + t * 16 + rr] = bf2f(rv[i]); }
        if (lt < 64) { const int t = lt >> 1, j = lt & 1; buf[5 * T * 64 + T * 16 + t * 2 + j] = rc; }
    };
    __syncthreads();
    if (tid >= 256) load_chunk(0, buf0);
    __syncthreads();
    const int rowgrp = lane >> 4, ks = lane & 15, vloc = 4 * wave + rowgrp, vrow = 16 * q + vloc;
    f32x4 S = {0.f, 0.f, 0.f, 0.f};
    for (int c = 0; c < SEQ / T; ++c) {
        float* cur = (c & 1) ? buf1 : buf0; float* nxt = (c & 1) ? buf0 : buf1;
        if (tid >= 256) { if (c + 1 < SEQ / T) load_chunk(c + 1, nxt); }
        else {
            const float* cb = cur + 4 * ks;
            f32x4 d4 = *(const f32x4*)(cb), dr4 = *(const f32x4*)(cb + T * 64), kk4 = *(const f32x4*)(cb + 2 * T * 64), ka4 = *(const f32x4*)(cb + 3 * T * 64), kp4 = *(const f32x4*)(cb + 4 * T * 64);
            float vv = cur[5 * T * 64 + vloc]; f32x2 cc = *(const f32x2*)(cur + 5 * T * 64 + T * 16);
            float* op = RWO + (rbase + (size_t)c * T) * 256 + h * 64 + vrow;
#pragma unroll 16
            for (int t = 0; t < T; ++t) {
                const float* nb = cb + (t + 1) * 64;
                const f32x4 nd4 = *(const f32x4*)(nb), ndr4 = *(const f32x4*)(nb + T * 64), nkk4 = *(const f32x4*)(nb + 2 * T * 64), nka4 = *(const f32x4*)(nb + 3 * T * 64), nkp4 = *(const f32x4*)(nb + 4 * T * 64);
                const float nvv = cur[5 * T * 64 + (t + 1) * 16 + vloc]; const f32x2 ncc = *(const f32x2*)(cur + 5 * T * 64 + T * 16 + (t + 1) * 2);
                const f32x2 t1 = S.lo * kk4.lo + S.hi * kk4.hi, t2 = S.lo * dr4.lo + S.hi * dr4.hi;
                float p1 = t1.x + t1.y, p2 = t2.x + t2.y;
                p1 = reduce16(p1); p2 = reduce16(p2);
                const float sa = -p1;
                S = S * d4 + ka4 * sa + kp4 * vv;
                op[t * 256] = p2 + sa * cc[0] + vv * cc[1];
                d4 = nd4; dr4 = ndr4; kk4 = nkk4; ka4 = nka4; kp4 = nkp4; vv = nvv; cc = ncc;
            }
        }
        __syncthreads();
    }
    if (tid < 256) *(f32x4*)(P.out + O_WKVP + ((size_t)((l * 8 + b) * 4 + h) * 64 + vrow) * 64 + 4 * ks) = S;
}
DEVI void rwkv_scan_sample(const Params& P, int l, int item) {
    const int tid = tidx(), wave = tid >> 6, lane = tid & 63, pair = item * 8 + wave, b = pair >> 2, h = pair & 3;
    const bf16_t* RWP = (const bf16_t*)(P.ws + OFF_RWP); const float* RWC = (const float*)(P.ws + OFF_RWC); float* RWO = P.out + SO_RWO;
    const size_t row = NTOK + b; const int rowgrp = lane >> 4, ks = lane & 15;
    const bf16_t* rp = RWP + row * 1536 + h * 64 + 4 * ks;
    f32x4 d4, dr4, kk4, ka4, kp4;
#pragma unroll
    for (int j = 0; j < 4; ++j) { const float lw = bf2f(rp[j]), r = bf2f(rp[1024 + j]); d4[j] = __expf(-lw); dr4[j] = d4[j] * r; kk4[j] = bf2f(rp[256 + j]); ka4[j] = bf2f(rp[512 + j]); kp4[j] = bf2f(rp[768 + j]); }
    const float c1 = RWC[row * 16 + h * 4], c2 = RWC[row * 16 + h * 4 + 1];
    const float* S0 = P.in[I_SWKV] + (size_t)((l * 128 + b) * 4 + h) * 4096; float* S1 = P.out + O_WKVS + (size_t)((l * 128 + b) * 4 + h) * 4096;
    f32x4 Sv[16]; bf16_t vr[16];
#pragma unroll
    for (int it = 0; it < 16; ++it) { const int vrow = 4 * it + rowgrp; Sv[it] = *(const f32x4*)(S0 + vrow * 64 + 4 * ks); vr[it] = RWP[row * 1536 + 1280 + h * 64 + vrow]; }
#pragma unroll
    for (int it = 0; it < 16; ++it) {
        const int vrow = 4 * it + rowgrp;
        f32x4 S = Sv[it];
        const float vv = bf2f(vr[it]);
        float p1 = (S[0] * kk4[0] + S[1] * kk4[1]) + (S[2] * kk4[2] + S[3] * kk4[3]);
        float p2 = (S[0] * dr4[0] + S[1] * dr4[1]) + (S[2] * dr4[2] + S[3] * dr4[3]);
        p1 = reduce16(p1); p2 = reduce16(p2);
        const float sa = -p1;
        S = S * d4 + ka4 * sa + kp4 * vv;
        *(f32x4*)(S1 + vrow * 64 + 4 * ks) = S;
        RWO[row * 256 + h * 64 + vrow] = p2 + sa * c1 + vv * c2;
    }
}
DEVI void gla_prefix(const Params& P, int l, int bh) {
    const int idx = tidx() * 4, d = idx >> 6;
    float* GU = P.out + SO_GU; const float* GD = P.out + SO_GD;
    f32x4 S = {0.f, 0.f, 0.f, 0.f};
#pragma nounroll
    for (int c0 = 0; c0 < 32; c0 += 8) {
        f32x4 U[8]; float dd[8];
#pragma unroll
        for (int c = 0; c < 8; ++c) { const size_t it = (size_t)bh * 32 + c0 + c; U[c] = *(const f32x4*)(GU + it * 2048 + idx); dd[c] = GD[it * 32 + d]; }
#pragma unroll
        for (int c = 0; c < 8; ++c) { const size_t it = (size_t)bh * 32 + c0 + c; *(f32x4*)(GU + it * 2048 + idx) = S; S = S * dd[c] + U[c]; }
    }
    *(f32x4*)(P.out + O_GLP + (size_t)(l * 32 + bh) * 2048 + idx) = S;
}
DEVI void lru_carry(const Params& P, int l, int b) {
    if (tidx() >= 256) return;
    const int d = tidx(); const float* LA = P.out + SO_LA; float* LB = P.out + SO_LB;
    float carry = 0.f;
#pragma nounroll
    for (int s0 = 0; s0 < 128; s0 += 32) {
        float A[32], Bv[32];
#pragma unroll
        for (int s = 0; s < 32; ++s) { const size_t o = (size_t)(b * 128 + s0 + s) * 256 + d; A[s] = LA[o]; Bv[s] = LB[o]; }
#pragma unroll
        for (int s = 0; s < 32; ++s) { const size_t o = (size_t)(b * 128 + s0 + s) * 256 + d; LB[o] = carry; carry = A[s] * carry + Bv[s]; }
    }
    P.out[O_HP + (size_t)(l * 8 + b) * 256 + d] = carry;
}
template <bool DRY = false> DEVI void swa_prompt(const Params& P, int l, int item, float* sm) {
    const bool dost = !DRY || (P.ws == nullptr);
    const int tid = tidx(), b = item >> 6, kv = (item >> 5) & 1, qb = item & 31, t0 = qb * 64;
    const bf16_t* PA = (const bf16_t*)(P.ws + OFF_PA); bf16_t* ZY = (bf16_t*)(P.ws + OFF_ZY);
    float* Ks = sm; float* Vs = sm + 192 * 68;
    __syncthreads();
    u32x4 kwa[3], vwa[3];
#pragma unroll
    for (int k = 0; k < 3; ++k) { const int i = tid + 512 * k, ls = i >> 3, c8 = (i & 7) * 8, s = t0 - 128 + ls; kwa[k] = (u32x4){0u, 0u, 0u, 0u}; vwa[k] = (u32x4){0u, 0u, 0u, 0u};
        if (s >= 0) { const bf16_t* rp = PA + (size_t)(b * 2048 + s) * PALD + CC + 256 + kv * 64 + c8; kwa[k] = *(const u32x4*)rp; vwa[k] = *(const u32x4*)(rp + 128); } }
#pragma unroll
    for (int k = 0; k < 3; ++k) { const int i = tid + 512 * k, ls = i >> 3, c8 = (i & 7) * 8; const u32x4 kw = kwa[k], vw = vwa[k];
        *(f32x4*)(Ks + ls * 68 + c8) = (f32x4){bflo(kw.x), bfhi(kw.x), bflo(kw.y), bfhi(kw.y)}; *(f32x4*)(Ks + ls * 68 + c8 + 4) = (f32x4){bflo(kw.z), bfhi(kw.z), bflo(kw.w), bfhi(kw.w)};
        *(f32x4*)(Vs + ls * 68 + c8) = (f32x4){bflo(vw.x), bfhi(vw.x), bflo(vw.y), bfhi(vw.y)}; *(f32x4*)(Vs + ls * 68 + c8 + 4) = (f32x4){bflo(vw.z), bfhi(vw.z), bflo(vw.w), bfhi(vw.w)}; }
    __syncthreads();
    const int rowid = tid >> 2, part = tid & 3, g = rowid & 1, qi = rowid >> 1, hh = kv * 2 + g, t = t0 + qi;
    const size_t row = (size_t)b * 2048 + t;
    f32x2 q2[8];
    { const u32x4* qp = (const u32x4*)(PA + row * PALD + CC + hh * 64 + 16 * part);
#pragma unroll
        for (int i = 0; i < 2; ++i) { const u32x4 w = qp[i]; q2[4 * i] = (f32x2){bflo(w.x), bfhi(w.x)} * 0.125f; q2[4 * i + 1] = (f32x2){bflo(w.y), bfhi(w.y)} * 0.125f;
            q2[4 * i + 2] = (f32x2){bflo(w.z), bfhi(w.z)} * 0.125f; q2[4 * i + 3] = (f32x2){bflo(w.w), bfhi(w.w)} * 0.125f; } }
    const float slope = exp2f(-2.f * (float)(hh + 1));
    float m = -1e30f, lsum = 0.f; f32x2 acc2[8];
#pragma unroll
    for (int i = 0; i < 8; ++i) acc2[i] = (f32x2){0.f, 0.f};
    const int j0 = (t < 128) ? (128 - t) : 0;
    for (int j = j0; j <= 128; j += 2) {
        const bool vb = (j + 1) <= 128; const int rb = vb ? (qi + j + 1) : (qi + j);
        const float* kra = Ks + (qi + j) * 68 + 16 * part; const float* krb = Ks + rb * 68 + 16 * part;
        f32x2 sa2 = {0.f, 0.f}, sb2 = {0.f, 0.f};
#pragma unroll
        for (int i = 0; i < 4; ++i) { const f32x4 ka = *(const f32x4*)(kra + 4 * i), kb = *(const f32x4*)(krb + 4 * i);
            sa2 += q2[2 * i] * ka.lo; sa2 += q2[2 * i + 1] * ka.hi; sb2 += q2[2 * i] * kb.lo; sb2 += q2[2 * i + 1] * kb.hi; }
        const float sca = quad_sum(sa2.x + sa2.y) - slope * (float)(128 - j);
        const float scb = vb ? (quad_sum(sb2.x + sb2.y) - slope * (float)(127 - j)) : -1e30f;
        const float mn = fmaxf(sca, scb);
        if (mn > m) { const float corr = __expf(m - mn); lsum *= corr;
#pragma unroll
            for (int i = 0; i < 8; ++i) acc2[i] *= corr;
            m = mn; }
        const float pa = __expf(sca - m), pb = vb ? __expf(scb - m) : 0.f; lsum += pa + pb;
        const float* vra = Vs + (qi + j) * 68 + 16 * part; const float* vrb = Vs + rb * 68 + 16 * part;
#pragma unroll
        for (int i = 0; i < 4; ++i) { const f32x4 va = *(const f32x4*)(vra + 4 * i), vbv = *(const f32x4*)(vrb + 4 * i);
            acc2[2 * i] += va.lo * pa; acc2[2 * i + 1] += va.hi * pa; acc2[2 * i] += vbv.lo * pb; acc2[2 * i + 1] += vbv.hi * pb; }
    }
    float acc[16];
#pragma unroll
    for (int i = 0; i < 8; ++i) { acc[2 * i] = acc2[i].x; acc[2 * i + 1] = acc2[i].y; }
    const float sk = P.in[I_SINK][l * 4 + hh], mf = fmaxf(m, sk), e = __expf(m - mf), inv = e * frcp(lsum * e + __expf(sk - mf));
    bf16_t* zp = ZY + row * 1024 + 512 + hh * 64 + 16 * part;
    const u32x4 z0 = *(const u32x4*)zp, z1 = *(const u32x4*)(zp + 8);
    float o[16];
#pragma unroll
    for (int i = 0; i < 16; ++i) o[i] = acc[i] * inv;
    u32x4 w0, w1;
    w0.x = pk2(o[0] * silu(bflo(z0.x)), o[1] * silu(bfhi(z0.x))); w0.y = pk2(o[2] * silu(bflo(z0.y)), o[3] * silu(bfhi(z0.y)));
    w0.z = pk2(o[4] * silu(bflo(z0.z)), o[5] * silu(bfhi(z0.z))); w0.w = pk2(o[6] * silu(bflo(z0.w)), o[7] * silu(bfhi(z0.w)));
    w1.x = pk2(o[8] * silu(bflo(z1.x)), o[9] * silu(bfhi(z1.x))); w1.y = pk2(o[10] * silu(bflo(z1.y)), o[11] * silu(bfhi(z1.y)));
    w1.z = pk2(o[12] * silu(bflo(z1.z)), o[13] * silu(bfhi(z1.z))); w1.w = pk2(o[14] * silu(bflo(z1.w)), o[15] * silu(bfhi(z1.w)));
    if (dost) { *(u32x4*)zp = w0; *(u32x4*)(zp + 8) = w1; }
}
DEVI void swa_sample(const Params& P, int l, int b, float* sm) {
    const int tid = tidx(), wave = tid >> 6, lane = tid & 63; const size_t row = NTOK + b;
    const bf16_t* PA = (const bf16_t*)(P.ws + OFF_PA); bf16_t* ZY = (bf16_t*)(P.ws + OFF_ZY);
    float* qs = sm; float* kn = sm + 256; float* vn = sm + 384; float* sc = sm + 512;
    const float* CK = P.in[I_CK] + (size_t)(l * 128 + b) * 16384; const float* CV = P.in[I_CV] + (size_t)(l * 128 + b) * 16384;
    __syncthreads();
    { const float v = bf2f(PA[row * PALD + CC + tid]); if (tid < 256) qs[tid] = v * 0.125f; else if (tid < 384) kn[tid - 256] = v; else vn[tid - 384] = v; }
    __syncthreads();
    { const int hh = tid >> 7, s = tid & 127, kv = hh >> 1; const f32x4* kp = (const f32x4*)(CK + s * 128 + kv * 64); const float* qh = qs + hh * 64; float d = 0.f;
#pragma unroll
        for (int i = 0; i < 16; ++i) { const f32x4 k4 = kp[i]; d += qh[4 * i] * k4[0] + qh[4 * i + 1] * k4[1] + qh[4 * i + 2] * k4[2] + qh[4 * i + 3] * k4[3]; }
        sc[hh * 132 + s] = d - exp2f(-2.f * (float)(hh + 1)) * (float)(128 - s); }
    if (wave < 4) { const int hh = wave; const float d = wave_sum(qs[hh * 64 + lane] * kn[(hh >> 1) * 64 + lane]); if (lane == 0) sc[hh * 132 + 128] = d; }
    __syncthreads();
    if (wave < 4) { const int hh = wave; const float a0 = sc[hh * 132 + lane], a1 = sc[hh * 132 + 64 + lane], a2 = lane == 0 ? sc[hh * 132 + 128] : -1e30f, sk = P.in[I_SINK][l * 4 + hh];
        const float mx = fmaxf(wave_max(fmaxf(fmaxf(a0, a1), a2)), sk); const float e0 = __expf(a0 - mx), e1 = __expf(a1 - mx), e2 = lane == 0 ? __expf(a2 - mx) : 0.f;
        const float inv = frcp(wave_sum(e0 + e1 + e2) + __expf(sk - mx));
        sc[hh * 132 + lane] = e0 * inv; sc[hh * 132 + 64 + lane] = e1 * inv; if (lane == 0) sc[hh * 132 + 128] = e2 * inv; }
    __syncthreads();
    if (tid < 256) { const int hh = tid >> 6, dd = tid & 63, kv = hh >> 1; const float* pp = sc + hh * 132; float o = pp[128] * vn[kv * 64 + dd];
#pragma nounroll
        for (int s0 = 0; s0 < 128; s0 += 32) { float cvv[32];
#pragma unroll
            for (int s = 0; s < 32; ++s) cvv[s] = CV[(s0 + s) * 128 + kv * 64 + dd];
#pragma unroll
            for (int s = 0; s < 32; ++s) o += pp[s0 + s] * cvv[s]; }
        bf16_t* zp = ZY + row * 1024 + 512 + tid; *zp = f2bf(o * silu(bf2f(*zp))); }
    float* KO = P.out + O_KS + (size_t)(l * 128 + b) * 16384; float* VO = P.out + O_VS + (size_t)(l * 128 + b) * 16384;
    { f32x4 tk[8], tv[8];
#pragma unroll
      for (int k = 0; k < 8; ++k) { const int e = (tid + 512 * k) * 4;
        if (e < 127 * 128) { tk[k] = *(const f32x4*)(CK + 128 + e); tv[k] = *(const f32x4*)(CV + 128 + e); }
        else { tk[k] = *(const f32x4*)(kn + (e - 127 * 128)); tv[k] = *(const f32x4*)(vn + (e - 127 * 128)); } }
#pragma unroll
      for (int k = 0; k < 8; ++k) { const int e = (tid + 512 * k) * 4; *(f32x4*)(KO + e) = tk[k]; *(f32x4*)(VO + e) = tv[k]; } }
}
DEVI void gla_sample(const Params& P, int l, int b, float* sm) {
    const int tid = tidx(); const size_t row = NTOK + b;
    const bf16_t* PA = (const bf16_t*)(P.ws + OFF_PA); bf16_t* ZY = (bf16_t*)(P.ws + OFF_ZY);
    float* qs = sm; float* ks = sm + 128; float* eg = sm + 256; float* gl = sm + 384;
    __syncthreads();
    if (tid < 128) { qs[tid] = bf2f(PA[row * PALD + CB + tid]) * 0.17677669529663687f; ks[tid] = bf2f(PA[row * PALD + CB + 128 + tid]); }
    if (tid >= 128 && tid < 144) gl[tid - 128] = bf2f(PA[row * PALD + CB + 512 + tid - 128]);
    __syncthreads();
    if (tid < 128) { float x = P.in[I_GB][l * 128 + tid];
#pragma unroll
        for (int j = 0; j < 16; ++j) x += gl[j] * P.in[I_GUP][(l * 16 + j) * 128 + tid];
        eg[tid] = __expf(logsig(x) * (1.f / 16.f)); }
    __syncthreads();
    if (tid < 256) { const int h = tid >> 6, e = tid & 63; const float v = bf2f(PA[row * PALD + CB + 256 + tid]);
        const float* S0 = P.in[I_SGLA] + (size_t)((l * 128 + b) * 4 + h) * 2048; float* S1 = P.out + O_GLS + (size_t)((l * 128 + b) * 4 + h) * 2048;
        float o = 0.f, s0v[32];
#pragma unroll
        for (int d = 0; d < 32; ++d) s0v[d] = S0[d * 64 + e];
#pragma unroll
        for (int d = 0; d < 32; ++d) { const float sn = eg[h * 32 + d] * s0v[d] + ks[h * 32 + d] * v; S1[d * 64 + e] = sn; o += qs[h * 32 + d] * sn; }
        const float rr = rsqrtf(wave_sum(o * o) * (1.f / 64.f) + 1e-6f);
        bf16_t* zp = ZY + row * 1024 + 256 + tid; *zp = f2bf(o * rr * P.in[I_GNG][l * 64 + e] * silu(bf2f(*zp))); }
}
DEVI void lru_sample(const Params& P, int l, int item, float* sm) {
    const int tid = tidx(), s = tid >> 8, d = tid & 255, b = item * 2 + s; const size_t row = NTOK + b;
    const bf16_t* PA = (const bf16_t*)(P.ws + OFF_PA); bf16_t* ZY = (bf16_t*)(P.ws + OFF_ZY);
    float* xcs = sm;
    __syncthreads();
    const float x = bf2f(PA[row * PALD + CD + d]); const float* cv = P.in[I_SCONV] + (size_t)(l * 128 + b) * 768;
    const float c0 = cv[d], c1 = cv[256 + d], c2 = cv[512 + d];
    const float xc = P.in[I_CBI][l * 256 + d] + P.in[I_CW][(l * 4 + 0) * 256 + d] * c0 + P.in[I_CW][(l * 4 + 1) * 256 + d] * c1 + P.in[I_CW][(l * 4 + 2) * 256 + d] * c2 + P.in[I_CW][(l * 4 + 3) * 256 + d] * x;
    xcs[s * 256 + d] = xc;
    __syncthreads();
    const int n = d >> 6, dl = d & 63; float rp = P.in[I_BA][l * 256 + d], ip = P.in[I_BX][l * 256 + d];
#pragma unroll 8
    for (int c = 0; c < 64; ++c) { const float xv = xcs[s * 256 + n * 64 + c]; rp += xv * P.in[I_WA][((l * 4 + n) * 64 + c) * 64 + dl]; ip += xv * P.in[I_WX][((l * 4 + n) * 64 + c) * 64 + dl]; }
    const float la = 8.f * logsig_acc(P.in[I_LAM][l * 256 + d]) * sigm(rp), a = __expf(la), bt = __builtin_amdgcn_sqrtf(fmaxf(-expm1f(2.f * la), 0.f)) * sigm(ip) * xc;
    const float hn = a * P.in[I_SH][(size_t)(l * 128 + b) * 256 + d] + bt;
    float* co = P.out + O_CVS + (size_t)(l * 128 + b) * 768; co[d] = c1; co[256 + d] = c2; co[512 + d] = x;
    P.out[O_HS + (size_t)(l * 128 + b) * 256 + d] = hn;
    bf16_t* zp = ZY + row * 1024 + 768 + d; *zp = f2bf(hn * silu(bf2f(*zp)));
}

template <bool DRY = false> DEVI void rwkv_post(const Params& P, int l, int item) {
    const bool dost = !DRY || (P.ws == nullptr);
    const int tid = tidx(), wave = tid >> 6, lane = tid & 63;
    const bf16_t* RWP = (const bf16_t*)(P.ws + OFF_RWP); const float* RWC = (const float*)(P.ws + OFF_RWC); const float* RWO = P.out + SO_RWO; bf16_t* ZY = (bf16_t*)(P.ws + OFF_ZY);
    float o[8], v[8], z[8], c3[8];
#pragma unroll
    for (int k = 0; k < 8; ++k) { const int task = wave * 8 + k, h = task & 3; const size_t row = (size_t)item * 16 + (task >> 2);
        o[k] = RWO[row * 256 + h * 64 + lane]; v[k] = bf2f(RWP[row * 1536 + 1280 + h * 64 + lane]); z[k] = bf2f(ZY[row * 1024 + h * 64 + lane]); c3[k] = RWC[row * 16 + h * 4 + 2]; }
#pragma unroll
    for (int k = 0; k < 8; ++k) { const int task = wave * 8 + k, h = task & 3; const size_t row = (size_t)item * 16 + (task >> 2);
        const float mean = wave_sum(o[k]) * (1.f / 64.f); const float dv = o[k] - mean; const float var = wave_sum(dv * dv) * (1.f / 64.f);
        const float y = dv * rsqrtf(var + 64e-5f) * P.in[I_LNG][l * 256 + h * 64 + lane] + P.in[I_LNB][l * 256 + h * 64 + lane] + c3[k] * v[k];
        if (dost) ZY[row * 1024 + h * 64 + lane] = f2bf(y * silu(z[k])); }
}
template <bool DRY = false> DEVI void lru_final(const Params& P, int l, int item) {
    const bool dost = !DRY || (P.ws == nullptr);
    const int tid = tidx(), b = item >> 6, ck = item & 63, d = tid & 255, half = tid >> 8, sub = ck * 2 + half;
    const float* LH = P.out + SO_LH; const float* LP = P.out + SO_LP; const float* LB = P.out + SO_LB; bf16_t* ZY = (bf16_t*)(P.ws + OFF_ZY);
    const float carry = LB[(size_t)(b * 128 + sub) * 256 + d];
    const size_t r0 = (size_t)b * 2048 + ck * 32 + half * 16;
    float hv[16], z[16];
#pragma unroll
    for (int tt = 0; tt < 16; ++tt) { hv[tt] = LH[(r0 + tt) * 256 + d] + LP[(r0 + tt) * 256 + d] * carry; z[tt] = bf2f(ZY[(r0 + tt) * 1024 + 768 + d]); }
#pragma unroll
    for (int tt = 0; tt < 16; ++tt) if (dost) ZY[(r0 + tt) * 1024 + 768 + d] = f2bf(hv[tt] * silu(z[tt]));
}
template <bool DRY = false> DEVI void gla_out(const Params& P, int l, int item, float* sm) {
    const bool dost = !DRY || (P.ws == nullptr);
    const int tid = tidx(), c = item & 31, h = (item >> 5) & 3, b = item >> 7, row0 = b * 2048 + c * 64;
    const bf16_t* PA = (const bf16_t*)(P.ws + OFF_PA); bf16_t* ZY = (bf16_t*)(P.ws + OFF_ZY);
    float* gs = sm; float* gl = sm + 2048; float* seg = sm + 3072; float* qs = sm + 3584; float* ks = qs + 64 * 36; float* vs = ks + 64 * 36; float* att = vs + 4096; float* Ss = att + 64 * 65;
    __syncthreads();
    { bf16_t tq[4], tk[4], tv[8]; float ts[4];
#pragma unroll
      for (int k = 0; k < 4; ++k) { const int i = tid + 512 * k, t = i >> 5, d = i & 31; const bf16_t* rp = PA + (size_t)(row0 + t) * PALD + CB + h * 32 + d; tq[k] = rp[0]; tk[k] = rp[128]; ts[k] = P.out[SO_GU + (size_t)item * 2048 + i]; }
#pragma unroll
      for (int k = 0; k < 8; ++k) { const int i = tid + 512 * k, t = i >> 6, e = i & 63; tv[k] = PA[(size_t)(row0 + t) * PALD + CB + 256 + h * 64 + e]; }
#pragma unroll
      for (int k = 0; k < 4; ++k) { const int i = tid + 512 * k, t = i >> 5, d = i & 31; qs[t * 36 + d] = bf2f(tq[k]) * 0.17677669529663687f; ks[t * 36 + d] = bf2f(tk[k]); Ss[i] = ts[k]; }
#pragma unroll
      for (int k = 0; k < 8; ++k) vs[tid + 512 * k] = bf2f(tv[k]); }
    gla_load_cum(P, l, h, row0, gs, gl, seg);
    for (int i = tid; i < 2048; i += 512) { const int t = i >> 5, d = i & 31; const float bc = gs[i]; qs[t * 36 + d] *= __expf(bc); ks[t * 36 + d] *= __expf(-bc); }
    __syncthreads();
    const int t = tid >> 3, s8 = (tid & 7) * 8;
    {
        f32x4 qv[8];
#pragma unroll
        for (int d4 = 0; d4 < 8; ++d4) qv[d4] = *(const f32x4*)(qs + t * 36 + 4 * d4);
#pragma unroll
        for (int i = 0; i < 8; ++i) { const int s = 8 * i + (tid & 7); float a = 0.f;
            if (s <= t) { f32x2 a2 = {0.f, 0.f};
#pragma unroll
                for (int d4 = 0; d4 < 8; ++d4) { const f32x4 kv = *(const f32x4*)(ks + s * 36 + 4 * d4); a2 += qv[d4].lo * kv.lo; a2 += qv[d4].hi * kv.hi; }
                a = a2.x + a2.y; }
            att[t * 65 + s] = a; }
    }
    __syncthreads();
    const int e8 = s8; float o[8]; f32x2 o2[4], o3[4];
#pragma unroll
    for (int i = 0; i < 4; ++i) { o2[i] = (f32x2){0.f, 0.f}; o3[i] = (f32x2){0.f, 0.f}; }
    int s = 0;
    for (; s + 1 <= t; s += 2) {
        const float a0 = att[t * 65 + s], a1 = att[t * 65 + s + 1];
        const f32x4 v0 = *(const f32x4*)(vs + s * 64 + e8), v1 = *(const f32x4*)(vs + s * 64 + e8 + 4), w0 = *(const f32x4*)(vs + (s + 1) * 64 + e8), w1 = *(const f32x4*)(vs + (s + 1) * 64 + e8 + 4);
        o2[0] += v0.lo * a0; o2[1] += v0.hi * a0; o2[2] += v1.lo * a0; o2[3] += v1.hi * a0;
        o3[0] += w0.lo * a1; o3[1] += w0.hi * a1; o3[2] += w1.lo * a1; o3[3] += w1.hi * a1; }
    if (s <= t) { const float a0 = att[t * 65 + s]; const f32x4 v0 = *(const f32x4*)(vs + s * 64 + e8), v1 = *(const f32x4*)(vs + s * 64 + e8 + 4);
        o2[0] += v0.lo * a0; o2[1] += v0.hi * a0; o2[2] += v1.lo * a0; o2[3] += v1.hi * a0; }
#pragma unroll 4
    for (int d = 0; d < 32; d += 2) { const float a0 = qs[t * 36 + d], a1 = qs[t * 36 + d + 1];
        const f32x4 v0 = *(const f32x4*)(Ss + d * 64 + e8), v1 = *(const f32x4*)(Ss + d * 64 + e8 + 4), w0 = *(const f32x4*)(Ss + (d + 1) * 64 + e8), w1 = *(const f32x4*)(Ss + (d + 1) * 64 + e8 + 4);
        o2[0] += v0.lo * a0; o2[1] += v0.hi * a0; o2[2] += v1.lo * a0; o2[3] += v1.hi * a0;
        o3[0] += w0.lo * a1; o3[1] += w0.hi * a1; o3[2] += w1.lo * a1; o3[3] += w1.hi * a1; }
#pragma unroll
    for (int i = 0; i < 4; ++i) { const f32x2 r2 = o2[i] + o3[i]; o[2 * i] = r2.x; o[2 * i + 1] = r2.y; }
    float ss = 0.f;
#pragma unroll
    for (int i = 0; i < 8; ++i) ss += o[i] * o[i];
    ss = reduce8(ss);
    const float rr = rsqrtf(ss * (1.f / 64.f) + 1e-6f);
    bf16_t* zp = ZY + (size_t)(row0 + t) * 1024 + 256 + h * 64 + e8; const u32x4 z = *(const u32x4*)zp; const float* ng = P.in[I_GNG] + l * 64 + e8;
    u32x4 w; w.x = pk2(o[0] * rr * ng[0] * silu(bflo(z.x)), o[1] * rr * ng[1] * silu(bfhi(z.x))); w.y = pk2(o[2] * rr * ng[2] * silu(bflo(z.y)), o[3] * rr * ng[3] * silu(bfhi(z.y)));
    w.z = pk2(o[4] * rr * ng[4] * silu(bflo(z.z)), o[5] * rr * ng[5] * silu(bfhi(z.z))); w.w = pk2(o[6] * rr * ng[6] * silu(bflo(z.w)), o[7] * rr * ng[7] * silu(bfhi(z.w)));
    if (dost) *(u32x4*)zp = w;
}


DEVI void grid_bar(unsigned* w, unsigned k) {
    asm volatile("s_waitcnt vmcnt(0)" ::: "memory");
    __syncthreads();
    if (tidx() == 0) {
        const unsigned G = gridDim.x;
        __builtin_amdgcn_fence(__ATOMIC_RELEASE, "agent");
        asm volatile("s_waitcnt vmcnt(0)" ::: "memory");
        const unsigned old = __hip_atomic_fetch_add(&w[0], 1u, __ATOMIC_RELAXED, __HIP_MEMORY_SCOPE_AGENT);
        if (old + 1u == k * G) __hip_atomic_store(&w[64], k, __ATOMIC_RELAXED, __HIP_MEMORY_SCOPE_AGENT);
        while (__hip_atomic_load(&w[64], __ATOMIC_RELAXED, __HIP_MEMORY_SCOPE_AGENT) < k) __builtin_amdgcn_s_sleep(1);
        __builtin_amdgcn_fence(__ATOMIC_ACQUIRE, "agent");
        asm volatile("s_waitcnt vmcnt(0)" ::: "memory");
    }
    __syncthreads();
}

template <int NT, class Epi>
DEVI void small_gemm(const bf16_t* A, int lda, const bf16_t* const (&bp)[NT], int ldb, int K, const Epi& E, float* sm) {
    const int tid = tidx(), wave = tid >> 6, lane = tid & 63, lr = lane & 15, lq = lane >> 4;
    const int kw = K >> 3, kbeg = wave * kw;
    const bf16_t* ap = A + (size_t)lr * lda + 8 * lq + kbeg;
    f32x4 acc[NT];
#pragma unroll
    for (int t = 0; t < NT; ++t) acc[t] = (f32x4){0.f, 0.f, 0.f, 0.f};
    if (kw == 128) {
        bf16x8 a[4], b[4][NT];
#pragma unroll
        for (int s2 = 0; s2 < 4; ++s2) { a[s2] = *(const bf16x8*)(ap + 32 * s2);
#pragma unroll
            for (int t = 0; t < NT; ++t) b[s2][t] = *(const bf16x8*)(bp[t] + (size_t)lr * ldb + 8 * lq + kbeg + 32 * s2); }
#pragma unroll
        for (int s2 = 0; s2 < 4; ++s2)
#pragma unroll
            for (int t = 0; t < NT; ++t) acc[t] = __builtin_amdgcn_mfma_f32_16x16x32_bf16(a[s2], b[s2][t], acc[t], 0, 0, 0);
    } else {
        const bf16x8 a = *(const bf16x8*)ap; bf16x8 b[NT];
#pragma unroll
        for (int t = 0; t < NT; ++t) b[t] = *(const bf16x8*)(bp[t] + (size_t)lr * ldb + 8 * lq + kbeg);
#pragma unroll
        for (int t = 0; t < NT; ++t) acc[t] = __builtin_amdgcn_mfma_f32_16x16x32_bf16(a, b[t], acc[t], 0, 0, 0);
    }
    __syncthreads();
    f32x4* red = (f32x4*)sm;
#pragma unroll
    for (int t = 0; t < NT; ++t) red[(wave * NT + t) * 64 + lane] = acc[t];
    __syncthreads();
    if (wave == 0) {
#pragma unroll
        for (int t = 0; t < NT; ++t) { f32x4 v = red[t * 64 + lane];
#pragma unroll
            for (int w = 1; w < 8; ++w) v += red[(w * NT + t) * 64 + lane];
            acc[t] = v; }
        E(acc, lane);
    }
}
DEVI void small_br(const Params& P, int l, int item, float* sm) {
    const int rg = item >> 6, it = item & 63, b = it >> 4, s4 = it & 15;
    const bf16_t* ZY = (const bf16_t*)(P.ws + OFF_ZY) + (size_t)(NTOK + 16 * rg) * 1024 + b * 256;
    const bf16_t* W = (const bf16_t*)(P.ws + OFF_WBR) + (size_t)(l * 4 + b) * 1024 * 256;
    const bf16_t* bp[4] = {W + (size_t)(64 * s4) * 256, W + (size_t)(64 * s4 + 16) * 256, W + (size_t)(64 * s4 + 32) * 256, W + (size_t)(64 * s4 + 48) * 256};
    bf16_t* BR = (bf16_t*)(P.ws + OFF_BR) + (size_t)(NTOK + 16 * rg) * 4096 + b * 1024;
    auto E = [&](const f32x4 (&acc)[4], int lane) {
#pragma unroll
        for (int t = 0; t < 4; ++t) { const int n = 64 * s4 + 16 * t + (lane & 15), col = (n & ~255) + natcol(n & 255);
#pragma unroll
            for (int g = 0; g < 4; ++g) BR[(size_t)((lane >> 4) * 4 + g) * 4096 + col] = f2bf(acc[t][g]); } };
    small_gemm<4>(ZY, 1024, bp, 256, 256, E, sm);
}
DEVI void small_gate(const Params& P, int l, int item, float* sm) {
    const int rg = item >> 6, it = item & 63, q = it >> 2, wc = it & 3;
    const bf16_t* XB = (const bf16_t*)(P.ws + OFF_XB) + (size_t)(NTOK + 16 * rg) * 1024;
    const bf16_t* W = (const bf16_t*)(P.ws + OFF_W1T) + (size_t)l * 7424 * 1024 + (size_t)(3328 + 256 * q + 32 * wc) * 1024;
    const bf16_t* bp[4] = {W, W + (size_t)16 * 1024, W + (size_t)128 * 1024, W + (size_t)144 * 1024};
    const bf16_t* BR = (const bf16_t*)(P.ws + OFF_BR) + (size_t)(NTOK + 16 * rg) * 4096;
    const float* ssq = (const float*)(P.ws + OFF_SSQ) + l * MPAD + NTOK + 16 * rg;
    bf16_t* ZY = (bf16_t*)(P.ws + OFF_ZY) + (size_t)(NTOK + 16 * rg) * 1024;
    auto E = [&](const f32x4 (&acc)[4], int lane) {
        const int col = 64 * q + 16 * wc + (lane & 15);
#pragma unroll
        for (int g = 0; g < 4; ++g) { const int rl = (lane >> 4) * 4 + g; const float rs = rsqrtf(ssq[rl] * (1.f / 1024.f) + 1e-6f); float o = 0.f;
#pragma unroll
            for (int b = 0; b < 4; ++b) o += sigm(acc[b][g] * rs) * bf2f(BR[(size_t)rl * 4096 + b * 1024 + col]);
            ZY[(size_t)rl * 1024 + col] = f2bf(o); } };
    small_gemm<4>(XB, 1024, bp, 1024, 1024, E, sm);
}
template <int LAYER> DEVI void small_out(const Params& P, int l, int item, float* sm) {
    const int rg = item >> 5, it = item & 31;
    const bf16_t* ZY = (const bf16_t*)(P.ws + OFF_ZY) + (size_t)(NTOK + 16 * rg) * 1024;
    const bf16_t* W = (const bf16_t*)(P.ws + OFF_WOUT) + (size_t)l * 1024 * 1024 + (size_t)(32 * it) * 1024;
    const bf16_t* bp[2] = {W, W + (size_t)16 * 1024};
    bf16_t* XB = (bf16_t*)(P.ws + OFF_XB) + (size_t)(NTOK + 16 * rg) * 1024; float* yout = P.out + (size_t)(NTOK + 16 * rg) * 1024; const float* xs = P.in[I_XS] + (size_t)(16 * rg) * 1024;
    float* ssq = (float*)(P.ws + OFF_SSQ) + (LAYER == 0 ? 1 : 2) * MPAD + NTOK + 16 * rg;
    auto E = [&](const f32x4 (&acc)[2], int lane) {
        const int i = lane & 15;
#pragma unroll
        for (int g = 0; g < 4; ++g) { const int rl = (lane >> 4) * 4 + g; float ps = 0.f;
#pragma unroll
            for (int t = 0; t < 2; ++t) { const int col = 32 * it + 8 * (i >> 2) + 4 * t + (i & 3); float v = acc[t][g];
                if (LAYER == 0) { v += xs[(size_t)rl * 1024 + col]; XB[(size_t)rl * 1024 + col] = f2bf(v); }
                else { v += bf2f(XB[(size_t)rl * 1024 + col]); yout[(size_t)rl * 1024 + col] = v; }
                ps += v * v; }
            ps = reduce16(ps);
            if (i == 0) atomicAdd(ssq + rl, ps); } };
    small_gemm<2>(ZY, 1024, bp, 1024, 1024, E, sm);
}

#ifndef PHMASK
#define PHMASK 0xFFFF
#endif
#define PHON(b) ((PHMASK >> (b)) & 1)
DEVI void run_phase(const Params& P, int ph, unsigned char* smem) {
    float* sm = (float*)smem;
    const int G = gridDim.x, c = blockIdx.x;
    if (ph == 0) { if (PHON(0)) phase_p0(P, smem); return; }
    if (ph == NPH - 1) { if (!PHON(8)) return;
        const int wave = tidx() >> 6, lane = tidx() & 63; const float* ssq = (const float*)(P.ws + OFF_SSQ) + 2 * MPAD;
        for (int row = c * 8 + wave; row < ROWS; row += G * 8) { const float rs = rsqrtf(ssq[row] * (1.f / 1024.f) + 1e-6f); f32x4* yp = (f32x4*)(P.out + (size_t)row * 1024) + lane; const f32x4* gp = (const f32x4*)P.in[I_FNG] + lane;
#pragma unroll
            for (int j = 0; j < 4; ++j) yp[64 * j] = yp[64 * j] * rs * gp[64 * j]; }
        return;
    }
    const int l = (ph - 1) / 7, sp = (ph - 1) % 7;
    const char* XB = (const char*)(P.ws + OFF_XB); const char* ZYc = (const char*)(P.ws + OFF_ZY);
    float* ssq = (float*)(P.ws + OFF_SSQ);
    if (sp == 0) { if (!PHON(1)) return; SchedG1 S{XB, (const char*)(P.ws + OFF_W1T) + (size_t)l * 7424 * 2048, G, c}; EpiG1 E{(bf16_t*)(P.ws + OFF_PA), (bf16_t*)(P.ws + OFF_ZY), ssq + l * MPAD};
        g8::gemm_phase((LAS unsigned char*)smem, 2048, 2048, 1024, S, E);
        if (l == 0) { const int nfull = 65 * 13 - 3 * G;
            if (false && c >= nfull) { __syncthreads(); weight_items(P, smem, WI_EARLY, WI_ALL, (c - nfull) * 8 + (tidx() >> 6), (G - nfull) * 8); } }
        return; }
    if (sp == 1) { if (!PHON(2)) return;
        constexpr int NA = 1024, NL = 512, NG = 1024, NAS = 32, NC = 8;
        for (int it = c; it < NA + NL + NG + NAS + NC; it += G) { int r = it;
            if (r < NA) { rwkv_prep(P, l, r); continue; } r -= NA;
            if (r < NL) { lru_prep(P, l, r, sm); continue; } r -= NL;
            if (r < NG) { gla_prep(P, l, r, sm); continue; } r -= NG;
            if (r < NAS) { rwkv_prep(P, l, 1024 + r); continue; } r -= NAS;
            cache_copy(P, l, r); }
        return; }
    if (sp == 2) { if (!PHON(3)) return;
        const int nR = G >= 256 ? 128 : (G > 1 ? G / 2 : 0);
        if (c < nR) { if (PROBE_SP != 13) for (int it = c; it < 128; it += nR) { const int slot = it >> 3; rwkv_scan_prompt(P, l, (((it & 7) * 4 + (slot >> 2)) * 4) + (slot & 3), sm); } return; }
        constexpr int NSW = 512, NGP = 32, NLC = 8, NRS = 64, NSS = 128, NGS = 128, NLS = 64;
        if (nR == 0) for (int it = 0; it < 128; ++it) rwkv_scan_prompt(P, l, it, sm);
        for (int it = c - nR; it < NSW + NGP + NLC + NRS + NSS + NGS + NLS; it += G - nR) { int r = it;
            if (r < NGP) { gla_prefix(P, l, r); continue; } r -= NGP;
            if (r < NLC) { lru_carry(P, l, r); continue; } r -= NLC;
            if (r < NSW) { swa_prompt(P, l, r, sm); continue; } r -= NSW;
            if (r < NRS) { rwkv_scan_sample(P, l, r); continue; } r -= NRS;
            if (r < NSS) { swa_sample(P, l, r, sm); continue; } r -= NSS;
            if (r < NGS) { gla_sample(P, l, r, sm); continue; } r -= NGS;
            lru_sample(P, l, r, sm); }
        return; }
    if (sp == 3) { if (!PHON(4)) return;
        constexpr int NG = 1024, NL = 512, NR = 1032;
        for (int it = c; it < NG + NL + NR; it += G) { int r = it;
            if (r < NG) { gla_out(P, l, r, sm); continue; } r -= NG;
            if (r < NL) { lru_final(P, l, r); continue; } r -= NL;
            rwkv_post(P, l, r); }
        return; }
    if (sp == 4) { if (!PHON(5)) return; SchedBr S{ZYc, (const char*)(P.ws + OFF_WBR) + (size_t)l * 4 * 1024 * 512, G, c}; EpiBr E{(bf16_t*)(P.ws + OFF_BR)};
        g8::gemm_phase((LAS unsigned char*)smem, 2048, 512, 256, S, E);
        for (int it = G - 1 - c; it < 512; it += G) small_br(P, l, it, sm);
        return; }
    if (sp == 5) { if (!PHON(6)) return; SchedGate S{XB, (const char*)(P.ws + OFF_W1T) + (size_t)l * 7424 * 2048, G, c}; EpiGate E{(const bf16_t*)(P.ws + OFF_BR), ssq + l * MPAD, (bf16_t*)(P.ws + OFF_ZY)};
        g8::gemm_phase((LAS unsigned char*)smem, 2048, 2048, 1024, S, E);
        for (int it = G - 1 - c; it < 512; it += G) small_gate(P, l, it, sm);
        return; }
    if (PHON(7)) { SchedOut S{ZYc, (const char*)(P.ws + OFF_WOUT) + (size_t)l * 1024 * 2048, G, c};
        if (l == 0) { EpiOut<0> E{P.in[I_XP], P.in[I_XS], (bf16_t*)(P.ws + OFF_XB), P.out, ssq + MPAD}; g8::gemm_phase((LAS unsigned char*)smem, 2048, 2048, 1024, S, E); for (int it = G - 1 - c; it < 256; it += G) small_out<0>(P, l, it, sm); }
        else { EpiOut<1> E{P.in[I_XP], P.in[I_XS], (bf16_t*)(P.ws + OFF_XB), P.out, ssq + 2 * MPAD}; g8::gemm_phase((LAS unsigned char*)smem, 2048, 2048, 1024, S, E); for (int it = G - 1 - c; it < 256; it += G) small_out<1>(P, l, it, sm); }
    }
}

__global__ void __launch_bounds__(512) mega_fwd(Params P, int ph_lo, int ph_hi, int cg_mode) {
    extern __shared__ __attribute__((aligned(16))) unsigned char smem[];
    cg::grid_group grid = cg::this_grid();
    unsigned nbar = 0;
    unsigned* barw = (unsigned*)(P.ws + OFF_BAR);
#define GSYNC() do { if (USE_CG_SYNC || cg_mode) grid.sync(); else grid_bar(barw, ++nbar); } while (0)
    for (int ph = ph_lo; ph < ph_hi; ++ph) {
        if (ph > ph_lo) GSYNC();
        __syncthreads();
        unsigned z; asm volatile("s_mov_b32 %0, 0" : "=s"(z));
        const Params* pp = (const Params*)((const char*)(const __attribute__((address_space(4))) char*)__builtin_amdgcn_kernarg_segment_ptr() + z);
        if (PROBE_SP == 13 && ph >= 1 && ph < NPH - 1 && (ph - 1) % 7 == 2) { if (blockIdx.x < 128) rwkv_scan_prompt(*pp, (ph - 1) / 7, blockIdx.x, (float*)smem); GSYNC(); __syncthreads(); }
        run_phase(*pp, ph, smem);
        if (PROBE_SP >= 0) {
            const int spx = (ph >= 1 && ph < NPH - 1) ? (ph - 1) % 7 : -1;
            if ((PROBE_SP < 7 && spx == PROBE_SP) || (PROBE_SP == 7 && ph == 0)) { GSYNC(); __syncthreads(); run_phase(*pp, ph, smem); }
            if (PROBE_SP == 8 && spx == 2) { GSYNC(); __syncthreads(); if (blockIdx.x < 128) rwkv_scan_prompt(*pp, (ph - 1) / 7, blockIdx.x, (float*)smem); }
            if (PROBE_SP == 9) GSYNC();
            if (PROBE_SP == 14 && spx == 2) { GSYNC(); __syncthreads(); if (blockIdx.x >= 128) for (int it = blockIdx.x - 128; it < 512; it += gridDim.x - 128) swa_prompt<true>(*pp, (ph - 1) / 7, it, (float*)smem); }
            if (PROBE_SP >= 15 && PROBE_SP <= 17 && spx == 2) { GSYNC(); __syncthreads(); const int l_ = (ph - 1) / 7;
                if (PROBE_SP == 15) for (int it = blockIdx.x; it < 1024; it += gridDim.x) gla_out<true>(*pp, l_, it, (float*)smem);
                if (PROBE_SP == 16) for (int it = blockIdx.x; it < 512; it += gridDim.x) lru_final<true>(*pp, l_, it);
                if (PROBE_SP == 17) for (int it = blockIdx.x; it < 1032; it += gridDim.x) rwkv_post<true>(*pp, l_, it); }
            if (PROBE_SP == 18 && spx == 5) { GSYNC(); __syncthreads(); const int l_ = (ph - 1) / 7; const int G = gridDim.x, c = blockIdx.x;
                SchedOut S{(const char*)(pp->ws + OFF_ZY), (const char*)(pp->ws + OFF_WOUT) + (size_t)l_ * 1024 * 2048, G, c}; float* ssq = (float*)(pp->ws + OFF_SSQ);
                if (l_ == 0) { EpiOut<0, false> E{pp->in[I_XP], pp->in[I_XS], (bf16_t*)(pp->ws + OFF_XB), pp->out, ssq + MPAD}; g8::gemm_phase((LAS unsigned char*)smem, 2048, 2048, 1024, S, E); }
                else { EpiOut<1, false> E{pp->in[I_XP], pp->in[I_XS], (bf16_t*)(pp->ws + OFF_XB), pp->out, ssq + 2 * MPAD}; g8::gemm_phase((LAS unsigned char*)smem, 2048, 2048, 1024, S, E); } }
            if (PROBE_SP >= 10 && PROBE_SP <= 12 && spx == 1) { GSYNC(); __syncthreads(); const int l_ = (ph - 1) / 7;
                if (PROBE_SP == 10) for (int it = blockIdx.x; it < 1024; it += gridDim.x) gla_prep(*pp, l_, it, (float*)smem);
                if (PROBE_SP == 11) for (int it = blockIdx.x; it < 512; it += gridDim.x) lru_prep(*pp, l_, it, (float*)smem);
                if (PROBE_SP == 12) for (int it = blockIdx.x; it < 1056; it += gridDim.x) rwkv_prep(*pp, l_, it); }
        }
    }
}

extern "C" void kernel_launch(void* const* d_in, const int* in_sizes, int n_in, void* d_out, int out_size, void* d_ws, size_t ws_size, hipStream_t stream) {
    static int grid = 0;
    if (grid == 0) {
        if (n_in != 35 || (size_t)out_size != O_END || ws_size < WS_END) { fprintf(stderr, "kernel_launch: unexpected shapes n_in %d out %d ws %zu (need %zu)\n", n_in, out_size, ws_size, (size_t)WS_END); grid = -1; return; }
        int dev = 0, cus = 0, per_cu = 0;
        hipGetDevice(&dev); hipDeviceGetAttribute(&cus, hipDeviceAttributeMultiprocessorCount, dev);
        if (hipFuncSetAttribute((const void*)mega_fwd, hipFuncAttributeMaxDynamicSharedMemorySize, LDS_BYTES) != hipSuccess) { fprintf(stderr, "kernel_launch: hipFuncSetAttribute failed\n"); grid = -1; return; }
        if (hipOccupancyMaxActiveBlocksPerMultiprocessor(&per_cu, (const void*)mega_fwd, 512, LDS_BYTES) != hipSuccess || per_cu < 1) { fprintf(stderr, "kernel_launch: occupancy query says %d\n", per_cu); per_cu = 1; }
        (void)hipGetLastError();
        grid = cus;
    }
    if (grid < 0) return;
    Params p{};
    for (int i = 0; i < 35; ++i) p.in[i] = (const float*)d_in[i];
    p.out = (float*)d_out; p.ws = (unsigned char*)d_ws;
#if ONE_LAUNCH
    (void)hipMemsetAsync((char*)d_ws + OFF_BAR, 0, 4096, stream);
    int lo = 0, hi = NPH, cgm = 0;
    void* args[] = {&p, &lo, &hi, &cgm};
    hipError_t e = hipLaunchCooperativeKernel((const void*)mega_fwd, dim3(grid), dim3(512), args, LDS_BYTES, stream);
    if (e != hipSuccess) fprintf(stderr, "cooperative launch failed: %s (grid %d)\n", hipGetErrorString(e), grid);
#else
    for (int ph = 0; ph < NPH; ++ph) hipLaunchKernelGGL(mega_fwd, dim3(grid), dim3(512), LDS_BYTES, stream, p, ph, ph + 1, 0);
#endif
}
```

```cpp
#include <hip/hip_runtime.h>
#include <hip/hip_cooperative_groups.h>
#include <cstdio>
#include <cstdint>
namespace cg = cooperative_groups;

typedef unsigned short bf16_t;
typedef short bf16x8 __attribute__((ext_vector_type(8)));
typedef float f32x4 __attribute__((ext_vector_type(4)));
typedef unsigned u32x4 __attribute__((ext_vector_type(4)));
typedef unsigned u32x2 __attribute__((ext_vector_type(2)));
typedef float f32x2 __attribute__((ext_vector_type(2)));
#define LAS __attribute__((address_space(3)))
#define DEVI __device__ __forceinline__

#ifndef PROBE_SP
#define PROBE_SP -1
#endif
#ifndef USE_CG_SYNC
#define USE_CG_SYNC 0
#endif
#ifndef ONE_LAUNCH
#define ONE_LAUNCH 1
#endif

constexpr int NTOK = 16384, NSAMP = 128, ROWS = 16512, MPAD = 16640, SEQ = 2048;
constexpr int INC = 7248;
constexpr int CA = 0, CB = 832, CC = 1360, CD = 1872, CZ = 2128, CG = 3152;
constexpr int PALD = 2304;
constexpr int NPH = 16;
constexpr int LDS_BYTES = 131072;

constexpr size_t OFF_W1T = 0, SZ_W1T = (size_t)2 * 7424 * 1024 * 2;
constexpr size_t OFF_WBR = OFF_W1T + SZ_W1T, SZ_WBR = (size_t)2 * 4 * 1024 * 256 * 2;
constexpr size_t OFF_WOUT = OFF_WBR + SZ_WBR, SZ_WOUT = (size_t)2 * 1024 * 1024 * 2;
constexpr size_t OFF_XB = OFF_WOUT + SZ_WOUT, SZ_XB = (size_t)MPAD * 1024 * 2;
constexpr size_t OFF_ZY = OFF_XB + SZ_XB;
constexpr size_t OFF_SSQ = OFF_ZY + SZ_XB, SZ_SSQ = (size_t)3 * MPAD * 4;
constexpr size_t OFF_BR = OFF_SSQ + SZ_SSQ, SZ_BR = (size_t)MPAD * 4096 * 2;
constexpr size_t OFF_PA = OFF_BR, SZ_PA = (size_t)MPAD * PALD * 2;
constexpr size_t OFF_RWP = OFF_BR + SZ_PA, SZ_RWP = (size_t)ROWS * 1536 * 2;
constexpr size_t OFF_RWC = OFF_RWP + SZ_RWP, SZ_RWC = (size_t)ROWS * 16 * 4;
constexpr size_t OFF_BAR = OFF_BR + SZ_BR;
constexpr size_t OFF_WLT = OFF_BAR + 4096, SZ_WLT = (size_t)2 * 2 * 4 * 4096 * 2;
constexpr size_t WS_END = OFF_WLT + SZ_WLT;
static_assert(OFF_RWC + SZ_RWC <= WS_END, "ws overlay");

constexpr size_t SO_RWO = 0;
constexpr size_t SO_LH = SO_RWO + (size_t)ROWS * 256;
constexpr size_t SO_LP = SO_LH + (size_t)NTOK * 256;
constexpr size_t SO_GU = SO_LP + (size_t)NTOK * 256;
constexpr size_t SO_GD = SO_GU + (size_t)1024 * 2048;
constexpr size_t SO_LA = SO_GD + (size_t)1024 * 32;
constexpr size_t SO_LB = SO_LA + (size_t)8 * 128 * 256;
static_assert(SO_LB + 8 * 128 * 256 <= (size_t)ROWS * 1024, "out scratch");

constexpr size_t O_Y = 0;
constexpr size_t O_WKVP = (size_t)ROWS * 1024;
constexpr size_t O_WKVS = O_WKVP + 2 * 8 * 4 * 64 * 64;
constexpr size_t O_SHP = O_WKVS + (size_t)2 * 128 * 4 * 64 * 64;
constexpr size_t O_SHS = O_SHP + 2 * 8 * 832;
constexpr size_t O_GLP = O_SHS + 2 * 128 * 832;
constexpr size_t O_GLS = O_GLP + 2 * 8 * 4 * 32 * 64;
constexpr size_t O_KP = O_GLS + 2 * 128 * 4 * 32 * 64;
constexpr size_t O_KS = O_KP + 2 * 8 * 128 * 128;
constexpr size_t O_VP = O_KS + (size_t)2 * 128 * 128 * 128;
constexpr size_t O_VS = O_VP + 2 * 8 * 128 * 128;
constexpr size_t O_CVP = O_VS + (size_t)2 * 128 * 128 * 128;
constexpr size_t O_CVS = O_CVP + 2 * 8 * 3 * 256;
constexpr size_t O_HP = O_CVS + 2 * 128 * 3 * 256;
constexpr size_t O_HS = O_HP + 2 * 8 * 256;
constexpr size_t O_END = O_HS + 2 * 128 * 256;

struct Params {
    const float* in[35];
    float* out;
    unsigned char* ws;
};
enum { I_XP = 0, I_XS, I_SWKV, I_SSHIFT, I_SGLA, I_CK, I_CV, I_SCONV, I_SH, I_NG, I_WIN, I_MU, I_W0, I_WUP, I_A0, I_AUP, I_KK, I_KA, I_RK, I_LNG, I_LNB,
       I_GUP, I_GB, I_GNG, I_SINK, I_CW, I_CBI, I_WA, I_BA, I_WX, I_BX, I_LAM, I_WBR, I_WOUT, I_FNG };

DEVI int tidx() { int t = (int)threadIdx.x; asm volatile("" : "+v"(t)); return t; }
DEVI float bf2f(bf16_t h) { return __uint_as_float(((unsigned)h) << 16); }
DEVI float bflo(unsigned w) { return __uint_as_float(w << 16); }
DEVI float bfhi(unsigned w) { return __uint_as_float(w & 0xffff0000u); }
DEVI unsigned f2bfu(float f) { unsigned u = __float_as_uint(f); return (u + 0x7fffu + ((u >> 16) & 1u)) >> 16; }
DEVI bf16_t f2bf(float f) { return (bf16_t)f2bfu(f); }
DEVI unsigned pk2(float lo, float hi) { return f2bfu(lo) | (f2bfu(hi) << 16); }
template <int CTRL> DEVI float dpp_mov(float v) { return __builtin_bit_cast(float, __builtin_amdgcn_update_dpp(0, __builtin_bit_cast(int, v), CTRL, 0xF, 0xF, true)); }
DEVI float rdlane(float v, int l) { return __builtin_bit_cast(float, __builtin_amdgcn_readlane(__builtin_bit_cast(int, v), l)); }
DEVI float reduce16(float v) { v += dpp_mov<0xB1>(v); v += dpp_mov<0x4E>(v); v += dpp_mov<0x141>(v); v += dpp_mov<0x140>(v); return v; }
DEVI float reduce8(float v) { v += dpp_mov<0xB1>(v); v += dpp_mov<0x4E>(v); v += dpp_mov<0x141>(v); return v; }
DEVI float wave_sum(float v) { v = reduce16(v); return (rdlane(v, 0) + rdlane(v, 16)) + (rdlane(v, 32) + rdlane(v, 48)); }
DEVI float wave_max(float v) { v = fmaxf(v, dpp_mov<0xB1>(v)); v = fmaxf(v, dpp_mov<0x4E>(v)); v = fmaxf(v, dpp_mov<0x141>(v)); v = fmaxf(v, dpp_mov<0x140>(v));
    return fmaxf(fmaxf(rdlane(v, 0), rdlane(v, 16)), fmaxf(rdlane(v, 32), rdlane(v, 48))); }
DEVI float quad_sum(float v) { v += dpp_mov<0xB1>(v); v += dpp_mov<0x4E>(v); return v; }
DEVI float quad_max(float v) { v = fmaxf(v, dpp_mov<0xB1>(v)); v = fmaxf(v, dpp_mov<0x4E>(v)); return v; }
DEVI float frcp(float x) { return __builtin_amdgcn_rcpf(x); }
DEVI float sigm(float x) { return frcp(1.f + __expf(-x)); }
DEVI float silu(float x) { return x * sigm(x); }
DEVI float flog(float x) { return __builtin_amdgcn_logf(x) * 0.6931471806f; }
DEVI float logsig(float x) { return fminf(x, 0.f) - flog(1.f + __expf(-fabsf(x))); }
DEVI float softplus(float x) { return fmaxf(x, 0.f) + flog(1.f + __expf(-fabsf(x))); }
DEVI float logsig_acc(float x) { return fminf(x, 0.f) - log1pf(expf(-fabsf(x))); }
DEVI float ftanh(float x) { const float e = __expf(-2.f * fabsf(x)); const float t = (1.f - e) * frcp(1.f + e); return x < 0.f ? -t : t; }
#define LDS_WAIT() asm volatile("s_waitcnt lgkmcnt(0)" ::: "memory")

DEVI int natcol(int p) { return (p & ~31) | (((p >> 2) & 3) << 3) | (((p >> 4) & 1) << 2) | (p & 3); }
DEVI int w1_src(int n) {
    const int pn = n >> 8, p = n & 255;
    if (pn < 9) { const int c = 256 * pn + natcol(p); return c < CZ ? c : -1; }
    if (pn < 13) return CZ + 256 * (pn - 9) + natcol(p);
    const int q = pn - 13, bj = p >> 7, wc = (p >> 5) & 3, n_ = (p >> 4) & 1, r16 = p & 15;
    return CG + (2 * bj + n_) * 1024 + 64 * q + 16 * wc + r16;
}

namespace g8 {
constexpr int BM = 256, BK = 64, HALF = 128, HTB = HALF * BK * 2;
DEVI int lds_byte(int r, int c) { const int st = (r >> 4) * 2 + (c >> 5), rr = r & 15, cc = c & 31, ob = rr * 64 + cc * 2; return st * 1024 + (ob ^ (((ob >> 9) & 1) << 5)); }
DEVI void stage_rc(int b, int& R, int& C) { const int st = b / 1024, sb = b % 1024, swz = sb ^ (((sb >> 9) & 1) << 5); R = (st >> 1) * 16 + swz / 64; C = (st & 1) * 32 + (swz % 64) / 2; }
struct Unit { const char* a; const char* b; int pm, pn; };
DEVI void tile_of(int L, int nM, int nN, int& pm, int& pn) {
    const int nwg = nM * nN; int wgid = L;
    { const int q = nwg / 8, r = nwg % 8, xcd = wgid % 8, off = wgid / 8; wgid = (xcd < r ? xcd * (q + 1) : r * (q + 1) + (xcd - r) * q) + off; }
    const int nig = 8 * nN, gid = wgid / nig, fm = gid * 8, gsz = (nM - fm) < 8 ? (nM - fm) : 8;
    pm = fm + ((wgid % nig) % gsz); pn = (wgid % nig) / gsz;
}

template <class Sched, class Epi>
DEVI void gemm_phase(LAS unsigned char* lds, const int lda, const int ldb, const int K, const Sched& S, const Epi& E) {
    const int tid = tidx(), wid = __builtin_amdgcn_readfirstlane(tid >> 6), lane = tid & 63, wr = wid >> 2, wc = wid & 3, fr = lane & 15, fq = lane >> 4;
    const int nt = K / BK;
    unsigned voffA[2], voffB[2];
#pragma unroll
    for (int i = 0; i < 2; ++i) { int R, C; stage_rc(tid * 16 + i * 8192, R, C); voffA[i] = (unsigned)(R * lda + C * 2); voffB[i] = (unsigned)(R * ldb + C * 2); }
    const size_t kstep = (size_t)(BK * 2);
    const size_t hstepA = (size_t)HALF * lda, hstepB = (size_t)HALF * ldb;
    const unsigned ldsw = (unsigned)wid * 1024u;
    const int aoff = lds_byte(wr * 64 + fr, fq * 8), boff = lds_byte(wc * 32 + fr, fq * 8);
#define G8_SA(b, h) (((b) * 2 + (h)) * HTB)
#define G8_SB(b, h) ((4 + (b) * 2 + (h)) * HTB)
#define G8_STAGE(bufoff, gbase, voff) do { _Pragma("unroll") for (int _i = 0; _i < 2; ++_i) \
        __builtin_amdgcn_global_load_lds((const unsigned*)((const char*)(gbase) + (voff)[_i]), (LAS unsigned*)(lds + (bufoff) + ldsw + _i * 8192), 16, 0, 0); } while (0)
#define G8_LDA(dst, b, h) do { _Pragma("unroll") for (int m = 0; m < 4; ++m) _Pragma("unroll") for (int k = 0; k < 2; ++k) dst[m][k] = *(const LAS bf16x8*)(lds + G8_SA(b, h) + aoff + m * 2048 + k * 1024); } while (0)
#define G8_LDB(dst, b, h) do { _Pragma("unroll") for (int n = 0; n < 2; ++n) _Pragma("unroll") for (int k = 0; k < 2; ++k) dst[n][k] = *(const LAS bf16x8*)(lds + G8_SB(b, h) + boff + n * 2048 + k * 1024); } while (0)
#define G8_MMA(ai, bj, At, Bt) do { __builtin_amdgcn_s_setprio(1); _Pragma("unroll") for (int m = 0; m < 4; ++m) _Pragma("unroll") for (int n = 0; n < 2; ++n) _Pragma("unroll") for (int k = 0; k < 2; ++k) \
        acc[ai][bj][m][n] = __builtin_amdgcn_mfma_f32_16x16x32_bf16(Bt[n][k], At[m][k], acc[ai][bj][m][n], 0, 0, 0); __builtin_amdgcn_s_setprio(0); } while (0)
#define G8_WAIT_V(n) asm volatile("s_waitcnt vmcnt(" #n ")" ::: "memory")
#define G8_WAIT_L(n) asm volatile("s_waitcnt lgkmcnt(" #n ")" ::: "memory")
#define G8_BAR __builtin_amdgcn_s_barrier()
#define G8_SCHED __builtin_amdgcn_sched_barrier(0)
    Unit cur, nxt; int ui = 0;
    if (!S.next(0, cur)) return;
    f32x4 acc[2][2][4][2];
#pragma unroll
    for (int a = 0; a < 2; ++a)
#pragma unroll
        for (int b = 0; b < 2; ++b)
#pragma unroll
            for (int m = 0; m < 4; ++m)
#pragma unroll
                for (int n = 0; n < 2; ++n) acc[a][b][m][n] = (f32x4){0.f, 0.f, 0.f, 0.f};
    bf16x8 At[4][2], B0[2][2], B1[2][2];
    const char* cA = cur.a; const char* cB = cur.b;
    G8_STAGE(G8_SB(0, 0), cB, voffB); G8_STAGE(G8_SA(0, 0), cA, voffA); G8_STAGE(G8_SB(0, 1), cB + hstepB, voffB); G8_STAGE(G8_SA(0, 1), cA + hstepA, voffA);
    if (wr == 1) G8_BAR;
    G8_WAIT_V(4); G8_BAR;
    G8_STAGE(G8_SB(1, 0), cB + kstep, voffB); G8_STAGE(G8_SA(1, 0), cA + kstep, voffA); G8_STAGE(G8_SB(1, 1), cB + hstepB + kstep, voffB);
    G8_WAIT_V(6); G8_BAR;
    for (;;) {
        const bool has_next = S.next(ui + 1, nxt);
        const char* nA = has_next ? nxt.a : cA; const char* nB = has_next ? nxt.b : cB;
        const bool full = cur.pm != 64;
#pragma nounroll
        for (int t = 0; t < nt; t += 2) {
            const bool last = (t == nt - 2);
            const char* a1 = cA + (size_t)(t + 1) * kstep;
            const char* a2 = last ? nA : cA + (size_t)(t + 2) * kstep; const char* b2 = last ? nB : cB + (size_t)(t + 2) * kstep;
            const char* a3 = a2 + kstep; const char* b3 = b2 + kstep;
            G8_LDB(B0, 0, 0); G8_SCHED; G8_LDA(At, 0, 0); G8_STAGE(G8_SA(1, 1), a1 + hstepA, voffA);
            G8_WAIT_L(8); G8_BAR; G8_WAIT_L(0); G8_MMA(0, 0, At, B0); G8_BAR; G8_SCHED;
            G8_LDB(B1, 0, 1); G8_STAGE(G8_SB(0, 0), b2, voffB);
            G8_BAR; G8_WAIT_L(0); G8_MMA(0, 1, At, B1); G8_BAR;
            G8_LDA(At, 0, 1); G8_STAGE(G8_SA(0, 0), a2, voffA);
            G8_BAR; G8_WAIT_L(0); G8_MMA(1, 0, At, B0); G8_BAR; G8_SCHED;
            G8_STAGE(G8_SB(0, 1), b2 + hstepB, voffB);
            G8_WAIT_V(6); G8_BAR; G8_MMA(1, 1, At, B1); G8_BAR;
            G8_LDB(B0, 1, 0); G8_SCHED; G8_LDA(At, 1, 0); G8_STAGE(G8_SA(0, 1), a2 + hstepA, voffA);
            G8_WAIT_L(8); G8_BAR; G8_WAIT_L(0); G8_MMA(0, 0, At, B0); G8_BAR; G8_SCHED;
            G8_LDB(B1, 1, 1); G8_STAGE(G8_SB(1, 0), b3, voffB);
            G8_BAR; G8_WAIT_L(0); G8_MMA(0, 1, At, B1); G8_BAR;
            G8_LDA(At, 1, 1); G8_STAGE(G8_SA(1, 0), a3, voffA);
            G8_BAR; G8_WAIT_L(0); G8_MMA(1, 0, At, B0); G8_BAR; G8_SCHED;
            G8_STAGE(G8_SB(1, 1), b3 + hstepB, voffB);
            G8_WAIT_V(6); G8_BAR; G8_MMA(1, 1, At, B1); G8_BAR;
        }
        E(acc, cur, wr, wc, fr, fq);
        if (!has_next) break;
#pragma unroll
        for (int a = 0; a < 2; ++a)
#pragma unroll
            for (int b = 0; b < 2; ++b)
#pragma unroll
                for (int m = 0; m < 4; ++m)
#pragma unroll
                    for (int n = 0; n < 2; ++n) acc[a][b][m][n] = (f32x4){0.f, 0.f, 0.f, 0.f};
        cur = nxt; cA = nA; cB = nB; ++ui;
    }
    G8_WAIT_V(0);
    if (wr == 0) G8_BAR;
    G8_BAR;
}
}
using g8::Unit;
typedef f32x4 AccT[2][2][4][2];

struct SchedG1 { const char* A; const char* B; int G, c;
    DEVI bool next(int i, Unit& u) const { const int L = i * G + c; if (L >= 65 * 13) return false; g8::tile_of(L, 65, 13, u.pm, u.pn);
        u.a = A + (size_t)u.pm * 256 * 2048; u.b = B + (size_t)u.pn * 256 * 2048; return true; } };
struct SchedBr { const char* A; const char* B; int G, c;
    DEVI bool next(int i, Unit& u) const { const int L = i * G + c; if (L >= 64 * 16) return false; g8::tile_of(L, 64, 16, u.pm, u.pn);
        const int b = u.pn >> 2, p4 = u.pn & 3; u.a = A + (size_t)u.pm * 256 * 2048 + b * 512; u.b = B + (size_t)b * (1024 * 512) + (size_t)p4 * 256 * 512; return true; } };
struct SchedGate { const char* A; const char* B; int G, c;
    DEVI bool next(int i, Unit& u) const { const int L = i * G + c; if (L >= 64 * 16) return false; g8::tile_of(L, 64, 16, u.pm, u.pn);
        u.a = A + (size_t)u.pm * 256 * 2048; u.b = B + (size_t)(3328 + 256 * u.pn) * 2048; return true; } };
struct SchedOut { const char* A; const char* B; int G, c;
    DEVI bool next(int i, Unit& u) const { const int L = i * G + c; if (L >= 64 * 4) return false; g8::tile_of(L, 64, 4, u.pm, u.pn);
        u.a = A + (size_t)u.pm * 256 * 2048; u.b = B + (size_t)u.pn * 256 * 2048; return true; } };

struct EpiG1 { bf16_t* PA; bf16_t* ZY; const float* ssq;
    DEVI void operator()(const AccT& acc, const Unit& u, int wr, int wc, int fr, int fq) const {
        bf16_t* base; int ld, pnl; if (u.pn < 9) { base = PA; ld = PALD; pnl = u.pn; } else { base = ZY; ld = 1024; pnl = u.pn - 9; }
        float sq[2][4];
#pragma unroll
        for (int ai = 0; ai < 2; ++ai)
#pragma unroll
            for (int m = 0; m < 4; ++m) sq[ai][m] = ssq[256 * u.pm + 128 * ai + 64 * wr + 16 * m + fr];
#pragma unroll
        for (int ai = 0; ai < 2; ++ai)
#pragma unroll
            for (int m = 0; m < 4; ++m) {
                const int r = 256 * u.pm + 128 * ai + 64 * wr + 16 * m + fr;
                const float rs = rsqrtf(sq[ai][m] * (1.f / 1024.f) + 1e-6f);
                bf16_t* rowp = base + (size_t)r * ld + 256 * pnl + 32 * wc + 8 * fq;
#pragma unroll
                for (int bj = 0; bj < 2; ++bj) { const f32x4 v0 = acc[ai][bj][m][0] * rs, v1 = acc[ai][bj][m][1] * rs;
                    u32x4 w; w.x = pk2(v0[0], v0[1]); w.y = pk2(v0[2], v0[3]); w.z = pk2(v1[0], v1[1]); w.w = pk2(v1[2], v1[3]);
                    *(u32x4*)(rowp + 128 * bj) = w; }
            }
    } };
struct EpiBr { bf16_t* BR;
    DEVI void operator()(const AccT& acc, const Unit& u, int wr, int wc, int fr, int fq) const {
        const int b = u.pn >> 2, p4 = u.pn & 3;
#pragma unroll
        for (int ai = 0; ai < 2; ++ai)
#pragma unroll
            for (int m = 0; m < 4; ++m) {
                const int r = 256 * u.pm + 128 * ai + 64 * wr + 16 * m + fr;
                bf16_t* rowp = BR + (size_t)r * 4096 + b * 1024 + 256 * p4 + 32 * wc + 8 * fq;
#pragma unroll
                for (int bj = 0; bj < 2; ++bj) { const f32x4 v0 = acc[ai][bj][m][0], v1 = acc[ai][bj][m][1];
                    u32x4 w; w.x = pk2(v0[0], v0[1]); w.y = pk2(v0[2], v0[3]); w.z = pk2(v1[0], v1[1]); w.w = pk2(v1[2], v1[3]);
                    *(u32x4*)(rowp + 128 * bj) = w; }
            }
    } };
struct EpiGate { const bf16_t* BR; const float* ssq; bf16_t* ZY;
    DEVI void operator()(const AccT& acc, const Unit& u, int wr, int wc, int fr, int fq) const {
        const int c = 64 * u.pn + 16 * wc + 4 * fq;
#pragma unroll
        for (int ai = 0; ai < 2; ++ai) {
            float sq[4]; u32x2 w[4][4];
#pragma unroll
            for (int m = 0; m < 4; ++m) { const int r = 256 * u.pm + 128 * ai + 64 * wr + 16 * m + fr; sq[m] = ssq[r]; const bf16_t* brr = BR + (size_t)r * 4096 + c;
#pragma unroll
                for (int b = 0; b < 4; ++b) w[m][b] = *(const u32x2*)(brr + b * 1024); }
#pragma unroll
            for (int m = 0; m < 4; ++m) {
                const int r = 256 * u.pm + 128 * ai + 64 * wr + 16 * m + fr;
                const float rs = rsqrtf(sq[m] * (1.f / 1024.f) + 1e-6f);
                float o0 = 0.f, o1 = 0.f, o2 = 0.f, o3 = 0.f;
#pragma unroll
                for (int bj = 0; bj < 2; ++bj)
#pragma unroll
                    for (int n = 0; n < 2; ++n) { const u32x2 ww = w[m][2 * bj + n]; const f32x4 g = acc[ai][bj][m][n];
                        o0 += sigm(g[0] * rs) * bflo(ww.x); o1 += sigm(g[1] * rs) * bfhi(ww.x); o2 += sigm(g[2] * rs) * bflo(ww.y); o3 += sigm(g[3] * rs) * bfhi(ww.y); }
                u32x2 o; o.x = pk2(o0, o1); o.y = pk2(o2, o3);
                *(u32x2*)(ZY + (size_t)r * 1024 + c) = o;
            }
        }
    } };
template <int LAYER, bool ATOM = true> struct EpiOut { const float* xp; const float* xs; bf16_t* XB; float* yout; float* ssq;
    DEVI void operator()(const AccT& acc, const Unit& u, int wr, int wc, int fr, int fq) const {
        const int col0 = 256 * u.pn + 32 * wc + 8 * fq;
#pragma unroll
        for (int ai = 0; ai < 2; ++ai) {
            if (256 * u.pm + 128 * ai >= ROWS) continue;
            f32x4 rf[4][2][2]; u32x4 rb[4][2];
#pragma unroll
            for (int m = 0; m < 4; ++m) { const int r = 256 * u.pm + 128 * ai + 64 * wr + 16 * m + fr;
#pragma unroll
                for (int bj = 0; bj < 2; ++bj) { const int col = col0 + 128 * bj;
                    if (LAYER == 0) { const float* xr = (r < NTOK ? xp + (size_t)r * 1024 : xs + (size_t)(r - NTOK) * 1024) + col; rf[m][bj][0] = *(const f32x4*)xr; rf[m][bj][1] = *(const f32x4*)(xr + 4); }
                    else rb[m][bj] = *(const u32x4*)(XB + (size_t)r * 1024 + col); } }
            float part[4];
#pragma unroll
            for (int m = 0; m < 4; ++m) {
                const int r = 256 * u.pm + 128 * ai + 64 * wr + 16 * m + fr;
                float ps = 0.f;
#pragma unroll
                for (int bj = 0; bj < 2; ++bj) { const int col = col0 + 128 * bj; f32x4 v0 = acc[ai][bj][m][0], v1 = acc[ai][bj][m][1];
                    if (LAYER == 0) { v0 += rf[m][bj][0]; v1 += rf[m][bj][1];
                        u32x4 w; w.x = pk2(v0[0], v0[1]); w.y = pk2(v0[2], v0[3]); w.z = pk2(v1[0], v1[1]); w.w = pk2(v1[2], v1[3]);
                        *(u32x4*)(XB + (size_t)r * 1024 + col) = w;
                    } else { const u32x4 w = rb[m][bj];
                        v0[0] += bflo(w.x); v0[1] += bfhi(w.x); v0[2] += bflo(w.y); v0[3] += bfhi(w.y); v1[0] += bflo(w.z); v1[1] += bfhi(w.z); v1[2] += bflo(w.w); v1[3] += bfhi(w.w);
                        *(f32x4*)(yout + (size_t)r * 1024 + col) = v0; *(f32x4*)(yout + (size_t)r * 1024 + col + 4) = v1; }
                    ps += v0[0] * v0[0] + v0[1] * v0[1] + v0[2] * v0[2] + v0[3] * v0[3] + v1[0] * v1[0] + v1[1] * v1[1] + v1[2] * v1[2] + v1[3] * v1[3]; }
                part[m] = ps;
            }
#pragma unroll
            for (int m = 0; m < 4; ++m) { const int r = 256 * u.pm + 128 * ai + 64 * wr + 16 * m + fr; float p = part[m]; p += __shfl_xor(p, 16); p += __shfl_xor(p, 32); if (ATOM && fq == 0) atomicAdd(ssq + r, p); }
        }
    } };

DEVI void transpose_item(const float* W, int ldw, const float* gain, int kind, bf16_t* WT, int K, int n0, int k0, float* scr, int lane) {
    const int nl = lane & 31, n = n0 + nl;
    const int sc = (kind == 0) ? w1_src(n) : ((n & ~255) + natcol(n & 255));
    float tw[32], tg[32];
#pragma unroll
    for (int i = 0; i < 32; ++i) { const int kk = 2 * i + (lane >> 5); tw[i] = (sc >= 0) ? W[(size_t)(k0 + kk) * ldw + sc] : 0.f; tg[i] = gain ? gain[k0 + kk] : 1.f; }
#pragma unroll
    for (int i = 0; i < 32; ++i) { const int kk = 2 * i + (lane >> 5); scr[kk * 33 + nl] = tw[i] * tg[i]; }
    LDS_WAIT();
    const int c = lane & 7;
#pragma unroll
    for (int j = 0; j < 4; ++j) { const int nn = (lane >> 3) + 8 * j; const float* s = scr + (8 * c) * 33 + nn;
        u32x4 o; o.x = pk2(s[0], s[33]); o.y = pk2(s[66], s[99]); o.z = pk2(s[132], s[165]); o.w = pk2(s[198], s[231]);
        *(u32x4*)(WT + (size_t)(n0 + nn) * K + k0 + 8 * c) = o; }
    LDS_WAIT();
}
DEVI void weight_items(const Params& P, unsigned char* smem, int it0, int it1, int gw, int NGW) {
    const int tid = tidx(), wave = tid >> 6, lane = tid & 63;
    float* scr = (float*)(smem + wave * 16384);
    bf16_t* W1T = (bf16_t*)(P.ws + OFF_W1T); bf16_t* WBR = (bf16_t*)(P.ws + OFF_WBR); bf16_t* WOUT = (bf16_t*)(P.ws + OFF_WOUT);
    constexpr int I1 = 2 * 232 * 16, I2 = 8 * 32 * 4;
    for (int it = it0 + gw; it < it1; it += NGW) {
        int r = it;
        if (r < I1) { const int l = r / 3712, q = r % 3712, nb = q >> 4, kb = q & 15;
            transpose_item(P.in[I_WIN] + (size_t)l * 1024 * INC, INC, P.in[I_NG] + l * 1024, 0, W1T + (size_t)l * 7424 * 1024, 1024, nb * 32, kb * 64, scr, lane); continue; }
        r -= I1;
        if (r < I2) { const int lb = r >> 7, q = r & 127, nb = q >> 2, kb = q & 3;
            transpose_item(P.in[I_WBR] + (size_t)lb * 256 * 1024, 1024, nullptr, 1, WBR + (size_t)lb * 1024 * 256, 256, nb * 32, kb * 64, scr, lane); continue; }
        r -= I2;
        { const int l = r >> 9, q = r & 511, nb = q >> 4, kb = q & 15;
            transpose_item(P.in[I_WOUT] + (size_t)l * 1024 * 1024, 1024, nullptr, 2, WOUT + (size_t)l * 1024 * 1024, 1024, nb * 32, kb * 64, scr, lane); }
    }
}
constexpr int WI_EARLY = 104 * 16, WI_ALL = 2 * 232 * 16 + 8 * 32 * 4 + 2 * 32 * 16;
DEVI void phase_p0(const Params& P, unsigned char* smem) {
    const int tid = tidx(), wave = tid >> 6, lane = tid & 63;
    const int gw = blockIdx.x * 8 + wave, NGW = gridDim.x * 8;
    weight_items(P, smem, 0, WI_ALL, gw, NGW);
    { bf16_t* WLT = (bf16_t*)(P.ws + OFF_WLT);
      for (int i = blockIdx.x * 512 + tid; i < 65536; i += gridDim.x * 512) { const int l = i >> 15, g = (i >> 14) & 1, n = (i >> 12) & 3, dd = (i >> 6) & 63, cc = i & 63;
          WLT[i] = f2bf(P.in[g ? I_WX : I_WA][((l * 4 + n) * 64 + cc) * 64 + dd]); } }
    bf16_t* XB = (bf16_t*)(P.ws + OFF_XB); float* ssq = (float*)(P.ws + OFF_SSQ);
    for (int row = gw; row < MPAD; row += NGW) {
        f32x4 v[4]; float s = 0.f;
        if (row < ROWS) { const f32x4* xr = (const f32x4*)(row < NTOK ? P.in[I_XP] + (size_t)row * 1024 : P.in[I_XS] + (size_t)(row - NTOK) * 1024) + lane;
#pragma unroll
            for (int j = 0; j < 4; ++j) { v[j] = xr[64 * j]; s += v[j][0] * v[j][0] + v[j][1] * v[j][1] + v[j][2] * v[j][2] + v[j][3] * v[j][3]; }
        } else {
#pragma unroll
            for (int j = 0; j < 4; ++j) v[j] = (f32x4){0.f, 0.f, 0.f, 0.f};
        }
        s = wave_sum(s);
        u32x2* o = (u32x2*)(XB + (size_t)row * 1024) + lane;
#pragma unroll
        for (int j = 0; j < 4; ++j) { u32x2 w; w.x = pk2(v[j][0], v[j][1]); w.y = pk2(v[j][2], v[j][3]); o[64 * j] = w; }
        if (lane == 0) { ssq[row] = s; ssq[MPAD + row] = 0.f; ssq[2 * MPAD + row] = 0.f; }
    }
}

DEVI void rwkv_prep(const Params& P, int l, int item) {
    const int tid = tidx(), wave = tid >> 6, lane = tid & 63, slot = wave >> 2, h = wave & 3, c = h * 64 + lane;
    const bf16_t* PA = (const bf16_t*)(P.ws + OFF_PA); bf16_t* RWP = (bf16_t*)(P.ws + OFF_RWP); float* RWC = (float*)(P.ws + OFF_RWC);
    const bool samp = item >= 1024; const int row0 = samp ? NTOK + (item - 1024) * 4 : item * 16, nit = samp ? 2 : 8;
    const float* mu = P.in[I_MU] + l * 832;
    float wup[32], aup[32];
#pragma unroll
    for (int j = 0; j < 32; ++j) { wup[j] = P.in[I_WUP][(l * 32 + j) * 256 + c]; aup[j] = P.in[I_AUP][(l * 32 + j) * 256 + c]; }
    const float w0 = P.in[I_W0][l * 256 + c], a0 = P.in[I_A0][l * 256 + c], kkw = P.in[I_KK][l * 256 + c], kaw = P.in[I_KA][l * 256 + c], rkw = P.in[I_RK][l * 256 + c];
    const float mur = mu[c], muk = mu[256 + c], muv = mu[512 + c], mul = mu[768 + lane];
    float aur[8], auk[8], auv[8], aul[8], apr[8], apk[8], apv[8], apl[8];
#pragma unroll
    for (int it = 0; it < 8; ++it) { const int row = row0 + 2 * (it < nit ? it : 0) + slot; const bf16_t* up = PA + (size_t)row * PALD;
        if (samp) { const float* sp = P.in[I_SSHIFT] + (size_t)(l * 128 + (row - NTOK)) * 832; apr[it] = sp[c]; apk[it] = sp[256 + c]; apv[it] = sp[512 + c]; apl[it] = sp[768 + lane]; }
        else if ((row & 2047) == 0) { apr[it] = apk[it] = apv[it] = apl[it] = 0.f; }
        else { const bf16_t* pp = up - PALD; apr[it] = bf2f(pp[c]); apk[it] = bf2f(pp[256 + c]); apv[it] = bf2f(pp[512 + c]); apl[it] = bf2f(pp[768 + lane]); }
        aur[it] = bf2f(up[c]); auk[it] = bf2f(up[256 + c]); auv[it] = bf2f(up[512 + c]); aul[it] = bf2f(up[768 + lane]); }
#pragma unroll
    for (int it = 0; it < 8; ++it) {
        if (it >= nit) break;
        const int row = row0 + 2 * it + slot;
        const float ur = aur[it], uk = auk[it], uv = auv[it], ul = aul[it], pr = apr[it], pk = apk[it], pv = apv[it], pl = apl[it];
        const float r = ur + (pr - ur) * mur, k = uk + (pk - uk) * muk, v = uv + (pv - uv) * muv;
        float lo = ul + (pl - ul) * mul;
        const float lt = lane < 32 ? ftanh(lo) : lo;
        float wpre = w0, apre = a0;
#pragma unroll
        for (int j = 0; j < 32; ++j) { wpre += rdlane(lt, j) * wup[j]; apre += rdlane(lt, 32 + j) * aup[j]; }
        const float w = -softplus(-wpre) - 0.5f, lw = __expf(w);
        const float a = sigm(apre);
        const float kkr = k * kkw; const float kk = kkr * __builtin_amdgcn_rsqf(fmaxf(wave_sum(kkr * kkr), 1e-24f));
        const float kp = k * (1.f + (a - 1.f) * kaw), ka = kk * a;
        const float kaq = bf2f(f2bf(ka)), kpq = bf2f(f2bf(kp)), rq = bf2f(f2bf(r));
        const float c1 = wave_sum(kaq * rq), c2 = wave_sum(kpq * rq), c3 = wave_sum(r * kp * rkw);
        bf16_t* o = RWP + (size_t)row * 1536 + c;
        o[0] = f2bf(lw); o[256] = f2bf(kk); o[512] = f2bf(ka); o[768] = f2bf(kp); o[1024] = f2bf(r); o[1280] = f2bf(v);
        if (lane == 0) { float* cc = RWC + (size_t)row * 16 + h * 4; cc[0] = c1; cc[1] = c2; cc[2] = c3; }
    }
    if (samp) { for (int i = tid; i < 4 * 832; i += 512) { const int rr = i / 832, cc = i % 832; const int b = row0 - NTOK + rr; P.out[O_SHS + (size_t)(l * 128 + b) * 832 + cc] = bf2f(PA[(size_t)(row0 + rr) * PALD + cc]); } }
    else if (((row0 + 16) & 2047) == 0) { const int b = row0 >> 11; for (int i = tid; i < 832; i += 512) P.out[O_SHP + (size_t)(l * 8 + b) * 832 + i] = bf2f(PA[(size_t)(row0 + 15) * PALD + i]); }
}
DEVI void cache_copy(const Params& P, int l, int b) {
    const bf16_t* PA = (const bf16_t*)(P.ws + OFF_PA);
    for (int i = tidx(); i < 128 * 128; i += 512) { const int j = i >> 7, c = i & 127; const bf16_t* rp = PA + (size_t)(b * 2048 + 1920 + j) * PALD + CC + 256 + c;
        P.out[O_KP + (size_t)((l * 8 + b) * 128 + j) * 128 + c] = bf2f(rp[0]); P.out[O_VP + (size_t)((l * 8 + b) * 128 + j) * 128 + c] = bf2f(rp[128]); }
}
DEVI void lru_prep(const Params& P, int l, int item, float* sm) {
    const int tid = tidx(), b = item >> 6, ck = item & 63, t0 = ck * 32;
    const bf16_t* PA = (const bf16_t*)(P.ws + OFF_PA);
    float* xs = sm; float* xc = sm + 35 * 256;
    __syncthreads();
    { bf16_t tx[18];
#pragma unroll
      for (int k = 0; k < 18; ++k) { const int i = tid + 512 * k, tt = i >> 8, ch = i & 255, tk = t0 - 3 + tt; tx[k] = (i < 35 * 256 && tk >= 0) ? PA[(size_t)(b * 2048 + tk) * PALD + CD + ch] : (bf16_t)0; }
#pragma unroll
      for (int k = 0; k < 18; ++k) { const int i = tid + 512 * k; if (i < 35 * 256) xs[i] = bf2f(tx[k]); } }
    __syncthreads();
    const int d = tid & 255, half = tid >> 8;
    { const float cb = P.in[I_CBI][l * 256 + d], c0 = P.in[I_CW][(l * 4 + 0) * 256 + d], c1 = P.in[I_CW][(l * 4 + 1) * 256 + d], c2 = P.in[I_CW][(l * 4 + 2) * 256 + d], c3 = P.in[I_CW][(l * 4 + 3) * 256 + d];
        for (int t = half; t < 32; t += 2) xc[t * 256 + d] = cb + c0 * xs[t * 256 + d] + c1 * xs[(t + 1) * 256 + d] + c2 * xs[(t + 2) * 256 + d] + c3 * xs[(t + 3) * 256 + d]; }
    __syncthreads();
    const int n = d >> 6, dl = d & 63;
    if (ck == 63) for (int i = tid; i < 768; i += 512) P.out[O_CVP + (size_t)(l * 8 + b) * 768 + i] = xs[32 * 256 + i];
    __syncthreads();
    {
        const int wave = tid >> 6, lane = tid & 63, wn = wave & 3, gate = wave >> 2, lr = lane & 15, lq = lane >> 4;
        float* gp = gate ? (sm + 67 * 256) : xs;
        const bf16_t* WL = (const bf16_t*)(P.ws + OFF_WLT) + (size_t)((l * 2 + gate) * 4 + wn) * 4096;
        bf16x8 bfr[4][2]; float bsv[4];
#pragma unroll
        for (int dt = 0; dt < 4; ++dt) { bsv[dt] = P.in[gate ? I_BX : I_BA][l * 256 + 64 * wn + 16 * dt + lr];
#pragma unroll
            for (int ks2 = 0; ks2 < 2; ++ks2) bfr[dt][ks2] = *(const bf16x8*)(WL + (16 * dt + lr) * 64 + 32 * ks2 + 8 * lq); }
#pragma unroll
        for (int tt = 0; tt < 2; ++tt) {
            bf16x8 afr[2];
#pragma unroll
            for (int ks2 = 0; ks2 < 2; ++ks2) { const float* xr = xc + (16 * tt + lr) * 256 + 64 * wn + 32 * ks2 + 8 * lq; const f32x4 x0 = *(const f32x4*)xr, x1 = *(const f32x4*)(xr + 4);
                u32x4 pk; pk.x = pk2(x0[0], x0[1]); pk.y = pk2(x0[2], x0[3]); pk.z = pk2(x1[0], x1[1]); pk.w = pk2(x1[2], x1[3]); afr[ks2] = __builtin_bit_cast(bf16x8, pk); }
#pragma unroll
            for (int dt = 0; dt < 4; ++dt) { f32x4 acc = {0.f, 0.f, 0.f, 0.f};
                acc = __builtin_amdgcn_mfma_f32_16x16x32_bf16(afr[0], bfr[dt][0], acc, 0, 0, 0); acc = __builtin_amdgcn_mfma_f32_16x16x32_bf16(afr[1], bfr[dt][1], acc, 0, 0, 0);
#pragma unroll
                for (int g = 0; g < 4; ++g) gp[(16 * tt + 4 * lq + g) * 256 + 64 * wn + 16 * dt + lr] = acc[g] + bsv[dt]; }
        }
    }
    __syncthreads();
    const float lsl = 8.f * logsig_acc(P.in[I_LAM][l * 256 + d]);
    float* LH = P.out + SO_LH; float* LP = P.out + SO_LP; float* LA = P.out + SO_LA; float* LB = P.out + SO_LB;
    const float* gr = xs; const float* gi = sm + 67 * 256;
    float hh = 0.f, pp = 1.f;
#pragma nounroll
    for (int tt = 0; tt < 16; ++tt) {
        const int t = half * 16 + tt;
        const float la = lsl * sigm(gr[t * 256 + d]), a = __expf(la), bt = __builtin_amdgcn_sqrtf(fmaxf(1.f - a * a, 0.f)) * sigm(gi[t * 256 + d]) * xc[t * 256 + d];
        hh = a * hh + bt; pp *= a;
        const size_t row = (size_t)b * 2048 + t0 + t; LH[row * 256 + d] = hh; LP[row * 256 + d] = pp;
    }
    const int sub = ck * 2 + half; LA[(size_t)(b * 128 + sub) * 256 + d] = pp; LB[(size_t)(b * 128 + sub) * 256 + d] = hh;
}
DEVI void gla_load_cum(const Params& P, int l, int h, int row0, float* gs, float* gl, float* seg) {
    const int tid = tidx(); const bf16_t* PA = (const bf16_t*)(P.ws + OFF_PA);
    { bf16_t t0 = PA[(size_t)(row0 + (tid >> 4)) * PALD + CB + 512 + (tid & 15)], t1 = PA[(size_t)(row0 + 32 + (tid >> 4)) * PALD + CB + 512 + (tid & 15)]; gl[tid] = bf2f(t0); gl[tid + 512] = bf2f(t1); }
    __syncthreads();
    const int d = tid & 31, sg = tid >> 5;
    float upc[16];
#pragma unroll
    for (int j = 0; j < 16; ++j) upc[j] = P.in[I_GUP][(l * 16 + j) * 128 + h * 32 + d];
    const float bias = P.in[I_GB][l * 128 + h * 32 + d];
    float run = 0.f, gv[4];
#pragma unroll
    for (int tt = 0; tt < 4; ++tt) { const int t = sg * 4 + tt; float x = bias;
#pragma unroll
        for (int j = 0; j < 16; ++j) x += gl[t * 16 + j] * upc[j];
        run += logsig(x) * (1.f / 16.f); gv[tt] = run; }
    seg[sg * 32 + d] = run;
    __syncthreads();
    float pre = 0.f; for (int s2 = 0; s2 < sg; ++s2) pre += seg[s2 * 32 + d];
#pragma unroll
    for (int tt = 0; tt < 4; ++tt) gs[(sg * 4 + tt) * 32 + d] = gv[tt] + pre;
    __syncthreads();
}
DEVI void gla_prep(const Params& P, int l, int item, float* sm) {
    const int tid = tidx(), c = item & 31, h = (item >> 5) & 3, b = item >> 7, row0 = b * 2048 + c * 64;
    const bf16_t* PA = (const bf16_t*)(P.ws + OFF_PA);
    float* gs = sm; float* ks = sm + 2048; float* vs = sm + 4096; float* gl = sm + 8192; float* seg = sm + 9216;
    __syncthreads();
    { bf16_t tk[4], tv[8];
#pragma unroll
      for (int k = 0; k < 4; ++k) { const int i = tid + 512 * k, t = i >> 5, d = i & 31; tk[k] = PA[(size_t)(row0 + t) * PALD + CB + 128 + h * 32 + d]; }
#pragma unroll
      for (int k = 0; k < 8; ++k) { const int i = tid + 512 * k, t = i >> 6, e = i & 63; tv[k] = PA[(size_t)(row0 + t) * PALD + CB + 256 + h * 64 + e]; }
#pragma unroll
      for (int k = 0; k < 4; ++k) ks[tid + 512 * k] = bf2f(tk[k]);
#pragma unroll
      for (int k = 0; k < 8; ++k) vs[tid + 512 * k] = bf2f(tv[k]); }
    gla_load_cum(P, l, h, row0, gs, gl, seg);
    for (int i = tid; i < 2048; i += 512) { const int d = i & 31; ks[i] *= __expf(gs[63 * 32 + d] - gs[i]); }
    __syncthreads();
    { const int d = tid >> 4, e4 = (tid & 15) * 4; f32x4 u = {0.f, 0.f, 0.f, 0.f};
        f32x4 u1 = {0.f, 0.f, 0.f, 0.f};
#pragma unroll 4
        for (int t = 0; t < 64; t += 2) { const float kd0 = ks[t * 32 + d], kd1 = ks[(t + 1) * 32 + d]; const f32x4 v40 = *(const f32x4*)(vs + t * 64 + e4), v41 = *(const f32x4*)(vs + (t + 1) * 64 + e4); u += v40 * kd0; u1 += v41 * kd1; }
        u += u1;
        *(f32x4*)(P.out + SO_GU + (size_t)item * 2048 + d * 64 + e4) = u; }
    if (tid < 32) P.out[SO_GD + (size_t)item * 32 + tid] = __expf(gs[63 * 32 + tid]);
}

DEVI void rwkv_scan_prompt(const Params& P, int l, int item, float* sm) {
    const int b = item >> 4, h = (item >> 2) & 3, q = item & 3;
    const int tid = tidx(), wave = tid >> 6, lane = tid & 63;
    const bf16_t* RWP = (const bf16_t*)(P.ws + OFF_RWP); const float* RWC = (const float*)(P.ws + OFF_RWC); float* RWO = P.out + SO_RWO;
    constexpr int T = 32, BUF = 5 * T * 64 + T * 16 + T * 2;
    const size_t rbase = (size_t)b * 2048;
    float* buf0 = sm; float* buf1 = sm + BUF;
    auto load_chunk = [&](int c, float* buf) {
        const int lt = tid - 256, ch = lt & 63, tq = lt >> 6;
        bf16_t raw[8][5], rv[2]; float rc = 0.f;
#pragma unroll
        for (int i = 0; i < 8; ++i) { const int t = tq + 4 * i; const bf16_t* rp = RWP + (rbase + c * T + t) * 1536 + h * 64 + ch;
            raw[i][0] = rp[0]; raw[i][1] = rp[256]; raw[i][2] = rp[512]; raw[i][3] = rp[768]; raw[i][4] = rp[1024]; }
#pragma unroll
        for (int i = 0; i < 2; ++i) { const int t = (lt >> 4) + 16 * i, rr = lt & 15; rv[i] = RWP[(rbase + c * T + t) * 1536 + 1280 + h * 64 + 16 * q + rr]; }
        if (lt < 64) { const int t = lt >> 1, j = lt & 1; rc = RWC[(rbase + c * T + t) * 16 + h * 4 + j]; }
#pragma unroll
        for (int i = 0; i < 8; ++i) { const int t = tq + 4 * i;
            const float lw = bf2f(raw[i][0]), kk = bf2f(raw[i][1]), ka = bf2f(raw[i][2]), kp = bf2f(raw[i][3]), r = bf2f(raw[i][4]); const float dd = __expf(-lw);
            buf[t * 64 + ch] = dd; buf[T * 64 + t * 64 + ch] = dd * r; buf[2 * T * 64 + t * 64 + ch] = kk; buf[3 * T * 64 + t * 64 + ch] = ka; buf[4 * T * 64 + t * 64 + ch] = kp; }
#pragma unroll
        for (int i = 0; i < 2; ++i) { const int t = (lt >> 4) + 16 * i, rr = lt & 15; buf[5 * T * 64 + t * 16 + rr] = bf2f(rv[i]); }
        if (lt < 64) { const int t = lt >> 1, j = lt & 1; buf[5 * T * 64 + T * 16 + t * 2 + j] = rc; }
    };
    __syncthreads();
    if (tid >= 256) load_chunk(0, buf0);
    __syncthreads();
    const int rowgrp = lane >> 4, ks = lane & 15, vloc = 4 * wave + rowgrp, vrow = 16 * q + vloc;
    f32x4 S = {0.f, 0.f, 0.f, 0.f};
    for (int c = 0; c < SEQ / T; ++c) {
        float* cur = (c & 1) ? buf1 : buf0; float* nxt = (c & 1) ? buf0 : buf1;
        if (tid >= 256) { if (c + 1 < SEQ / T) load_chunk(c + 1, nxt); }
        else {
            const float* cb = cur + 4 * ks;
            f32x4 d4 = *(const f32x4*)(cb), dr4 = *(const f32x4*)(cb + T * 64), kk4 = *(const f32x4*)(cb + 2 * T * 64), ka4 = *(const f32x4*)(cb + 3 * T * 64), kp4 = *(const f32x4*)(cb + 4 * T * 64);
            float vv = cur[5 * T * 64 + vloc]; f32x2 cc = *(const f32x2*)(cur + 5 * T * 64 + T * 16);
            float* op = RWO + (rbase + (size_t)c * T) * 256 + h * 64 + vrow;
#pragma unroll 16
            for (int t = 0; t < T; ++t) {
                const float* nb = cb + (t + 1) * 64;
                const f32x4 nd4 = *(const f32x4*)(nb), ndr4 = *(const f32x4*)(nb + T * 64), nkk4 = *(const f32x4*)(nb + 2 * T * 64), nka4 = *(const f32x4*)(nb + 3 * T * 64), nkp4 = *(const f32x4*)(nb + 4 * T * 64);
                const float nvv = cur[5 * T * 64 + (t + 1) * 16 + vloc]; const f32x2 ncc = *(const f32x2*)(cur + 5 * T * 64 + T * 16 + (t + 1) * 2);
                const f32x2 t1 = S.lo * kk4.lo + S.hi * kk4.hi, t2 = S.lo * dr4.lo + S.hi * dr4.hi;
                float p1 = t1.x + t1.y, p2 = t2.x + t2.y;
                p1 = reduce16(p1); p2 = reduce16(p2);
                const float sa = -p1;
                S = S * d4 + ka4 * sa + kp4 * vv;
                op[t * 256] = p2 + sa * cc[0] + vv * cc[1];
                d4 = nd4; dr4 = ndr4; kk4 = nkk4; ka4 = nka4; kp4 = nkp4; vv = nvv; cc = ncc;
            }
        }
        __syncthreads();
    }
    if (tid < 256) *(f32x4*)(P.out + O_WKVP + ((size_t)((l * 8 + b) * 4 + h) * 64 + vrow) * 64 + 4 * ks) = S;
}
DEVI void rwkv_scan_sample(const Params& P, int l, int item) {
    const int tid = tidx(), wave = tid >> 6, lane = tid & 63, pair = item * 8 + wave, b = pair >> 2, h = pair & 3;
    const bf16_t* RWP = (const bf16_t*)(P.ws + OFF_RWP); const float* RWC = (const float*)(P.ws + OFF_RWC); float* RWO = P.out + SO_RWO;
    const size_t row = NTOK + b; const int rowgrp = lane >> 4, ks = lane & 15;
    const bf16_t* rp = RWP + row * 1536 + h * 64 + 4 * ks;
    f32x4 d4, dr4, kk4, ka4, kp4;
#pragma unroll
    for (int j = 0; j < 4; ++j) { const float lw = bf2f(rp[j]), r = bf2f(rp[1024 + j]); d4[j] = __expf(-lw); dr4[j] = d4[j] * r; kk4[j] = bf2f(rp[256 + j]); ka4[j] = bf2f(rp[512 + j]); kp4[j] = bf2f(rp[768 + j]); }
    const float c1 = RWC[row * 16 + h * 4], c2 = RWC[row * 16 + h * 4 + 1];
    const float* S0 = P.in[I_SWKV] + (size_t)((l * 128 + b) * 4 + h) * 4096; float* S1 = P.out + O_WKVS + (size_t)((l * 128 + b) * 4 + h) * 4096;
    f32x4 Sv[16]; bf16_t vr[16];
#pragma unroll
    for (int it = 0; it < 16; ++it) { const int vrow = 4 * it + rowgrp; Sv[it] = *(const f32x4*)(S0 + vrow * 64 + 4 * ks); vr[it] = RWP[row * 1536 + 1280 + h * 64 + vrow]; }
#pragma unroll
    for (int it = 0; it < 16; ++it) {
        const int vrow = 4 * it + rowgrp;
        f32x4 S = Sv[it];
        const float vv = bf2f(vr[it]);
        float p1 = (S[0] * kk4[0] + S[1] * kk4[1]) + (S[2] * kk4[2] + S[3] * kk4[3]);
        float p2 = (S[0] * dr4[0] + S[1] * dr4[1]) + (S[2] * dr4[2] + S[3] * dr4[3]);
        p1 = reduce16(p1); p2 = reduce16(p2);
        const float sa = -p1;
        S = S * d4 + ka4 * sa + kp4 * vv;
        *(f32x4*)(S1 + vrow * 64 + 4 * ks) = S;
        RWO[row * 256 + h * 64 + vrow] = p2 + sa * c1 + vv * c2;
    }
}
DEVI void gla_prefix(const Params& P, int l, int bh) {
    const int idx = tidx() * 4, d = idx >> 6;
    float* GU = P.out + SO_GU; const float* GD = P.out + SO_GD;
    f32x4 S = {0.f, 0.f, 0.f, 0.f};
#pragma nounroll
    for (int c0 = 0; c0 < 32; c0 += 8) {
        f32x4 U[8]; float dd[8];
#pragma unroll
        for (int c = 0; c < 8; ++c) { const size_t it = (size_t)bh * 32 + c0 + c; U[c] = *(const f32x4*)(GU + it * 2048 + idx); dd[c] = GD[it * 32 + d]; }
#pragma unroll
        for (int c = 0; c < 8; ++c) { const size_t it = (size_t)bh * 32 + c0 + c; *(f32x4*)(GU + it * 2048 + idx) = S; S = S * dd[c] + U[c]; }
    }
    *(f32x4*)(P.out + O_GLP + (size_t)(l * 32 + bh) * 2048 + idx) = S;
}
DEVI void lru_carry(const Params& P, int l, int b) {
    if (tidx() >= 256) return;
    const int d = tidx(); const float* LA = P.out + SO_LA; float* LB = P.out + SO_LB;
    float carry = 0.f;
#pragma nounroll
    for (int s0 = 0; s0 < 128; s0 += 32) {
        float A[32], Bv[32];
#pragma unroll
        for (int s = 0; s < 32; ++s) { const size_t o = (size_t)(b * 128 + s0 + s) * 256 + d; A[s] = LA[o]; Bv[s] = LB[o]; }
#pragma unroll
        for (int s = 0; s < 32; ++s) { const size_t o = (size_t)(b * 128 + s0 + s) * 256 + d; LB[o] = carry; carry = A[s] * carry + Bv[s]; }
    }
    P.out[O_HP + (size_t)(l * 8 + b) * 256 + d] = carry;
}
template <bool DRY = false> DEVI void swa_prompt(const Params& P, int l, int item, float* sm) {
    const bool dost = !DRY || (P.ws == nullptr);
    const int tid = tidx(), b = item >> 6, kv = (item >> 5) & 1, qb = item & 31, t0 = qb * 64;
    const bf16_t* PA = (const bf16_t*)(P.ws + OFF_PA); bf16_t* ZY = (bf16_t*)(P.ws + OFF_ZY);
    float* Ks = sm; float* Vs = sm + 192 * 68;
    __syncthreads();
    u32x4 kwa[3], vwa[3];
#pragma unroll
    for (int k = 0; k < 3; ++k) { const int i = tid + 512 * k, ls = i >> 3, c8 = (i & 7) * 8, s = t0 - 128 + ls; kwa[k] = (u32x4){0u, 0u, 0u, 0u}; vwa[k] = (u32x4){0u, 0u, 0u, 0u};
        if (s >= 0) { const bf16_t* rp = PA + (size_t)(b * 2048 + s) * PALD + CC + 256 + kv * 64 + c8; kwa[k] = *(const u32x4*)rp; vwa[k] = *(const u32x4*)(rp + 128); } }
#pragma unroll
    for (int k = 0; k < 3; ++k) { const int i = tid + 512 * k, ls = i >> 3, c8 = (i & 7) * 8; const u32x4 kw = kwa[k], vw = vwa[k];
        *(f32x4*)(Ks + ls * 68 + c8) = (f32x4){bflo(kw.x), bfhi(kw.x), bflo(kw.y), bfhi(kw.y)}; *(f32x4*)(Ks + ls * 68 + c8 + 4) = (f32x4){bflo(kw.z), bfhi(kw.z), bflo(kw.w), bfhi(kw.w)};
        *(f32x4*)(Vs + ls * 68 + c8) = (f32x4){bflo(vw.x), bfhi(vw.x), bflo(vw.y), bfhi(vw.y)}; *(f32x4*)(Vs + ls * 68 + c8 + 4) = (f32x4){bflo(vw.z), bfhi(vw.z), bflo(vw.w), bfhi(vw.w)}; }
    __syncthreads();
    const int rowid = tid >> 2, part = tid & 3, g = rowid & 1, qi = rowid >> 1, hh = kv * 2 + g, t = t0 + qi;
    const size_t row = (size_t)b * 2048 + t;
    f32x2 q2[8];
    { const u32x4* qp = (const u32x4*)(PA + row * PALD + CC + hh * 64 + 16 * part);
#pragma unroll
        for (int i = 0; i < 2; ++i) { const u32x4 w = qp[i]; q2[4 * i] = (f32x2){bflo(w.x), bfhi(w.x)} * 0.125f; q2[4 * i + 1] = (f32x2){bflo(w.y), bfhi(w.y)} * 0.125f;
            q2[4 * i + 2] = (f32x2){bflo(w.z), bfhi(w.z)} * 0.125f; q2[4 * i + 3] = (f32x2){bflo(w.w), bfhi(w.w)} * 0.125f; } }
    const float slope = exp2f(-2.f * (float)(hh + 1));
    float m = -1e30f, lsum = 0.f; f32x2 acc2[8];
#pragma unroll
    for (int i = 0; i < 8; ++i) acc2[i] = (f32x2){0.f, 0.f};
    const int j0 = (t < 128) ? (128 - t) : 0;
    for (int j = j0; j <= 128; j += 2) {
        const bool vb = (j + 1) <= 128; const int rb = vb ? (qi + j + 1) : (qi + j);
        const float* kra = Ks + (qi + j) * 68 + 16 * part; const float* krb = Ks + rb * 68 + 16 * part;
        f32x2 sa2 = {0.f, 0.f}, sb2 = {0.f, 0.f};
#pragma unroll
        for (int i = 0; i < 4; ++i) { const f32x4 ka = *(const f32x4*)(kra + 4 * i), kb = *(const f32x4*)(krb + 4 * i);
            sa2 += q2[2 * i] * ka.lo; sa2 += q2[2 * i + 1] * ka.hi; sb2 += q2[2 * i] * kb.lo; sb2 += q2[2 * i + 1] * kb.hi; }
        const float sca = quad_sum(sa2.x + sa2.y) - slope * (float)(128 - j);
        const float scb = vb ? (quad_sum(sb2.x + sb2.y) - slope * (float)(127 - j)) : -1e30f;
        const float mn = fmaxf(sca, scb);
        if (mn > m) { const float corr = __expf(m - mn); lsum *= corr;
#pragma unroll
            for (int i = 0; i < 8; ++i) acc2[i] *= corr;
            m = mn; }
        const float pa = __expf(sca - m), pb = vb ? __expf(scb - m) : 0.f; lsum += pa + pb;
        const float* vra = Vs + (qi + j) * 68 + 16 * part; const float* vrb = Vs + rb * 68 + 16 * part;
#pragma unroll
        for (int i = 0; i < 4; ++i) { const f32x4 va = *(const f32x4*)(vra + 4 * i), vbv = *(const f32x4*)(vrb + 4 * i);
            acc2[2 * i] += va.lo * pa; acc2[2 * i + 1] += va.hi * pa; acc2[2 * i] += vbv.lo * pb; acc2[2 * i + 1] += vbv.hi * pb; }
    }
    float acc[16];
#pragma unroll
    for (int i = 0; i < 8; ++i) { acc[2 * i] = acc2[i].x; acc[2 * i + 1] = acc2[i].y; }
    const float sk = P.in[I_SINK][l * 4 + hh], mf = fmaxf(m, sk), e = __expf(m - mf), inv = e * frcp(lsum * e + __expf(sk - mf));
    bf16_t* zp = ZY + row * 1024 + 512 + hh * 64 + 16 * part;
    const u32x4 z0 = *(const u32x4*)zp, z1 = *(const u32x4*)(zp + 8);
    float o[16];
#pragma unroll
    for (int i = 0; i < 16; ++i) o[i] = acc[i] * inv;
    u32x4 w0, w1;
    w0.x = pk2(o[0] * silu(bflo(z0.x)), o[1] * silu(bfhi(z0.x))); w0.y = pk2(o[2] * silu(bflo(z0.y)), o[3] * silu(bfhi(z0.y)));
    w0.z = pk2(o[4] * silu(bflo(z0.z)), o[5] * silu(bfhi(z0.z))); w0.w = pk2(o[6] * silu(bflo(z0.w)), o[7] * silu(bfhi(z0.w)));
    w1.x = pk2(o[8] * silu(bflo(z1.x)), o[9] * silu(bfhi(z1.x))); w1.y = pk2(o[10] * silu(bflo(z1.y)), o[11] * silu(bfhi(z1.y)));
    w1.z = pk2(o[12] * silu(bflo(z1.z)), o[13] * silu(bfhi(z1.z))); w1.w = pk2(o[14] * silu(bflo(z1.w)), o[15] * silu(bfhi(z1.w)));
    if (dost) { *(u32x4*)zp = w0; *(u32x4*)(zp + 8) = w1; }
}
DEVI void swa_sample(const Params& P, int l, int b, float* sm) {
    const int tid = tidx(), wave = tid >> 6, lane = tid & 63; const size_t row = NTOK + b;
    const bf16_t* PA = (const bf16_t*)(P.ws + OFF_PA); bf16_t* ZY = (bf16_t*)(P.ws + OFF_ZY);
    float* qs = sm; float* kn = sm + 256; float* vn = sm + 384; float* sc = sm + 512;
    const float* CK = P.in[I_CK] + (size_t)(l * 128 + b) * 16384; const float* CV = P.in[I_CV] + (size_t)(l * 128 + b) * 16384;
    __syncthreads();
    { const float v = bf2f(PA[row * PALD + CC + tid]); if (tid < 256) qs[tid] = v * 0.125f; else if (tid < 384) kn[tid - 256] = v; else vn[tid - 384] = v; }
    __syncthreads();
    { const int hh = tid >> 7, s = tid & 127, kv = hh >> 1; const f32x4* kp = (const f32x4*)(CK + s * 128 + kv * 64); const float* qh = qs + hh * 64; float d = 0.f;
#pragma unroll
        for (int i = 0; i < 16; ++i) { const f32x4 k4 = kp[i]; d += qh[4 * i] * k4[0] + qh[4 * i + 1] * k4[1] + qh[4 * i + 2] * k4[2] + qh[4 * i + 3] * k4[3]; }
        sc[hh * 132 + s] = d - exp2f(-2.f * (float)(hh + 1)) * (float)(128 - s); }
    if (wave < 4) { const int hh = wave; const float d = wave_sum(qs[hh * 64 + lane] * kn[(hh >> 1) * 64 + lane]); if (lane == 0) sc[hh * 132 + 128] = d; }
    __syncthreads();
    if (wave < 4) { const int hh = wave; const float a0 = sc[hh * 132 + lane], a1 = sc[hh * 132 + 64 + lane], a2 = lane == 0 ? sc[hh * 132 + 128] : -1e30f, sk = P.in[I_SINK][l * 4 + hh];
        const float mx = fmaxf(wave_max(fmaxf(fmaxf(a0, a1), a2)), sk); const float e0 = __expf(a0 - mx), e1 = __expf(a1 - mx), e2 = lane == 0 ? __expf(a2 - mx) : 0.f;
        const float inv = frcp(wave_sum(e0 + e1 + e2) + __expf(sk - mx));
        sc[hh * 132 + lane] = e0 * inv; sc[hh * 132 + 64 + lane] = e1 * inv; if (lane == 0) sc[hh * 132 + 128] = e2 * inv; }
    __syncthreads();
    if (tid < 256) { const int hh = tid >> 6, dd = tid & 63, kv = hh >> 1; const float* pp = sc + hh * 132; float o = pp[128] * vn[kv * 64 + dd];
#pragma nounroll
        for (int s0 = 0; s0 < 128; s0 += 32) { float cvv[32];
#pragma unroll
            for (int s = 0; s < 32; ++s) cvv[s] = CV[(s0 + s) * 128 + kv * 64 + dd];
#pragma unroll
            for (int s = 0; s < 32; ++s) o += pp[s0 + s] * cvv[s]; }
        bf16_t* zp = ZY + row * 1024 + 512 + tid; *zp = f2bf(o * silu(bf2f(*zp))); }
    float* KO = P.out + O_KS + (size_t)(l * 128 + b) * 16384; float* VO = P.out + O_VS + (size_t)(l * 128 + b) * 16384;
    { f32x4 tk[8], tv[8];
#pragma unroll
      for (int k = 0; k < 8; ++k) { const int e = (tid + 512 * k) * 4;
        if (e < 127 * 128) { tk[k] = *(const f32x4*)(CK + 128 + e); tv[k] = *(const f32x4*)(CV + 128 + e); }
        else { tk[k] = *(const f32x4*)(kn + (e - 127 * 128)); tv[k] = *(const f32x4*)(vn + (e - 127 * 128)); } }
#pragma unroll
      for (int k = 0; k < 8; ++k) { const int e = (tid + 512 * k) * 4; *(f32x4*)(KO + e) = tk[k]; *(f32x4*)(VO + e) = tv[k]; } }
}
DEVI void gla_sample(const Params& P, int l, int b, float* sm) {
    const int tid = tidx(); const size_t row = NTOK + b;
    const bf16_t* PA = (const bf16_t*)(P.ws + OFF_PA); bf16_t* ZY = (bf16_t*)(P.ws + OFF_ZY);
    float* qs = sm; float* ks = sm + 128; float* eg = sm + 256; float* gl = sm + 384;
    __syncthreads();
    if (tid < 128) { qs[tid] = bf2f(PA[row * PALD + CB + tid]) * 0.17677669529663687f; ks[tid] = bf2f(PA[row * PALD + CB + 128 + tid]); }
    if (tid >= 128 && tid < 144) gl[tid - 128] = bf2f(PA[row * PALD + CB + 512 + tid - 128]);
    __syncthreads();
    if (tid < 128) { float x = P.in[I_GB][l * 128 + tid];
#pragma unroll
        for (int j = 0; j < 16; ++j) x += gl[j] * P.in[I_GUP][(l * 16 + j) * 128 + tid];
        eg[tid] = __expf(logsig(x) * (1.f / 16.f)); }
    __syncthreads();
    if (tid < 256) { const int h = tid >> 6, e = tid & 63; const float v = bf2f(PA[row * PALD + CB + 256 + tid]);
        const float* S0 = P.in[I_SGLA] + (size_t)((l * 128 + b) * 4 + h) * 2048; float* S1 = P.out + O_GLS + (size_t)((l * 128 + b) * 4 + h) * 2048;
        float o = 0.f, s0v[32];
#pragma unroll
        for (int d = 0; d < 32; ++d) s0v[d] = S0[d * 64 + e];
#pragma unroll
        for (int d = 0; d < 32; ++d) { const float sn = eg[h * 32 + d] * s0v[d] + ks[h * 32 + d] * v; S1[d * 64 + e] = sn; o += qs[h * 32 + d] * sn; }
        const float rr = rsqrtf(wave_sum(o * o) * (1.f / 64.f) + 1e-6f);
        bf16_t* zp = ZY + row * 1024 + 256 + tid; *zp = f2bf(o * rr * P.in[I_GNG][l * 64 + e] * silu(bf2f(*zp))); }
}
DEVI void lru_sample(const Params& P, int l, int item, float* sm) {
    const int tid = tidx(), s = tid >> 8, d = tid & 255, b = item * 2 + s; const size_t row = NTOK + b;
    const bf16_t* PA = (const bf16_t*)(P.ws + OFF_PA); bf16_t* ZY = (bf16_t*)(P.ws + OFF_ZY);
    float* xcs = sm;
    __syncthreads();
    const float x = bf2f(PA[row * PALD + CD + d]); const float* cv = P.in[I_SCONV] + (size_t)(l * 128 + b) * 768;
    const float c0 = cv[d], c1 = cv[256 + d], c2 = cv[512 + d];
    const float xc = P.in[I_CBI][l * 256 + d] + P.in[I_CW][(l * 4 + 0) * 256 + d] * c0 + P.in[I_CW][(l * 4 + 1) * 256 + d] * c1 + P.in[I_CW][(l * 4 + 2) * 256 + d] * c2 + P.in[I_CW][(l * 4 + 3) * 256 + d] * x;
    xcs[s * 256 + d] = xc;
    __syncthreads();
    const int n = d >> 6, dl = d & 63; float rp = P.in[I_BA][l * 256 + d], ip = P.in[I_BX][l * 256 + d];
#pragma unroll 8
    for (int c = 0; c < 64; ++c) { const float xv = xcs[s * 256 + n * 64 + c]; rp += xv * P.in[I_WA][((l * 4 + n) * 64 + c) * 64 + dl]; ip += xv * P.in[I_WX][((l * 4 + n) * 64 + c) * 64 + dl]; }
    const float la = 8.f * logsig_acc(P.in[I_LAM][l * 256 + d]) * sigm(rp), a = __expf(la), bt = __builtin_amdgcn_sqrtf(fmaxf(-expm1f(2.f * la), 0.f)) * sigm(ip) * xc;
    const float hn = a * P.in[I_SH][(size_t)(l * 128 + b) * 256 + d] + bt;
    float* co = P.out + O_CVS + (size_t)(l * 128 + b) * 768; co[d] = c1; co[256 + d] = c2; co[512 + d] = x;
    P.out[O_HS + (size_t)(l * 128 + b) * 256 + d] = hn;
    bf16_t* zp = ZY + row * 1024 + 768 + d; *zp = f2bf(hn * silu(bf2f(*zp)));
}

template <bool DRY = false> DEVI void rwkv_post(const Params& P, int l, int item) {
    const bool dost = !DRY || (P.ws == nullptr);
    const int tid = tidx(), wave = tid >> 6, lane = tid & 63;
    const bf16_t* RWP = (const bf16_t*)(P.ws + OFF_RWP); const float* RWC = (const float*)(P.ws + OFF_RWC); const float* RWO = P.out + SO_RWO; bf16_t* ZY = (bf16_t*)(P.ws + OFF_ZY);
    float o[8], v[8], z[8], c3[8];
#pragma unroll
    for (int k = 0; k < 8; ++k) { const int task = wave * 8 + k, h = task & 3; const size_t row = (size_t)item * 16 + (task >> 2);
        o[k] = RWO[row * 256 + h * 64 + lane]; v[k] = bf2f(RWP[row * 1536 + 1280 + h * 64 + lane]); z[k] = bf2f(ZY[row * 1024 + h * 64 + lane]); c3[k] = RWC[row * 16 + h * 4 + 2]; }
#pragma unroll
    for (int k = 0; k < 8; ++k) { const int task = wave * 8 + k, h = task & 3; const size_t row = (size_t)item * 16 + (task >> 2);
        const float mean = wave_sum(o[k]) * (1.f / 64.f); const float dv = o[k] - mean; const float var = wave_sum(dv * dv) * (1.f / 64.f);
        const float y = dv * rsqrtf(var + 64e-5f) * P.in[I_LNG][l * 256 + h * 64 + lane] + P.in[I_LNB][l * 256 + h * 64 + lane] + c3[k] * v[k];
        if (dost) ZY[row * 1024 + h * 64 + lane] = f2bf(y * silu(z[k])); }
}
template <bool DRY = false> DEVI void lru_final(const Params& P, int l, int item) {
    const bool dost = !DRY || (P.ws == nullptr);
    const int tid = tidx(), b = item >> 6, ck = item & 63, d = tid & 255, half = tid >> 8, sub = ck * 2 + half;
    const float* LH = P.out + SO_LH; const float* LP = P.out + SO_LP; const float* LB = P.out + SO_LB; bf16_t* ZY = (bf16_t*)(P.ws + OFF_ZY);
    const float carry = LB[(size_t)(b * 128 + sub) * 256 + d];
    const size_t r0 = (size_t)b * 2048 + ck * 32 + half * 16;
    float hv[16], z[16];
#pragma unroll
    for (int tt = 0; tt < 16; ++tt) { hv[tt] = LH[(r0 + tt) * 256 + d] + LP[(r0 + tt) * 256 + d] * carry; z[tt] = bf2f(ZY[(r0 + tt) * 1024 + 768 + d]); }
#pragma unroll
    for (int tt = 0; tt < 16; ++tt) if (dost) ZY[(r0 + tt) * 1024 + 768 + d] = f2bf(hv[tt] * silu(z[tt]));
}
template <bool DRY = false> DEVI void gla_out(const Params& P, int l, int item, float* sm) {
    const bool dost = !DRY || (P.ws == nullptr);
    const int tid = tidx(), c = item & 31, h = (item >> 5) & 3, b = item >> 7, row0 = b * 2048 + c * 64;
    const bf16_t* PA = (const bf16_t*)(P.ws + OFF_PA); bf16_t* ZY = (bf16_t*)(P.ws + OFF_ZY);
    float* gs = sm; float* gl = sm + 2048; float* seg = sm + 3072; float* qs = sm + 3584; float* ks = qs + 64 * 36; float* vs = ks + 64 * 36; float* att = vs + 4096; float* Ss = att + 64 * 65;
    __syncthreads();
    { bf16_t tq[4], tk[4], tv[8]; float ts[4];
#pragma unroll
      for (int k = 0; k < 4; ++k) { const int i = tid + 512 * k, t = i >> 5, d = i & 31; const bf16_t* rp = PA + (size_t)(row0 + t) * PALD + CB + h * 32 + d; tq[k] = rp[0]; tk[k] = rp[128]; ts[k] = P.out[SO_GU + (size_t)item * 2048 + i]; }
#pragma unroll
      for (int k = 0; k < 8; ++k) { const int i = tid + 512 * k, t = i >> 6, e = i & 63; tv[k] = PA[(size_t)(row0 + t) * PALD + CB + 256 + h * 64 + e]; }
#pragma unroll
      for (int k = 0; k < 4; ++k) { const int i = tid + 512 * k, t = i >> 5, d = i & 31; qs[t * 36 + d] = bf2f(tq[k]) * 0.17677669529663687f; ks[t * 36 + d] = bf2f(tk[k]); Ss[i] = ts[k]; }
#pragma unroll
      for (int k = 0; k < 8; ++k) vs[tid + 512 * k] = bf2f(tv[k]); }
    gla_load_cum(P, l, h, row0, gs, gl, seg);
    for (int i = tid; i < 2048; i += 512) { const int t = i >> 5, d = i & 31; const float bc = gs[i]; qs[t * 36 + d] *= __expf(bc); ks[t * 36 + d] *= __expf(-bc); }
    __syncthreads();
    const int t = tid >> 3, s8 = (tid & 7) * 8;
    {
        f32x4 qv[8];
#pragma unroll
        for (int d4 = 0; d4 < 8; ++d4) qv[d4] = *(const f32x4*)(qs + t * 36 + 4 * d4);
#pragma unroll
        for (int i = 0; i < 8; ++i) { const int s = 8 * i + (tid & 7); float a = 0.f;
            if (s <= t) { f32x2 a2 = {0.f, 0.f};
#pragma unroll
                for (int d4 = 0; d4 < 8; ++d4) { const f32x4 kv = *(const f32x4*)(ks + s * 36 + 4 * d4); a2 += qv[d4].lo * kv.lo; a2 += qv[d4].hi * kv.hi; }
                a = a2.x + a2.y; }
            att[t * 65 + s] = a; }
    }
    __syncthreads();
    const int e8 = s8; float o[8]; f32x2 o2[4], o3[4];
#pragma unroll
    for (int i = 0; i < 4; ++i) { o2[i] = (f32x2){0.f, 0.f}; o3[i] = (f32x2){0.f, 0.f}; }
    int s = 0;
    for (; s + 1 <= t; s += 2) {
        const float a0 = att[t * 65 + s], a1 = att[t * 65 + s + 1];
        const f32x4 v0 = *(const f32x4*)(vs + s * 64 + e8), v1 = *(const f32x4*)(vs + s * 64 + e8 + 4), w0 = *(const f32x4*)(vs + (s + 1) * 64 + e8), w1 = *(const f32x4*)(vs + (s + 1) * 64 + e8 + 4);
        o2[0] += v0.lo * a0; o2[1] += v0.hi * a0; o2[2] += v1.lo * a0; o2[3] += v1.hi * a0;
        o3[0] += w0.lo * a1; o3[1] += w0.hi * a1; o3[2] += w1.lo * a1; o3[3] += w1.hi * a1; }
    if (s <= t) { const float a0 = att[t * 65 + s]; const f32x4 v0 = *(const f32x4*)(vs + s * 64 + e8), v1 = *(const f32x4*)(vs + s * 64 + e8 + 4);
        o2[0] += v0.lo * a0; o2[1] += v0.hi * a0; o2[2] += v1.lo * a0; o2[3] += v1.hi * a0; }
#pragma unroll 4
    for (int d = 0; d < 32; d += 2) { const float a0 = qs[t * 36 + d], a1 = qs[t * 36 + d + 1];
        const f32x4 v0 = *(const f32x4*)(Ss + d * 64 + e8), v1 = *(const f32x4*)(Ss + d * 64 + e8 + 4), w0 = *(const f32x4*)(Ss + (d + 1) * 64 + e8), w1 = *(const f32x4*)(Ss + (d + 1) * 64 + e8 + 4);
        o2[0] += v0.lo * a0; o2[1] += v0.hi * a0; o2[2] += v1.lo * a0; o2[3] += v1.hi * a0;
        o3[0] += w0.lo * a1; o3[1] += w0.hi * a1; o3[2] += w1.lo * a1; o3[3] += w1.hi * a1; }
#pragma unroll
    for (int i = 0; i < 4; ++i) { const f32x2 r2 = o2[i] + o3[i]; o[2 * i] = r2.x; o[2 * i + 1] = r2.y; }
    float ss = 0.f;
#pragma unroll
    for (int i = 0; i < 8; ++i) ss += o[i] * o[i];
    ss = reduce8(ss);
    const float rr = rsqrtf(ss * (1.f / 64.f) + 1e-6f);
    bf16_t* zp = ZY + (size_t)(row0 + t) * 1024 + 256 + h * 64 + e8; const u32x4 z = *(const u32x4*)zp; const float* ng = P.in[I_GNG] + l * 64 + e8;
    u32x4 w; w.x = pk2(o[0] * rr * ng[0] * silu(bflo(z.x)), o[1] * rr * ng[1] * silu(bfhi(z.x))); w.y = pk2(o[2] * rr * ng[2] * silu(bflo(z.y)), o[3] * rr * ng[3] * silu(bfhi(z.y)));
    w.z = pk2(o[4] * rr * ng[4] * silu(bflo(z.z)), o[5] * rr * ng[5] * silu(bfhi(z.z))); w.w = pk2(o[6] * rr * ng[6] * silu(bflo(z.w)), o[7] * rr * ng[7] * silu(bfhi(z.w)));
    if (dost) *(u32x4*)zp = w;
}


DEVI void grid_bar(unsigned* w, unsigned k) {
    asm volatile("s_waitcnt vmcnt(0)" ::: "memory");
    __syncthreads();
    if (tidx() == 0) {
        const unsigned G = gridDim.x;
        __builtin_amdgcn_fence(__ATOMIC_RELEASE, "agent");
        asm volatile("s_waitcnt vmcnt(0)" ::: "memory");
        const unsigned old = __hip_atomic_fetch_add(&w[0], 1u, __ATOMIC_RELAXED, __HIP_MEMORY_SCOPE_AGENT);
        if (old + 1u == k * G) __hip_atomic_store(&w[64], k, __ATOMIC_RELAXED, __HIP_MEMORY_SCOPE_AGENT);
        while (__hip_atomic_load(&w[64], __ATOMIC_RELAXED, __HIP_MEMORY_SCOPE_AGENT) < k) __builtin_amdgcn_s_sleep(1);
        __builtin_amdgcn_fence(__ATOMIC_ACQUIRE, "agent");
        asm volatile("s_waitcnt vmcnt(0)" ::: "memory");
    }
    __syncthreads();
}

template <int NT, class Epi>
DEVI void small_gemm(const bf16_t* A, int lda, const bf16_t* const (&bp)[NT], int ldb, int K, const Epi& E, float* sm) {
    const int tid = tidx(), wave = tid >> 6, lane = tid & 63, lr = lane & 15, lq = lane >> 4;
    const int kw = K >> 3, kbeg = wave * kw;
    const bf16_t* ap = A + (size_t)lr * lda + 8 * lq + kbeg;
    f32x4 acc[NT];
#pragma unroll
    for (int t = 0; t < NT; ++t) acc[t] = (f32x4){0.f, 0.f, 0.f, 0.f};
    if (kw == 128) {
        bf16x8 a[4], b[4][NT];
#pragma unroll
        for (int s2 = 0; s2 < 4; ++s2) { a[s2] = *(const bf16x8*)(ap + 32 * s2);
#pragma unroll
            for (int t = 0; t < NT; ++t) b[s2][t] = *(const bf16x8*)(bp[t] + (size_t)lr * ldb + 8 * lq + kbeg + 32 * s2); }
#pragma unroll
        for (int s2 = 0; s2 < 4; ++s2)
#pragma unroll
            for (int t = 0; t < NT; ++t) acc[t] = __builtin_amdgcn_mfma_f32_16x16x32_bf16(a[s2], b[s2][t], acc[t], 0, 0, 0);
    } else {
        const bf16x8 a = *(const bf16x8*)ap; bf16x8 b[NT];
#pragma unroll
        for (int t = 0; t < NT; ++t) b[t] = *(const bf16x8*)(bp[t] + (size_t)lr * ldb + 8 * lq + kbeg);
#pragma unroll
        for (int t = 0; t < NT; ++t) acc[t] = __builtin_amdgcn_mfma_f32_16x16x32_bf16(a, b[t], acc[t], 0, 0, 0);
    }
    __syncthreads();
    f32x4* red = (f32x4*)sm;
#pragma unroll
    for (int t = 0; t < NT; ++t) red[(wave * NT + t) * 64 + lane] = acc[t];
    __syncthreads();
    if (wave == 0) {
#pragma unroll
        for (int t = 0; t < NT; ++t) { f32x4 v = red[t * 64 + lane];
#pragma unroll
            for (int w = 1; w < 8; ++w) v += red[(w * NT + t) * 64 + lane];
            acc[t] = v; }
        E(acc, lane);
    }
}
DEVI void small_br(const Params& P, int l, int item, float* sm) {
    const int rg = item >> 6, it = item & 63, b = it >> 4, s4 = it & 15;
    const bf16_t* ZY = (const bf16_t*)(P.ws + OFF_ZY) + (size_t)(NTOK + 16 * rg) * 1024 + b * 256;
    const bf16_t* W = (const bf16_t*)(P.ws + OFF_WBR) + (size_t)(l * 4 + b) * 1024 * 256;
    const bf16_t* bp[4] = {W + (size_t)(64 * s4) * 256, W + (size_t)(64 * s4 + 16) * 256, W + (size_t)(64 * s4 + 32) * 256, W + (size_t)(64 * s4 + 48) * 256};
    bf16_t* BR = (bf16_t*)(P.ws + OFF_BR) + (size_t)(NTOK + 16 * rg) * 4096 + b * 1024;
    auto E = [&](const f32x4 (&acc)[4], int lane) {
#pragma unroll
        for (int t = 0; t < 4; ++t) { const int n = 64 * s4 + 16 * t + (lane & 15), col = (n & ~255) + natcol(n & 255);
#pragma unroll
            for (int g = 0; g < 4; ++g) BR[(size_t)((lane >> 4) * 4 + g) * 4096 + col] = f2bf(acc[t][g]); } };
    small_gemm<4>(ZY, 1024, bp, 256, 256, E, sm);
}
DEVI void small_gate(const Params& P, int l, int item, float* sm) {
    const int rg = item >> 6, it = item & 63, q = it >> 2, wc = it & 3;
    const bf16_t* XB = (const bf16_t*)(P.ws + OFF_XB) + (size_t)(NTOK + 16 * rg) * 1024;
    const bf16_t* W = (const bf16_t*)(P.ws + OFF_W1T) + (size_t)l * 7424 * 1024 + (size_t)(3328 + 256 * q + 32 * wc) * 1024;
    const bf16_t* bp[4] = {W, W + (size_t)16 * 1024, W + (size_t)128 * 1024, W + (size_t)144 * 1024};
    const bf16_t* BR = (const bf16_t*)(P.ws + OFF_BR) + (size_t)(NTOK + 16 * rg) * 4096;
    const float* ssq = (const float*)(P.ws + OFF_SSQ) + l * MPAD + NTOK + 16 * rg;
    bf16_t* ZY = (bf16_t*)(P.ws + OFF_ZY) + (size_t)(NTOK + 16 * rg) * 1024;
    auto E = [&](const f32x4 (&acc)[4], int lane) {
        const int col = 64 * q + 16 * wc + (lane & 15);
#pragma unroll
        for (int g = 0; g < 4; ++g) { const int rl = (lane >> 4) * 4 + g; const float rs = rsqrtf(ssq[rl] * (1.f / 1024.f) + 1e-6f); float o = 0.f;
#pragma unroll
            for (int b = 0; b < 4; ++b) o += sigm(acc[b][g] * rs) * bf2f(BR[(size_t)rl * 4096 + b * 1024 + col]);
            ZY[(size_t)rl * 1024 + col] = f2bf(o); } };
    small_gemm<4>(XB, 1024, bp, 1024, 1024, E, sm);
}
template <int LAYER> DEVI void small_out(const Params& P, int l, int item, float* sm) {
    const int rg = item >> 5, it = item & 31;
    const bf16_t* ZY = (const bf16_t*)(P.ws + OFF_ZY) + (size_t)(NTOK + 16 * rg) * 1024;
    const bf16_t* W = (const bf16_t*)(P.ws + OFF_WOUT) + (size_t)l * 1024 * 1024 + (size_t)(32 * it) * 1024;
    const bf16_t* bp[2] = {W, W + (size_t)16 * 1024};
    bf16_t* XB = (bf16_t*)(P.ws + OFF_XB) + (size_t)(NTOK + 16 * rg) * 1024; float* yout = P.out + (size_t)(NTOK + 16 * rg) * 1024; const float* xs = P.in[I_XS] + (size_t)(16 * rg) * 1024;
    float* ssq = (float*)(P.ws + OFF_SSQ) + (LAYER == 0 ? 1 : 2) * MPAD + NTOK + 16 * rg;
    auto E = [&](const f32x4 (&acc)[2], int lane) {
        const int i = lane & 15;
#pragma unroll
        for (int g = 0; g < 4; ++g) { const int rl = (lane >> 4) * 4 + g; float ps = 0.f;
#pragma unroll
            for (int t = 0; t < 2; ++t) { const int col = 32 * it + 8 * (i >> 2) + 4 * t + (i & 3); float v = acc[t][g];
                if (LAYER == 0) { v += xs[(size_t)rl * 1024 + col]; XB[(size_t)rl * 1024 + col] = f2bf(v); }
                else { v += bf2f(XB[(size_t)rl * 1024 + col]); yout[(size_t)rl * 1024 + col] = v; }
                ps += v * v; }
            ps = reduce16(ps);
            if (i == 0) atomicAdd(ssq + rl, ps); } };
    small_gemm<2>(ZY, 1024, bp, 1024, 1024, E, sm);
}

#ifndef PHMASK
#define PHMASK 0xFFFF
#endif
#define PHON(b) ((PHMASK >> (b)) & 1)
DEVI void run_phase(const Params& P, int ph, unsigned char* smem) {
    float* sm = (float*)smem;
    const int G = gridDim.x, c = blockIdx.x;
    if (ph == 0) { if (PHON(0)) phase_p0(P, smem); return; }
    if (ph == NPH - 1) { if (!PHON(8)) return;
        const int wave = tidx() >> 6, lane = tidx() & 63; const float* ssq = (const float*)(P.ws + OFF_SSQ) + 2 * MPAD;
        for (int row = c * 8 + wave; row < ROWS; row += G * 8) { const float rs = rsqrtf(ssq[row] * (1.f / 1024.f) + 1e-6f); f32x4* yp = (f32x4*)(P.out + (size_t)row * 1024) + lane; const f32x4* gp = (const f32x4*)P.in[I_FNG] + lane;
#pragma unroll
            for (int j = 0; j < 4; ++j) yp[64 * j] = yp[64 * j] * rs * gp[64 * j]; }
        return;
    }
    const int l = (ph - 1) / 7, sp = (ph - 1) % 7;
    const char* XB = (const char*)(P.ws + OFF_XB); const char* ZYc = (const char*)(P.ws + OFF_ZY);
    float* ssq = (float*)(P.ws + OFF_SSQ);
    if (sp == 0) { if (!PHON(1)) return; SchedG1 S{XB, (const char*)(P.ws + OFF_W1T) + (size_t)l * 7424 * 2048, G, c}; EpiG1 E{(bf16_t*)(P.ws + OFF_PA), (bf16_t*)(P.ws + OFF_ZY), ssq + l * MPAD};
        g8::gemm_phase((LAS unsigned char*)smem, 2048, 2048, 1024, S, E);
        if (l == 0) { const int nfull = 65 * 13 - 3 * G;
            if (false && c >= nfull) { __syncthreads(); weight_items(P, smem, WI_EARLY, WI_ALL, (c - nfull) * 8 + (tidx() >> 6), (G - nfull) * 8); } }
        return; }
    if (sp == 1) { if (!PHON(2)) return;
        constexpr int NA = 1024, NL = 512, NG = 1024, NAS = 32, NC = 8;
        for (int it = c; it < NA + NL + NG + NAS + NC; it += G) { int r = it;
            if (r < NA) { rwkv_prep(P, l, r); continue; } r -= NA;
            if (r < NL) { lru_prep(P, l, r, sm); continue; } r -= NL;
            if (r < NG) { gla_prep(P, l, r, sm); continue; } r -= NG;
            if (r < NAS) { rwkv_prep(P, l, 1024 + r); continue; } r -= NAS;
            cache_copy(P, l, r); }
        return; }
    if (sp == 2) { if (!PHON(3)) return;
        const int nR = G >= 256 ? 128 : (G > 1 ? G / 2 : 0);
        if (c < nR) { if (PROBE_SP != 13) for (int it = c; it < 128; it += nR) { const int slot = it >> 3; rwkv_scan_prompt(P, l, (((it & 7) * 4 + (slot >> 2)) * 4) + (slot & 3), sm); } return; }
        constexpr int NSW = 512, NGP = 32, NLC = 8, NRS = 64, NSS = 128, NGS = 128, NLS = 64;
        if (nR == 0) for (int it = 0; it < 128; ++it) rwkv_scan_prompt(P, l, it, sm);
        for (int it = c - nR; it < NSW + NGP + NLC + NRS + NSS + NGS + NLS; it += G - nR) { int r = it;
            if (r < NGP) { gla_prefix(P, l, r); continue; } r -= NGP;
            if (r < NLC) { lru_carry(P, l, r); continue; } r -= NLC;
            if (r < NSW) { swa_prompt(P, l, r, sm); continue; } r -= NSW;
            if (r < NRS) { rwkv_scan_sample(P, l, r); continue; } r -= NRS;
            if (r < NSS) { swa_sample(P, l, r, sm); continue; } r -= NSS;
            if (r < NGS) { gla_sample(P, l, r, sm); continue; } r -= NGS;
            lru_sample(P, l, r, sm); }
        return; }
    if (sp == 3) { if (!PHON(4)) return;
        constexpr int NG = 1024, NL = 512, NR = 1032;
        for (int it = c; it < NG + NL + NR; it += G) { int r = it;
            if (r < NG) { gla_out(P, l, r, sm); continue; } r -= NG;
            if (r < NL) { lru_final(P, l, r); continue; } r -= NL;
            rwkv_post(P, l, r); }
        return; }
    if (sp == 4) { if (!PHON(5)) return; SchedBr S{ZYc, (const char*)(P.ws + OFF_WBR) + (size_t)l * 4 * 1024 * 512, G, c}; EpiBr E{(bf16_t*)(P.ws + OFF_BR)};
        g8::gemm_phase((LAS unsigned char*)smem, 2048, 512, 256, S, E);
        for (int it = G - 1 - c; it < 512; it += G) small_br(P, l, it, sm);
        return; }
    if (sp == 5) { if (!PHON(6)) return; SchedGate S{XB, (const char*)(P.ws + OFF_W1T) + (size_t)l * 7424 * 2048, G, c}; EpiGate E{(const bf16_t*)(P.ws + OFF_BR), ssq + l * MPAD, (bf16_t*)(P.ws + OFF_ZY)};
        g8::gemm_phase((LAS unsigned char*)smem, 2048, 2048, 1024, S, E);
        for (int it = G - 1 - c; it < 512; it += G) small_gate(P, l, it, sm);
        return; }
    if (PHON(7)) { SchedOut S{ZYc, (const char*)(P.ws + OFF_WOUT) + (size_t)l * 1024 * 2048, G, c};
        if (l == 0) { EpiOut<0> E{P.in[I_XP], P.in[I_XS], (bf16_t*)(P.ws + OFF_XB), P.out, ssq + MPAD}; g8::gemm_phase((LAS unsigned char*)smem, 2048, 2048, 1024, S, E); for (int it = G - 1 - c; it < 256; it += G) small_out<0>(P, l, it, sm); }
        else { EpiOut<1> E{P.in[I_XP], P.in[I_XS], (bf16_t*)(P.ws + OFF_XB), P.out, ssq + 2 * MPAD}; g8::gemm_phase((LAS unsigned char*)smem, 2048, 2048, 1024, S, E); for (int it = G - 1 - c; it < 256; it += G) small_out<1>(P, l, it, sm); }
    }
}

__global__ void __launch_bounds__(512) mega_fwd(Params P, int ph_lo, int ph_hi, int cg_mode) {
    extern __shared__ __attribute__((aligned(16))) unsigned char smem[];
    cg::grid_group grid = cg::this_grid();
    unsigned nbar = 0;
    unsigned* barw = (unsigned*)(P.ws + OFF_BAR);
#define GSYNC() do { if (USE_CG_SYNC || cg_mode) grid.sync(); else grid_bar(barw, ++nbar); } while (0)
    for (int ph = ph_lo; ph < ph_hi; ++ph) {
        if (ph > ph_lo) GSYNC();
        __syncthreads();
        unsigned z; asm volatile("s_mov_b32 %0, 0" : "=s"(z));
        const Params* pp = (const Params*)((const char*)(const __attribute__((address_space(4))) char*)__builtin_amdgcn_kernarg_segment_ptr() + z);
        if (PROBE_SP == 13 && ph >= 1 && ph < NPH - 1 && (ph - 1) % 7 == 2) { if (blockIdx.x < 128) rwkv_scan_prompt(*pp, (ph - 1) / 7, blockIdx.x, (float*)smem); GSYNC(); __syncthreads(); }
        run_phase(*pp, ph, smem);
        if (PROBE_SP >= 0) {
            const int spx = (ph >= 1 && ph < NPH - 1) ? (ph - 1) % 7 : -1;
            if ((PROBE_SP < 7 && spx == PROBE_SP) || (PROBE_SP == 7 && ph == 0)) { GSYNC(); __syncthreads(); run_phase(*pp, ph, smem); }
            if (PROBE_SP == 8 && spx == 2) { GSYNC(); __syncthreads(); if (blockIdx.x < 128) rwkv_scan_prompt(*pp, (ph - 1) / 7, blockIdx.x, (float*)smem); }
            if (PROBE_SP == 9) GSYNC();
            if (PROBE_SP == 14 && spx == 2) { GSYNC(); __syncthreads(); if (blockIdx.x >= 128) for (int it = blockIdx.x - 128; it < 512; it += gridDim.x - 128) swa_prompt<true>(*pp, (ph - 1) / 7, it, (float*)smem); }
            if (PROBE_SP >= 15 && PROBE_SP <= 17 && spx == 2) { GSYNC(); __syncthreads(); const int l_ = (ph - 1) / 7;
                if (PROBE_SP == 15) for (int it = blockIdx.x; it < 1024; it += gridDim.x) gla_out<true>(*pp, l_, it, (float*)smem);
                if (PROBE_SP == 16) for (int it = blockIdx.x; it < 512; it += gridDim.x) lru_final<true>(*pp, l_, it);
                if (PROBE_SP == 17) for (int it = blockIdx.x; it < 1032; it += gridDim.x) rwkv_post<true>(*pp, l_, it); }
            if (PROBE_SP == 18 && spx == 5) { GSYNC(); __syncthreads(); const int l_ = (ph - 1) / 7; const int G = gridDim.x, c = blockIdx.x;
                SchedOut S{(const char*)(pp->ws + OFF_ZY), (const char*)(pp->ws + OFF_WOUT) + (size_t)l_ * 1024 * 2048, G, c}; float* ssq = (float*)(pp->ws + OFF_SSQ);
                if (l_ == 0) { EpiOut<0, false> E{pp->in[I_XP], pp->in[I_XS], (bf16_t*)(pp->ws + OFF_XB), pp->out, ssq + MPAD}; g8::gemm_phase((LAS unsigned char*)smem, 2048, 2048, 1024, S, E); }
                else { EpiOut<1, false> E{pp->in[I_XP], pp->in[I_XS], (bf16_t*)(pp->ws + OFF_XB), pp->out, ssq + 2 * MPAD}; g8::gemm_phase((LAS unsigned char*)smem, 2048, 2048, 1024, S, E); } }
            if (PROBE_SP >= 10 && PROBE_SP <= 12 && spx == 1) { GSYNC(); __syncthreads(); const int l_ = (ph - 1) / 7;
                if (PROBE_SP == 10) for (int it = blockIdx.x; it < 1024; it += gridDim.x) gla_prep(*pp, l_, it, (float*)smem);
                if (PROBE_SP == 11) for (int it = blockIdx.x; it < 512; it += gridDim.x) lru_prep(*pp, l_, it, (float*)smem);
                if (PROBE_SP == 12) for (int it = blockIdx.x; it < 1056; it += gridDim.x) rwkv_prep(*pp, l_, it); }
        }
    }
}

extern "C" void kernel_launch(void* const* d_in, const int* in_sizes, int n_in, void* d_out, int out_size, void* d_ws, size_t ws_size, hipStream_t stream) {
    static int grid = 0;
    if (grid == 0) {
        if (n_in != 35 || (size_t)out_size != O_END || ws_size < WS_END) { fprintf(stderr, "kernel_launch: unexpected shapes n_in %d out %d ws %zu (need %zu)\n", n_in, out_size, ws_size, (size_t)WS_END); grid = -1; return; }
        int dev = 0, cus = 0, per_cu = 0;
        hipGetDevice(&dev); hipDeviceGetAttribute(&cus, hipDeviceAttributeMultiprocessorCount, dev);
        if (hipFuncSetAttribute((const void*)mega_fwd, hipFuncAttributeMaxDynamicSharedMemorySize, LDS_BYTES) != hipSuccess) { fprintf(stderr, "kernel_launch: hipFuncSetAttribute failed\n"); grid = -1; return; }
        if (hipOccupancyMaxActiveBlocksPerMultiprocessor(&per_cu, (const void*)mega_fwd, 512, LDS_BYTES) != hipSuccess || per_cu < 1) { fprintf(stderr, "kernel_launch: occupancy query says %d\n", per_cu); per_cu = 1; }
        (void)hipGetLastError();
        grid = cus;
    }
    if (grid < 0) return;
    Params p{};
    for (int i = 0; i < 35; ++i) p.in[i] = (const float*)d_in[i];
    p.out = (float*)d_out; p.ws = (unsigned char*)d_ws;
#if ONE_LAUNCH
    (void)hipMemsetAsync((char*)d_ws + OFF_BAR, 0, 4096, stream);
    int lo = 0, hi = NPH, cgm = 0;
    void* args[] = {&p, &lo, &hi, &cgm};
    hipError_t e = hipLaunchCooperativeKernel((const void*)mega_fwd, dim3(grid), dim3(512), args, LDS_BYTES, stream);
    if (e != hipSuccess) fprintf(stderr, "cooperative launch failed: %s (grid %d)\n", hipGetErrorString(e), grid);
#else
    for (int ph = 0; ph < NPH; ++ph) hipLaunchKernelGGL(mega_fwd, dim3(grid), dim3(512), LDS_BYTES, stream, p, ph, ph + 1, 0);
#endif
}
```
